# Optimizing an MI355X kernel written in HIP

```python
import jax, jax.numpy as jnp
from jax import lax
import numpy as np

D_MODEL = 2048
BATCH = 4
SEQ = 4096
DEPTH = 2
DEC_BATCH = 32
DEC_SEQ = 64
PAST_LEN = 4096

CHUNK = 64
HEAD_DIM = 128
D_A = D_MODEL // 2
N_BLOCKS_A = D_A // HEAD_DIM
H_B = D_MODEL // 4 // HEAD_DIM
H_C = D_MODEL // 4 // HEAD_DIM
D_B = H_B * HEAD_DIM
D_C = H_C * HEAD_DIM
D_MIX = D_A + D_B + D_C
CONV_W = 4
LRU_C = 8.0
N_PREV_CHUNKS = 8
BAND = N_PREV_CHUNKS * CHUNK
REL_CLIP = 256
N_REL = 2 * REL_CLIP + 1
D_FF = 4 * D_MODEL
D_IN = 2 * D_A + 3 * D_B + 3 * D_C + H_C
SPLITS = (D_A, 2 * D_A, 2 * D_A + D_B, 2 * D_A + 2 * D_B, 2 * D_A + 3 * D_B,
          2 * D_A + 3 * D_B + D_C, 2 * D_A + 3 * D_B + 2 * D_C, 2 * D_A + 3 * D_B + 3 * D_C)
ALPHA = (2 * DEPTH) ** 0.25
BETA = (8 * DEPTH) ** -0.25
Q_BLOCK = 128
SCALE = HEAD_DIM ** -0.5
LN_EPS = 1e-5
NEG = -1e30

kernel_name = "hybrid_streaming_encoder_step"


def _layer_norm(x, g, b):
    xf = x.astype(jnp.float32)
    mu = jnp.mean(xf, -1, keepdims=True)
    var = jnp.mean(jnp.square(xf - mu), -1, keepdims=True)
    return ((xf - mu) * lax.rsqrt(var + LN_EPS) * g + b).astype(x.dtype)


def _rms_norm(x, g):
    xf = x.astype(jnp.float32)
    return (xf * lax.rsqrt(jnp.mean(xf * xf, -1, keepdims=True) + LN_EPS) * g).astype(x.dtype)


def _project(x, w_in, b_forget):
    B, T = x.shape[:2]
    a_x, a_g, bq, bk, bv, cq, ck, cv, cf = jnp.split(jnp.einsum('btd,de->bte', x, w_in), SPLITS, axis=-1)
    heads = lambda t, n: t.reshape(B, T, n, HEAD_DIM)
    logf = jax.nn.log_sigmoid((cf + b_forget).astype(jnp.float32))
    return (a_x, a_g, heads(bq, H_B), heads(bk, H_B), heads(bv, H_B),
            heads(cq, H_C), heads(ck, H_C), heads(cv, H_C), logf)


def _lin_combine(c1, c2):
    a1, b1 = c1
    a2, b2 = c2
    return a1 * a2, a2 * b1 + b2


def _rglru(xa, conv_buf, h0, w_conv, b_conv, w_ra, b_ra, w_rx, b_rx, lam, reset_first):
    B, T, _ = xa.shape
    xe = jnp.concatenate([conv_buf.astype(xa.dtype), xa], axis=1)
    xc = b_conv + sum(w_conv[j] * xe[:, j:j + T] for j in range(CONV_W))
    xb = xc.reshape(B, T, N_BLOCKS_A, HEAD_DIM)
    r = jax.nn.sigmoid(jnp.einsum('btnd,nde->btne', xb, w_ra).reshape(B, T, D_A) + b_ra)
    i = jax.nn.sigmoid(jnp.einsum('btnd,nde->btne', xb, w_rx).reshape(B, T, D_A) + b_rx)
    log_a = -LRU_C * r.astype(jnp.float32) * jax.nn.softplus(-lam.astype(jnp.float32))
    a = jnp.exp(log_a)
    mult = jnp.sqrt(-jnp.expm1(2.0 * log_a))
    if reset_first:
        mult = mult.at[:, 0].set(1.0)
    u = mult * (i * xc).astype(jnp.float32)
    u = u.at[:, 0].add(a[:, 0] * h0.astype(jnp.float32))
    _, h = lax.associative_scan(_lin_combine, (a, u), axis=1)
    return h, xe[:, -(CONV_W - 1):], h[:, -1]


def _rel_bias(table, dist):
    return table[:, jnp.clip(dist, -REL_CLIP, REL_CLIP) + REL_CLIP].astype(jnp.float32)


def _band_prompt(q, k, v, rel_table):
    B, S = q.shape[:2]
    nc = S // CHUNK
    nk = (N_PREV_CHUNKS + 1) * CHUNK
    qc = q.reshape(B, nc, CHUNK, H_B, HEAD_DIM)
    pad = jnp.zeros((B, N_PREV_CHUNKS, CHUNK, H_B, HEAD_DIM), k.dtype)
    kp = jnp.concatenate([pad, k.reshape(B, nc, CHUNK, H_B, HEAD_DIM)], axis=1)
    vp = jnp.concatenate([pad, v.reshape(B, nc, CHUNK, H_B, HEAD_DIM)], axis=1)
    kband = jnp.concatenate([kp[:, j:j + nc] for j in range(N_PREV_CHUNKS + 1)], axis=2)
    vband = jnp.concatenate([vp[:, j:j + nc] for j in range(N_PREV_CHUNKS + 1)], axis=2)
    qi = jnp.arange(CHUNK)[:, None]
    km = jnp.arange(nk)[None, :]
    bias = _rel_bias(rel_table, BAND + qi - km)
    valid = (jnp.arange(nc)[:, None] * CHUNK - BAND + jnp.arange(nk)[None, :]) >= 0
    s = jnp.einsum('bnqhd,bnkhd->bnhqk', qc, kband).astype(jnp.float32) * SCALE + bias[None, None]
    s = jnp.where(valid[None, :, None, None, :], s, NEG)
    p = jax.nn.softmax(s, axis=-1).astype(v.dtype)
    o = jnp.einsum('bnhqk,bnkhd->bnqhd', p, vband)
    return o.reshape(B, S, D_B)


def _band_sample(q, k_new, v_new, k_cache, v_cache, rel_table):
    B, T = q.shape[:2]
    n_c = k_cache.shape[1]
    k = jnp.concatenate([k_cache.astype(k_new.dtype), k_new], axis=1)
    v = jnp.concatenate([v_cache.astype(v_new.dtype), v_new], axis=1)
    pos_k = jnp.concatenate([jnp.arange(n_c) - n_c, jnp.arange(T)])
    bias = _rel_bias(rel_table, jnp.arange(T)[:, None] - pos_k[None, :])
    s = jnp.einsum('bqhd,bkhd->bhqk', q, k).astype(jnp.float32) * SCALE + bias[None]
    p = jax.nn.softmax(s, axis=-1).astype(v.dtype)
    return jnp.einsum('bhqk,bkhd->bqhd', p, v).reshape(B, T, D_C)


def _fox_attend(q, fq, tq, k, v, fk, tk):
    s = jnp.einsum('bqhd,bkhd->bhqk', q, k).astype(jnp.float32) * SCALE
    s = s + (jnp.swapaxes(fq, 1, 2)[..., :, None] - jnp.swapaxes(fk, 1, 2)[..., None, :])
    s = jnp.where(tk[None, :] <= tq[:, None], s, NEG)
    p = jax.nn.softmax(s, axis=-1).astype(v.dtype)
    return jnp.einsum('bhqk,bkhd->bqhd', p, v)


def _fox_prompt(q, k, v, logf):
    B, S = q.shape[:2]
    F = jnp.cumsum(logf.astype(jnp.float32), axis=1)
    nb = S // Q_BLOCK
    qb = q.reshape(B, nb, Q_BLOCK, H_C, HEAD_DIM).transpose(1, 0, 2, 3, 4)
    fb = F.reshape(B, nb, Q_BLOCK, H_C).transpose(1, 0, 2, 3)
    tq = jnp.arange(S).reshape(nb, Q_BLOCK)
    tk = jnp.arange(S)
    o = lax.map(lambda blk: _fox_attend(blk[0], blk[1], blk[2], k, v, F, tk), (qb, fb, tq))
    return o.transpose(1, 0, 2, 3, 4).reshape(B, S, D_C)


def _fox_sample(q, k_new, v_new, logf_new, k_cache, v_cache, logf_cache):
    B, T = q.shape[:2]
    P = k_cache.shape[1]
    k = jnp.concatenate([k_cache.astype(k_new.dtype), k_new], axis=1)
    v = jnp.concatenate([v_cache.astype(v_new.dtype), v_new], axis=1)
    F = jnp.cumsum(jnp.concatenate([logf_cache.astype(jnp.float32), logf_new], axis=1), axis=1)
    o = _fox_attend(q, F[:, P:], P + jnp.arange(T), k, v, F, jnp.arange(P + T))
    return o.reshape(B, T, D_C)


def _finish_layer(x, y_a, y_b, y_c, g_mix, w_out, ln1_g, ln1_b, w_up, w_down, ln2_g, ln2_b):
    y = jnp.concatenate([_rms_norm(y_a, g_mix[:D_A]),
                         _rms_norm(y_b, g_mix[D_A:D_A + D_B]),
                         _rms_norm(y_c, g_mix[D_A + D_B:])], axis=-1)
    x = _layer_norm(ALPHA * x + jnp.einsum('btm,md->btd', y, w_out), ln1_g, ln1_b)
    hdn = jnp.square(jax.nn.relu(jnp.einsum('btd,df->btf', x, w_up)))
    return _layer_norm(ALPHA * x + jnp.einsum('btf,fd->btd', hdn, w_down), ln2_g, ln2_b)


def setup_inputs(seed: int = 0) -> dict:
    key = jax.random.key(seed)
    ks = jax.random.split(key, 32)
    f32 = jnp.float32
    nrm = lambda k, shape, s: jax.random.normal(k, shape, f32) * s
    band_rows = min(BAND, PAST_LEN)
    u = jax.random.uniform(ks[15], (DEPTH, D_A), f32, minval=0.9, maxval=0.999)
    a_base = u ** (1.0 / LRU_C)
    lru_lambda = jnp.log(a_base) - jnp.log1p(-a_base)
    return {
        "x_prompt": nrm(ks[0], (BATCH, SEQ, D_MODEL), 1.0),
        "x_sample": nrm(ks[1], (DEC_BATCH, DEC_SEQ, D_MODEL), 1.0),
        "state_conv": nrm(ks[2], (DEPTH, DEC_BATCH, CONV_W - 1, D_A), 1.0),
        "state_lru": nrm(ks[3], (DEPTH, DEC_BATCH, D_A), 0.5),
        "cache_band_k": nrm(ks[4], (DEPTH, DEC_BATCH, band_rows, H_B, HEAD_DIM), 1.0),
        "cache_band_v": nrm(ks[5], (DEPTH, DEC_BATCH, band_rows, H_B, HEAD_DIM), 1.0),
        "cache_fox_k": nrm(ks[6], (DEPTH, DEC_BATCH, PAST_LEN, H_C, HEAD_DIM), 1.0),
        "cache_fox_v": nrm(ks[7], (DEPTH, DEC_BATCH, PAST_LEN, H_C, HEAD_DIM), 1.0),
        "cache_fox_logf": jax.nn.log_sigmoid(nrm(ks[8], (DEPTH, DEC_BATCH, PAST_LEN, H_C), 1.0) + 4.0),
        "w_in": nrm(ks[9], (DEPTH, D_MODEL, D_IN), D_MODEL ** -0.5),
        "w_conv": nrm(ks[10], (DEPTH, CONV_W, D_A), CONV_W ** -0.5),
        "b_conv": nrm(ks[11], (DEPTH, D_A), 0.02),
        "w_rg_a": nrm(ks[12], (DEPTH, N_BLOCKS_A, HEAD_DIM, HEAD_DIM), HEAD_DIM ** -0.5),
        "b_rg_a": nrm(ks[13], (DEPTH, D_A), 0.02),
        "w_rg_x": nrm(ks[14], (DEPTH, N_BLOCKS_A, HEAD_DIM, HEAD_DIM), HEAD_DIM ** -0.5),
        "b_rg_x": nrm(ks[16], (DEPTH, D_A), 0.02),
        "lru_lambda": lru_lambda,
        "rel_bias": nrm(ks[17], (DEPTH, H_B, N_REL), 0.2),
        "b_forget": jax.random.uniform(ks[18], (DEPTH, H_C), f32, minval=2.0, maxval=6.0),
        "g_mix": 1.0 + nrm(ks[19], (DEPTH, D_MIX), 0.02),
        "w_out": nrm(ks[20], (DEPTH, D_MIX, D_MODEL), BETA * D_MIX ** -0.5),
        "ln1_g": 1.0 + nrm(ks[21], (DEPTH, D_MODEL), 0.02),
        "ln1_b": nrm(ks[22], (DEPTH, D_MODEL), 0.02),
        "w_up": nrm(ks[23], (DEPTH, D_MODEL, D_FF), D_MODEL ** -0.5),
        "w_down": nrm(ks[24], (DEPTH, D_FF, D_MODEL), BETA * D_FF ** -0.5),
        "ln2_g": 1.0 + nrm(ks[25], (DEPTH, D_MODEL), 0.02),
        "ln2_b": nrm(ks[26], (DEPTH, D_MODEL), 0.02),
    }


def reference(x_prompt, x_sample, state_conv, state_lru, cache_band_k, cache_band_v,
              cache_fox_k, cache_fox_v, cache_fox_logf, w_in, w_conv, b_conv, w_rg_a, b_rg_a,
              w_rg_x, b_rg_x, lru_lambda, rel_bias, b_forget, g_mix, w_out, ln1_g, ln1_b,
              w_up, w_down, ln2_g, ln2_b):
    xp, xs = x_prompt, x_sample
    Bp, S = xp.shape[:2]
    n_band_p = min(BAND, S)
    p_conv, p_lru, p_bk, p_bv, p_fk, p_fv, p_fl = [], [], [], [], [], [], []
    s_conv, s_lru, s_bk, s_bv, s_fk, s_fv, s_fl = [], [], [], [], [], [], []
    for l in range(DEPTH):
        lru_w = (w_conv[l], b_conv[l], w_rg_a[l], b_rg_a[l], w_rg_x[l], b_rg_x[l], lru_lambda[l])
        out_w = (g_mix[l], w_out[l], ln1_g[l], ln1_b[l], w_up[l], w_down[l], ln2_g[l], ln2_b[l])

        a_x, a_g, bq, bk, bv, cq, ck, cv, logf = _project(xp, w_in[l], b_forget[l])
        h, buf, h_last = _rglru(a_x, jnp.zeros((Bp, CONV_W - 1, D_A), xp.dtype),
                                jnp.zeros((Bp, D_A), jnp.float32), *lru_w, reset_first=True)
        y_a = h.astype(xp.dtype) * jax.nn.gelu(a_g)
        y_b = _band_prompt(bq, bk, bv, rel_bias[l])
        y_c = _fox_prompt(cq, ck, cv, logf)
        xp = _finish_layer(xp, y_a, y_b, y_c, *out_w)
        p_conv.append(buf)
        p_lru.append(h_last)
        p_bk.append(bk[:, S - n_band_p:])
        p_bv.append(bv[:, S - n_band_p:])
        p_fk.append(ck)
        p_fv.append(cv)
        p_fl.append(logf)

        a_x, a_g, bq, bk, bv, cq, ck, cv, logf = _project(xs, w_in[l], b_forget[l])
        h, buf, h_last = _rglru(a_x, state_conv[l], state_lru[l], *lru_w, reset_first=False)
        y_a = h.astype(xs.dtype) * jax.nn.gelu(a_g)
        y_b = _band_sample(bq, bk, bv, cache_band_k[l], cache_band_v[l], rel_bias[l])
        y_c = _fox_sample(cq, ck, cv, logf, cache_fox_k[l], cache_fox_v[l], cache_fox_logf[l])
        xs = _finish_layer(xs, y_a, y_b, y_c, *out_w)
        s_conv.append(buf)
        s_lru.append(h_last)
        s_bk.append(bk)
        s_bv.append(bv)
        s_fk.append(ck)
        s_fv.append(cv)
        s_fl.append(logf)

    st = lambda xs_list: jnp.stack(xs_list, axis=0)
    return (xp, xs,
            st(p_conv), st(p_lru), st(p_bk), st(p_bv), st(p_fk), st(p_fv), st(p_fl),
            st(s_conv), st(s_lru), st(s_bk), st(s_bv), st(s_fk), st(s_fv), st(s_fl))
```

```cpp
#include <hip/hip_runtime.h>
#include <cstdio>
#include <cstdint>

typedef unsigned short bf16_t;

constexpr int DM = 2048, NB_P = 4, SEQ = 4096, DEPTH = 2, NB_S = 32, TS = 64, PAST = 4096;
constexpr int TP = NB_P * SEQ;
constexpr int TT = TP + NB_S * TS;
constexpr int DA = 1024, HD = 128, NH = 4, DB = 512, DIN = 5124, DINP = 5120, DFF = 8192, NREL = 513, BAND = 512;
constexpr int HP = DINP;
constexpr float ALPHA = 1.41421356237309515f, SCALE = 0.08838834764831845f, LN_EPS = 1e-5f, NEGBIG = -1e30f;
constexpr int C_AX = 0, C_AG = 1024, C_BQ = 2048, C_BK = 2560, C_BV = 3072, C_CQ = 3584, C_CK = 4096, C_CV = 4608;

constexpr size_t O_YP = 0;
constexpr size_t O_YS = O_YP + (size_t)NB_P * SEQ * DM;
constexpr size_t O_PCONV = O_YS + (size_t)NB_S * TS * DM;
constexpr size_t O_PLRU = O_PCONV + (size_t)DEPTH * NB_P * 3 * DA;
constexpr size_t O_PBK = O_PLRU + (size_t)DEPTH * NB_P * DA;
constexpr size_t O_PBV = O_PBK + (size_t)DEPTH * NB_P * BAND * DB;
constexpr size_t O_PFK = O_PBV + (size_t)DEPTH * NB_P * BAND * DB;
constexpr size_t O_PFV = O_PFK + (size_t)DEPTH * NB_P * SEQ * DB;
constexpr size_t O_PFL = O_PFV + (size_t)DEPTH * NB_P * SEQ * DB;
constexpr size_t O_SCONV = O_PFL + (size_t)DEPTH * NB_P * SEQ * NH;
constexpr size_t O_SLRU = O_SCONV + (size_t)DEPTH * NB_S * 3 * DA;
constexpr size_t O_SBK = O_SLRU + (size_t)DEPTH * NB_S * DA;
constexpr size_t O_SBV = O_SBK + (size_t)DEPTH * NB_S * TS * DB;
constexpr size_t O_SFK = O_SBV + (size_t)DEPTH * NB_S * TS * DB;
constexpr size_t O_SFV = O_SFK + (size_t)DEPTH * NB_S * TS * DB;
constexpr size_t O_SFL = O_SFV + (size_t)DEPTH * NB_S * TS * DB;
constexpr size_t O_END = O_SFL + (size_t)DEPTH * NB_S * TS * NH;
static_assert(O_END == 84328448ull, "output size");

constexpr size_t MiB = 1ull << 20;
constexpr size_t WS_CTL = 0;
constexpr size_t WS_WIN = 1 * MiB;
constexpr size_t WS_WOUT = WS_WIN + 40 * MiB;
constexpr size_t WS_WUP = WS_WOUT + 16 * MiB;
constexpr size_t WS_WDN = WS_WUP + 64 * MiB;
constexpr size_t WS_WF = WS_WDN + 64 * MiB;
constexpr size_t WS_XB = WS_WF + 1 * MiB;
constexpr size_t WS_X1F = WS_XB + 72 * MiB;
constexpr size_t WS_X1B = WS_X1F + 144 * MiB;
constexpr size_t WS_X2F = WS_X1B + 72 * MiB;
constexpr size_t WS_Z = WS_X2F + 144 * MiB;
constexpr size_t WS_H = WS_Z + 144 * MiB;
constexpr size_t WS_Y = WS_H + 186 * MiB;
constexpr size_t WS_HDN = WS_Y + 72 * MiB;
constexpr size_t WS_OB = WS_HDN + 288 * MiB;
constexpr size_t WS_OC = WS_OB + 36 * MiB;
constexpr size_t WS_FP = WS_OC + 36 * MiB;
constexpr size_t WS_FS = WS_FP + 1 * MiB;
constexpr size_t WS_OA = WS_FS + 3 * MiB;
constexpr size_t WS_XC = WS_OA + 72 * MiB;
constexpr size_t WS_AA = WS_XC + 72 * MiB;
constexpr size_t WS_UU = WS_AA + 72 * MiB;
constexpr size_t WS_WG = WS_UU + 72 * MiB;
constexpr size_t WS_PO = WS_WG + 1 * MiB;
constexpr size_t WS_PM = WS_PO + 16 * MiB;
constexpr size_t WS_PL = WS_PM + 1 * MiB;
constexpr size_t WS_SA = WS_PL + 1 * MiB;
constexpr size_t WS_SH = WS_SA + 1 * MiB;
constexpr size_t WS_SK = WS_SH + 1 * MiB;
constexpr size_t WS_END = WS_SK + 64 * MiB;
static_assert(WS_END <= 2048 * MiB, "workspace");

__device__ __forceinline__ float bf2f(bf16_t b) { return __uint_as_float(((unsigned)b) << 16); }
__device__ __forceinline__ float bflo(unsigned w) { return __uint_as_float(w << 16); }
__device__ __forceinline__ float bfhi(unsigned w) { return __uint_as_float(w & 0xffff0000u); }
__device__ __forceinline__ bf16_t f2bf(float f) { unsigned u = __float_as_uint(f); u += 0x7fffu + ((u >> 16) & 1u); return (bf16_t)(u >> 16); }
__device__ __forceinline__ float xshfl32(float v, int lane) { return __builtin_bit_cast(float, __builtin_amdgcn_ds_bpermute((lane ^ 32) << 2, __builtin_bit_cast(int, v))); }
__device__ __forceinline__ float wave_sum(float v) {
#define WS_DPP(x, ctrl, rmask) __builtin_bit_cast(float, __builtin_amdgcn_update_dpp(0, __builtin_bit_cast(int, (x)), (ctrl), (rmask), 0xF, false))
    v += WS_DPP(v, 0xB1, 0xF);
    v += WS_DPP(v, 0x4E, 0xF);
    v += WS_DPP(v, 0x141, 0xF);
    v += WS_DPP(v, 0x140, 0xF);
    v += WS_DPP(v, 0x142, 0xA);
    v += WS_DPP(v, 0x143, 0xC);
#undef WS_DPP
    return __builtin_bit_cast(float, __builtin_amdgcn_readlane(__builtin_bit_cast(int, v), 63));
}
__device__ __forceinline__ float wave_max(float v) {
#pragma unroll
    for (int o = 1; o < 64; o <<= 1) v = fmaxf(v, __shfl_xor(v, o));
    return v;
}
__device__ __forceinline__ float log_sigmoid_f(float z) { return fminf(z, 0.f) - log1pf(expf(-fabsf(z))); }
__device__ __forceinline__ float sigmoid_f(float z) { return 1.f / (1.f + expf(-z)); }
__device__ __forceinline__ float gelu_tanh_f(float x) { return 0.5f * x * (1.f + tanhf(0.7978845608028654f * (x + 0.044715f * x * x * x))); }
__device__ __forceinline__ const float* xrow0(const float* xp, const float* xs, int row) { return row < TP ? xp + (size_t)row * DM : xs + (size_t)(row - TP) * DM; }
__device__ __forceinline__ void row_bt(int row, bool& prm, int& b, int& t) { prm = row < TP; if (prm) { b = row >> 12; t = row & 4095; } else { const int r = row - TP; b = r >> 6; t = r & 63; } }

__device__ __forceinline__ float logf_get(const float* out, const float* cfl_l, int l, bool prm, int b, int h, int i) {
    if (prm) return out[O_PFL + ((size_t)(l * NB_P + b) * SEQ + i) * NH + h];
    if (i < PAST) return cfl_l[((size_t)b * PAST + i) * NH + h];
    return out[O_SFL + ((size_t)(l * NB_S + b) * TS + (i - PAST)) * NH + h];
}
namespace pg8 {
#define PG8_LAS __attribute__((address_space(3)))
typedef unsigned short bf16_t;
typedef short bf16x8 __attribute__((ext_vector_type(8)));
typedef float f32x4 __attribute__((ext_vector_type(4)));
typedef unsigned u32x4 __attribute__((ext_vector_type(4)));
constexpr int BM = 256, BK = 64, HALF = 128, HTB = HALF * BK * 2  , STAGE_BYTES = 8 * HTB, NXCD = 8, WGM = 8;

__host__ __device__ __forceinline__ int lds_byte(int r, int c) { const int st = (r >> 4) * 2 + (c >> 5), rr = r & 15, cc = c & 31, ob = rr * 64 + cc * 2; return st * 1024 + (ob ^ (((ob >> 9) & 1) << 5)); }
__host__ __device__ __forceinline__ void stage_rc(int b, int& R, int& C) { const int st = b / 1024, sb = b % 1024, swz = sb ^ (((sb >> 9) & 1) << 5); R = (st >> 1) * 16 + swz / 64; C = (st & 1) * 32 + (swz % 64) / 2; }
__host__ __device__ __forceinline__ int perm32(int rho) { const int n = rho >> 4, i = rho & 15; return 8 * (i >> 2) + 4 * n + (i & 3); }

struct Unit { int pm, pn, k0, nt, part, slot; };
struct Gemm { const bf16_t* A; const bf16_t* Bt; int M, N, K; };

struct StaticOrder {
    int nM, nN, nwg, G, c, ntk, R, SF;
    __host__ __device__ __forceinline__ void init(int M, int N, int K, int G_, int c_, bool split) {
        nM = M / BM; nN = N / BM; nwg = nM * nN; G = G_; c = c_; ntk = K / BK; R = nwg / G;
        const int rem = nwg - R * G; SF = rem ? 1 : 0;
        if (split && rem && (G % rem) == 0) { const int sf = G / rem; if (sf == 4 && (ntk % (2 * sf)) == 0 && ntk / sf >= 4) SF = sf; }
    }
    __host__ __device__ __forceinline__ Unit tile_of(int L, int k0, int nt, int part, int slot) const {
        int wgid = L; { const int q = nwg / NXCD, r = nwg % NXCD, xcd = wgid % NXCD, off = wgid / NXCD; wgid = (xcd < r ? xcd * (q + 1) : r * (q + 1) + (xcd - r) * q) + off; }
        const int nig = WGM * nN, gid = wgid / nig, fm = gid * WGM, gsz = (nM - fm) < WGM ? (nM - fm) : WGM;
        return Unit{fm + ((wgid % nig) % gsz), (wgid % nig) / gsz, k0, nt, part, slot};
    }
    __host__ __device__ __forceinline__ Unit next(int i) const {
        if (SF >= 2) {
            if (i == 0) { const int j = c / SF, part = c % SF, ntp = ntk / SF; return tile_of(R * G + j, part * ntp, ntp, part, j); }
            if (i <= R) return tile_of((i - 1) * G + c, 0, ntk, -1, 0);
            return Unit{0, 0, 0, 0, -1, 0};
        }
        if (i < R) return tile_of(i * G + c, 0, ntk, -1, 0);
        if (i > R || SF == 0) return Unit{0, 0, 0, 0, -1, 0};
        { const int L = R * G + c; if (L >= nwg) return Unit{0, 0, 0, 0, -1, 0}; return tile_of(L, 0, ntk, -1, 0); }
    }
    __device__ __forceinline__ void a_ready(const Unit&) const {}
    __device__ __forceinline__ void done(const Unit&) const {}
};
typedef unsigned u32x2 __attribute__((ext_vector_type(2)));
__device__ __forceinline__ unsigned cvt_pk_bf16(float lo, float hi) { unsigned r; asm volatile("v_cvt_pk_bf16_f32 %0, %1, %2" : "=v"(r) : "v"(lo), "v"(hi)); return r; }

struct EpiInP {
    static constexpr bool PERM = true, AFTER_DRAIN = false, HAS_FRAG = false;
    bf16_t* H; float* out; int l;
    __device__ __forceinline__ void operator()(const f32x4 (&acc)[2][2][4][2], const Unit& u, int wr, int wc, int fr, int fq) const {
        const int pn = u.pn, pm = u.pm;
        const bool prm = pm < 64;
        const int ccol = (pn & 1) * 256 + wc * 32 + 8 * fq;
        const int col0 = pn * 256 + wc * 32 + 8 * fq;
        const int kind = (pn < 4) ? 3 : ((pn >= 10 && pn < 14) ? 1 : ((pn >= 16) ? 2 : 0));
        const bool isv = (kind == 1) ? (pn >= 12) : (pn >= 18);
#pragma unroll
        for (int ai = 0; ai < 2; ++ai)
#pragma unroll
            for (int m = 0; m < 4; ++m) {
                const int rloc = ai * 128 + wr * 64 + m * 16 + fr;
                const int row = pm * 256 + rloc;
                int b, t; if (prm) { b = pm >> 4; t = (pm & 15) * 256 + rloc; } else { const int r = row - TP; b = r >> 6; t = r & 63; }
                float* fp = nullptr;
                if (kind == 1) { if (prm) { if (t >= SEQ - BAND) fp = out + (isv ? O_PBV : O_PBK) + ((size_t)(l * NB_P + b) * BAND + (t - (SEQ - BAND))) * DB + ccol; }
                                 else fp = out + (isv ? O_SBV : O_SBK) + ((size_t)(l * NB_S + b) * TS + t) * DB + ccol; }
                else if (kind == 2) { if (prm) fp = out + (isv ? O_PFV : O_PFK) + ((size_t)(l * NB_P + b) * SEQ + t) * DB + ccol;
                                      else fp = out + (isv ? O_SFV : O_SFK) + ((size_t)(l * NB_S + b) * TS + t) * DB + ccol; }
                else if (kind == 3) { if (prm) { if (t >= SEQ - 3) fp = out + O_PCONV + ((size_t)(l * NB_P + b) * 3 + (t - (SEQ - 3))) * DA + col0; }
                                      else { if (t >= TS - 3) fp = out + O_SCONV + ((size_t)(l * NB_S + b) * 3 + (t - (TS - 3))) * DA + col0; } }
                bf16_t* hp = H + (size_t)row * HP + col0;
#pragma unroll
                for (int bj = 0; bj < 2; ++bj) {
                    const f32x4 v0 = acc[ai][bj][m][0], v1 = acc[ai][bj][m][1];
                    u32x4 w; w.x = cvt_pk_bf16(v0[0], v0[1]); w.y = cvt_pk_bf16(v0[2], v0[3]); w.z = cvt_pk_bf16(v1[0], v1[1]); w.w = cvt_pk_bf16(v1[2], v1[3]);
                    *(u32x4*)(hp + bj * HALF) = w;
                    if (fp) { *(f32x4*)(fp + bj * HALF) = v0; *(f32x4*)(fp + bj * HALF + 4) = v1; }
                }
            }
    }
};
template <bool XB16> struct EpiResP {
    static constexpr bool PERM = true, AFTER_DRAIN = false, HAS_FRAG = true;
    bf16_t* Z; const float* xa; const float* xb; const bf16_t* xh;
    __device__ __forceinline__ f32x4 xload(const Unit& u, size_t o) const {
        if constexpr (XB16) { const unsigned long long w = *(const unsigned long long*)(xh + (size_t)u.pm * BM * DM + o); const unsigned lo = (unsigned)w, hi = (unsigned)(w >> 32);
                              return (f32x4){__uint_as_float(lo << 16), __uint_as_float(lo & 0xffff0000u), __uint_as_float(hi << 16), __uint_as_float(hi & 0xffff0000u)}; }
        else { const float* xbase = (u.pm < TP / BM) ? xa + (size_t)u.pm * BM * DM : xb + (size_t)(u.pm - TP / BM) * BM * DM; return *(const f32x4*)(xbase + o); }
    }
    __device__ __forceinline__ void frag(const f32x4 v, const Unit& u, int ai, int bj, int m, int n, int wr, int wc, int fr, int fq) const {
        const size_t o = (size_t)(wr * 64 + fr + ai * HALF + m * 16) * DM + u.pn * BM + wc * 32 + 8 * fq + bj * HALF + 4 * n;
        const f32x4 r = xload(u, o) * ALPHA + v;
        u32x2 w; w.x = cvt_pk_bf16(r[0], r[1]); w.y = cvt_pk_bf16(r[2], r[3]);
        *(u32x2*)(Z + (size_t)u.pm * BM * DM + o) = w;
    }
    __device__ __forceinline__ void operator()(const f32x4 (&acc)[2][2][4][2], const Unit& u, int wr, int wc, int fr, int fq) const {
        const int rloc0 = wr * 64 + fr, col0 = u.pn * BM + wc * 32 + 8 * fq;
        bf16_t* zbase = Z + (size_t)u.pm * BM * DM;
#pragma unroll
        for (int ai = 0; ai < 2; ++ai)
#pragma unroll
            for (int m = 0; m < 4; ++m) {
                const size_t ro = (size_t)(rloc0 + ai * HALF + m * 16) * DM + col0;
#pragma unroll
                for (int bj = 0; bj < 2; ++bj) {
                    const f32x4 r0 = xload(u, ro + bj * HALF) * ALPHA + acc[ai][bj][m][0], r1 = xload(u, ro + bj * HALF + 4) * ALPHA + acc[ai][bj][m][1];
                    u32x4 w; w.x = cvt_pk_bf16(r0[0], r0[1]); w.y = cvt_pk_bf16(r0[2], r0[3]); w.z = cvt_pk_bf16(r1[0], r1[1]); w.w = cvt_pk_bf16(r1[2], r1[3]);
                    *(u32x4*)(zbase + ro + bj * HALF) = w;
                }
            }
    }
};
struct EpiUpP {
    static constexpr bool PERM = true, AFTER_DRAIN = false, HAS_FRAG = false;
    bf16_t* HDN;
    __device__ __forceinline__ void operator()(const f32x4 (&acc)[2][2][4][2], const Unit& u, int wr, int wc, int fr, int fq) const {
        const int row0 = u.pm * BM + wr * 64 + fr, col0 = u.pn * BM + wc * 32 + 8 * fq;
#pragma unroll
        for (int ai = 0; ai < 2; ++ai)
#pragma unroll
            for (int m = 0; m < 4; ++m) {
                bf16_t* rowp = HDN + (size_t)(row0 + ai * HALF + m * 16) * DFF + col0;
#pragma unroll
                for (int bj = 0; bj < 2; ++bj) {
                    f32x4 v0 = acc[ai][bj][m][0], v1 = acc[ai][bj][m][1];
#pragma unroll
                    for (int j = 0; j < 4; ++j) { const float a = fmaxf(v0[j], 0.f), b = fmaxf(v1[j], 0.f); v0[j] = a * a; v1[j] = b * b; }
                    u32x4 w; w.x = cvt_pk_bf16(v0[0], v0[1]); w.y = cvt_pk_bf16(v0[2], v0[3]); w.z = cvt_pk_bf16(v1[0], v1[1]); w.w = cvt_pk_bf16(v1[2], v1[3]);
                    *(u32x4*)(rowp + bj * HALF) = w;
                }
            }
    }
};
#ifdef PROBE_PLAIN_SLAB
#define SK_AUX 0
#else
#define SK_AUX 16
#endif
template <class Epi, class Sched, bool ALIGN_EPI = false, bool SP2 = false>
__device__ __forceinline__ void gemm_phase(PG8_LAS unsigned char* lds, const Gemm g, const Sched& S, const Epi& E, float* sk_slab = nullptr, unsigned* sk_cnt = nullptr) {
    int tid_ = threadIdx.x; asm volatile("" : "+v"(tid_));
    const int tid = tid_, wid = __builtin_amdgcn_readfirstlane(tid >> 6), lane = tid & 63, wr = wid >> 2, wc = wid & 3, fr = lane & 15, fq = lane >> 4;
    const int K = g.K;
    unsigned voffA[2], voffB[2];
#pragma unroll
    for (int i = 0; i < 2; ++i) { int R, C; stage_rc(tid * 16 + i * 8192, R, C); const int Rb = Epi::PERM ? ((R & ~31) + perm32(R & 31)) : R;
        voffA[i] = (unsigned)(R * K + C) * 2u; voffB[i] = (unsigned)(Rb * K + C) * 2u; }
    const size_t kstep = (size_t)(BK * 2);
    const size_t hstep = (size_t)HALF * K * 2;
    const size_t tstep = 2 * hstep;
    const unsigned ldsw = (unsigned)wid * 1024u;
    const int aoff = lds_byte(wr * 64 + fr, fq * 8), boff = lds_byte(wc * 32 + fr, fq * 8);
#define PG8_SA(b, h) (((b) * 2 + (h)) * HTB)
#define PG8_SB(b, h) ((4 + (b) * 2 + (h)) * HTB)
#define PG8_STAGE(bufoff, gbase, voff) do { _Pragma("unroll") for (int _i = 0; _i < 2; ++_i) \
        __builtin_amdgcn_global_load_lds((const unsigned*)((const char*)(gbase) + (voff)[_i]), (PG8_LAS unsigned*)(lds + (bufoff) + ldsw + _i * 8192), 16, 0, 0); } while (0)
#define PG8_LDA(dst, b, h) do { _Pragma("unroll") for (int m = 0; m < 4; ++m) _Pragma("unroll") for (int k = 0; k < 2; ++k) dst[m][k] = *(const PG8_LAS bf16x8*)(lds + PG8_SA(b, h) + aoff + m * 2048 + k * 1024); } while (0)
#define PG8_LDB(dst, b, h) do { _Pragma("unroll") for (int n = 0; n < 2; ++n) _Pragma("unroll") for (int k = 0; k < 2; ++k) dst[n][k] = *(const PG8_LAS bf16x8*)(lds + PG8_SB(b, h) + boff + n * 2048 + k * 1024); } while (0)
#define PG8_MMA(ai, bj, At, Bt) do { __builtin_amdgcn_s_setprio(1); _Pragma("unroll") for (int m = 0; m < 4; ++m) _Pragma("unroll") for (int n = 0; n < 2; ++n) _Pragma("unroll") for (int k = 0; k < 2; ++k) \
        acc[ai][bj][m][n] = __builtin_amdgcn_mfma_f32_16x16x32_bf16(Bt[n][k], At[m][k], acc[ai][bj][m][n], 0, 0, 0); __builtin_amdgcn_s_setprio(0); } while (0)
#define PG8_WAIT_V(n) asm volatile("s_waitcnt vmcnt(" #n ")" ::: "memory")
#define PG8_WAIT_L(n) asm volatile("s_waitcnt lgkmcnt(" #n ")" ::: "memory")
#define PG8_BAR __builtin_amdgcn_s_barrier()
#define PG8_SCHED __builtin_amdgcn_sched_barrier(0)
    int ui = 0;
    Unit cur = S.next(0), nxt = cur;
    if (cur.nt == 0) return;
    const Unit first = cur;
    f32x4 acc[2][2][4][2];
#pragma unroll
    for (int a = 0; a < 2; ++a)
#pragma unroll
        for (int b = 0; b < 2; ++b)
#pragma unroll
            for (int m = 0; m < 4; ++m)
#pragma unroll
                for (int n = 0; n < 2; ++n) acc[a][b][m][n] = (f32x4){0.f, 0.f, 0.f, 0.f};
    bf16x8 At[4][2], B0[2][2], B1[2][2];
    const char* cA = (const char*)g.A + (size_t)cur.pm * tstep + (size_t)cur.k0 * kstep; const char* cB = (const char*)g.Bt + (size_t)cur.pn * tstep + (size_t)cur.k0 * kstep;
    S.a_ready(cur);
    if constexpr (SP2) {
        PG8_STAGE(PG8_SB(0, 0), cB, voffB); PG8_STAGE(PG8_SB(0, 1), cB + hstep, voffB); PG8_STAGE(PG8_SA(0, 0), cA, voffA); PG8_STAGE(PG8_SA(0, 1), cA + hstep, voffA);
        if (wr == 1) PG8_BAR;
        PG8_WAIT_V(2); PG8_BAR;
        PG8_STAGE(PG8_SB(1, 0), cB + kstep, voffB); PG8_STAGE(PG8_SA(1, 0), cA + kstep, voffA); PG8_STAGE(PG8_SB(1, 1), cB + hstep + kstep, voffB);
        PG8_WAIT_V(6); PG8_BAR;
    } else {
        PG8_STAGE(PG8_SB(0, 0), cB, voffB); PG8_STAGE(PG8_SA(0, 0), cA, voffA); PG8_STAGE(PG8_SB(0, 1), cB + hstep, voffB); PG8_STAGE(PG8_SA(0, 1), cA + hstep, voffA);
        if (wr == 1) PG8_BAR;
        PG8_WAIT_V(4); PG8_BAR;
        PG8_STAGE(PG8_SB(1, 0), cB + kstep, voffB); PG8_STAGE(PG8_SA(1, 0), cA + kstep, voffA); PG8_STAGE(PG8_SB(1, 1), cB + hstep + kstep, voffB);
        PG8_WAIT_V(6); PG8_BAR;
    }
    for (;;) {
        nxt = S.next(ui + 1); const bool has_next = nxt.nt != 0;
        const char* nA = has_next ? (const char*)g.A + (size_t)nxt.pm * tstep + (size_t)nxt.k0 * kstep : cA; const char* nB = has_next ? (const char*)g.Bt + (size_t)nxt.pn * tstep + (size_t)nxt.k0 * kstep : cB;
        const int nt = cur.nt;
        for (int t = 0; t < nt; t += 2) {
            const bool last = (t == nt - 2);
            const char* a1 = cA + (size_t)(t + 1) * kstep;
            const char* a2 = last ? nA : cA + (size_t)(t + 2) * kstep; const char* b2 = last ? nB : cB + (size_t)(t + 2) * kstep;
            const char* a3 = a2 + kstep; const char* b3 = b2 + kstep;
            if (last && has_next) S.a_ready(nxt);
            if constexpr (SP2) {
            PG8_LDB(B0, 0, 0); PG8_LDB(B1, 0, 1); PG8_SCHED; PG8_LDA(At, 0, 0); PG8_STAGE(PG8_SA(1, 1), a1 + hstep, voffA);
            PG8_WAIT_V(8); PG8_WAIT_L(0); PG8_BAR; PG8_MMA(0, 0, At, B0); PG8_MMA(0, 1, At, B1); PG8_BAR; PG8_SCHED;
            PG8_LDA(At, 0, 1); PG8_STAGE(PG8_SB(0, 0), b2, voffB); PG8_STAGE(PG8_SB(0, 1), b2 + hstep, voffB); PG8_STAGE(PG8_SA(0, 0), a2, voffA);
            PG8_WAIT_V(8); PG8_WAIT_L(0); PG8_BAR; PG8_MMA(1, 0, At, B0); PG8_MMA(1, 1, At, B1); PG8_BAR; PG8_SCHED;
            PG8_LDB(B0, 1, 0); PG8_LDB(B1, 1, 1); PG8_SCHED; PG8_LDA(At, 1, 0); PG8_STAGE(PG8_SA(0, 1), a2 + hstep, voffA);
            PG8_WAIT_V(8); PG8_WAIT_L(0); PG8_BAR; PG8_MMA(0, 0, At, B0); PG8_MMA(0, 1, At, B1); PG8_BAR; PG8_SCHED;
            PG8_LDA(At, 1, 1); PG8_STAGE(PG8_SB(1, 0), b3, voffB); PG8_STAGE(PG8_SB(1, 1), b3 + hstep, voffB); PG8_STAGE(PG8_SA(1, 0), a3, voffA);
            PG8_WAIT_V(8); PG8_WAIT_L(0); PG8_BAR; PG8_MMA(1, 0, At, B0); PG8_MMA(1, 1, At, B1); PG8_BAR; PG8_SCHED;
            } else {
            PG8_LDB(B0, 0, 0); PG8_SCHED; PG8_LDA(At, 0, 0); PG8_STAGE(PG8_SA(1, 1), a1 + hstep, voffA);
            PG8_WAIT_L(8); PG8_BAR; PG8_WAIT_L(0); PG8_MMA(0, 0, At, B0); PG8_BAR; PG8_SCHED;
            PG8_LDB(B1, 0, 1); PG8_STAGE(PG8_SB(0, 0), b2, voffB);
            PG8_BAR; PG8_WAIT_L(0); PG8_MMA(0, 1, At, B1); PG8_BAR;
            PG8_LDA(At, 0, 1); PG8_STAGE(PG8_SA(0, 0), a2, voffA);
            PG8_BAR; PG8_WAIT_L(0); PG8_MMA(1, 0, At, B0); PG8_BAR; PG8_SCHED;
            PG8_STAGE(PG8_SB(0, 1), b2 + hstep, voffB);
            PG8_WAIT_V(6); PG8_BAR; PG8_MMA(1, 1, At, B1); PG8_BAR;
            PG8_LDB(B0, 1, 0); PG8_SCHED; PG8_LDA(At, 1, 0); PG8_STAGE(PG8_SA(0, 1), a2 + hstep, voffA);
            PG8_WAIT_L(8); PG8_BAR; PG8_WAIT_L(0); PG8_MMA(0, 0, At, B0); PG8_BAR; PG8_SCHED;
            PG8_LDB(B1, 1, 1); PG8_STAGE(PG8_SB(1, 0), b3, voffB);
            PG8_BAR; PG8_WAIT_L(0); PG8_MMA(0, 1, At, B1); PG8_BAR;
            PG8_LDA(At, 1, 1); PG8_STAGE(PG8_SA(1, 0), a3, voffA);
            PG8_BAR; PG8_WAIT_L(0); PG8_MMA(1, 0, At, B0); PG8_BAR; PG8_SCHED;
            PG8_STAGE(PG8_SB(1, 1), b3 + hstep, voffB);
            PG8_WAIT_V(6); PG8_BAR; PG8_MMA(1, 1, At, B1); PG8_BAR;
            }
        }
        if constexpr (ALIGN_EPI) { if (wr == 0) PG8_BAR; }
        if constexpr (!Epi::AFTER_DRAIN) {
            if (cur.part < 0) E(acc, cur, wr, wc, fr, fq);
            else {
                const __amdgpu_buffer_rsrc_t rs = __builtin_amdgcn_make_buffer_rsrc((void*)((char*)sk_slab + ((size_t)cur.slot * 4 + cur.part) * (BM * BM * 2)), (short)0, BM * BM * 2, 0x00020000);
#pragma unroll
                for (int a = 0; a < 2; ++a)
#pragma unroll
                    for (int b = 0; b < 2; ++b)
#pragma unroll
                        for (int m = 0; m < 4; ++m) {
                            const f32x4 v0 = acc[a][b][m][0], v1 = acc[a][b][m][1];
                            u32x4 w; w.x = cvt_pk_bf16(v0[0], v0[1]); w.y = cvt_pk_bf16(v0[2], v0[3]); w.z = cvt_pk_bf16(v1[0], v1[1]); w.w = cvt_pk_bf16(v1[2], v1[3]);
                            __builtin_amdgcn_raw_buffer_store_b128(w, rs, tid * 16, (((a * 2 + b) * 4 + m) * 512) * 16, SK_AUX);
                        }
                asm volatile("s_waitcnt vmcnt(0)" ::: "memory");
                if (lane == 0) __hip_atomic_fetch_add(sk_cnt + 16 * cur.slot, 1u, __ATOMIC_RELAXED, __HIP_MEMORY_SCOPE_AGENT);
            }
            S.done(cur); }
        if (!has_next) break;
#pragma unroll
        for (int a = 0; a < 2; ++a)
#pragma unroll
            for (int b = 0; b < 2; ++b)
#pragma unroll
                for (int m = 0; m < 4; ++m)
#pragma unroll
                    for (int n = 0; n < 2; ++n) acc[a][b][m][n] = (f32x4){0.f, 0.f, 0.f, 0.f};
        cur = nxt; cA = nA; cB = nB; ++ui;
        if constexpr (ALIGN_EPI) { if (wr == 1) PG8_BAR; }
    }
    PG8_WAIT_V(0);
    if constexpr (!ALIGN_EPI) { if (wr == 0) PG8_BAR; }
    PG8_BAR;
    if constexpr (Epi::AFTER_DRAIN) { E.fused(acc, cur, wr, wc, fr, fq, lds, wid, lane); S.done(cur); }
    if constexpr (Epi::HAS_FRAG) {
        if (first.part >= 0) {
            if (wid == 0) {
                unsigned spins = 0;
                while ((unsigned)__builtin_amdgcn_readfirstlane(__hip_atomic_load(sk_cnt + 16 * first.slot, __ATOMIC_RELAXED, __HIP_MEMORY_SCOPE_AGENT)) < 32u) { __builtin_amdgcn_s_sleep(2); if (++spins > (1u << 22)) break; }
                __builtin_amdgcn_fence(__ATOMIC_ACQUIRE, "agent");
                asm volatile("s_waitcnt vmcnt(0)" ::: "memory");
            }
            asm volatile("" ::: "memory"); PG8_BAR; asm volatile("" ::: "memory");
            const __amdgpu_buffer_rsrc_t rs4 = __builtin_amdgcn_make_buffer_rsrc((void*)((char*)sk_slab + (size_t)first.slot * 4 * (BM * BM * 2)), (short)0, 4 * BM * BM * 2, 0x00020000);
            const int a = first.part >> 1, b = first.part & 1;
            u32x4 pv[4][4];
#pragma unroll
            for (int m = 0; m < 4; ++m)
#pragma unroll
                for (int q = 0; q < 4; ++q) pv[m][q] = __builtin_amdgcn_raw_buffer_load_b128(rs4, tid * 16, (((a * 2 + b) * 4 + m) * 512) * 16 + q * (BM * BM * 2), 0);
            __builtin_amdgcn_sched_barrier(0);
#pragma unroll
            for (int m = 0; m < 4; ++m) {
                f32x4 v0 = (f32x4){0.f, 0.f, 0.f, 0.f}, v1 = v0;
#pragma unroll
                for (int q = 0; q < 4; ++q) { const u32x4 w = pv[m][q];
                    v0 += (f32x4){__uint_as_float(w.x << 16), __uint_as_float(w.x & 0xffff0000u), __uint_as_float(w.y << 16), __uint_as_float(w.y & 0xffff0000u)};
                    v1 += (f32x4){__uint_as_float(w.z << 16), __uint_as_float(w.z & 0xffff0000u), __uint_as_float(w.w << 16), __uint_as_float(w.w & 0xffff0000u)}; }
                E.frag(v0, first, a, b, m, 0, wr, wc, fr, fq); E.frag(v1, first, a, b, m, 1, wr, wc, fr, fq);
            }
        }
    }
#undef PG8_SA
#undef PG8_SB
#undef PG8_STAGE
#undef PG8_LDA
#undef PG8_LDB
#undef PG8_MMA
#undef PG8_WAIT_V
#undef PG8_WAIT_L
#undef PG8_BAR
#undef PG8_SCHED
}
}
#define GAS __attribute__((address_space(1)))
#define LAS __attribute__((address_space(3)))
typedef float f32x4 __attribute__((ext_vector_type(4)));
typedef unsigned u32x2 __attribute__((ext_vector_type(2)));
typedef unsigned u32x4 __attribute__((ext_vector_type(4)));
constexpr int NWAVES = 8, NTHREADS = 512;
#define LDS_WAIT() asm volatile("s_waitcnt lgkmcnt(0)" ::: "memory")
#define VM_WAIT() asm volatile("s_waitcnt vmcnt(0)" ::: "memory")
constexpr int RING_BYTES = 145408;
constexpr int MISC_OFF = RING_BYTES + 320;
constexpr int LDS_BYTES = 147456;
#define XB_TMO      128
#define XB_XCNT(j)  (256  + 64 * (j))
#define XB_XSUB(j)  (1280 + 64 * (j))
#define XB_XGEN(j)  (2304 + 64 * (j))
#define XB_TOP      3328
#define XB_TOPGEN   3392
#define XCD_BAR_WORDS 3456
#define XB_SPIN_CAP (1u << 18)

__device__ __forceinline__ unsigned xb_ld(unsigned* p)              { return __hip_atomic_load(p, __ATOMIC_RELAXED, __HIP_MEMORY_SCOPE_AGENT); }
__device__ __forceinline__ unsigned xb_add(unsigned* p, unsigned v) { return __hip_atomic_fetch_add(p, v, __ATOMIC_RELAXED, __HIP_MEMORY_SCOPE_AGENT); }
__device__ __forceinline__ unsigned xb_xcc_id() { return (unsigned)__builtin_amdgcn_s_getreg((3 << 11) | 20) & 0xFu; }
#define XB_SPIN(cond, bar) do { unsigned _sp = 0; while (cond) { __builtin_amdgcn_s_sleep(1); \
    if ((++_sp & 255u) == 0u) { if (xb_ld(&(bar)[XB_TMO])) break; if (_sp > XB_SPIN_CAP) { atomicAdd(&(bar)[XB_TMO], 1u); break; } } } } while (0)

struct XcdBarrier {
    unsigned* bar; unsigned x;
    volatile LAS unsigned* st;
};

__device__ __forceinline__ XcdBarrier xcd_barrier_post(unsigned* bar, volatile LAS unsigned* st) {
    XcdBarrier b; b.bar = bar; b.x = xb_xcc_id(); b.st = st;
    if (threadIdx.x == 0) (void)xb_add(&bar[XB_XCNT(b.x)], 1u);
    return b;
}
__device__ __forceinline__ void xcd_barrier_complete(unsigned* bar, unsigned x, unsigned& nloc, unsigned& nx) {
    const unsigned G = gridDim.x * gridDim.y * gridDim.z;
    unsigned sum, cnt, mine, sp = 0u;
    for (;;) {
        sum = 0u; cnt = 0u; mine = 0u;
#pragma unroll
        for (unsigned j = 0; j < 16; ++j) { const unsigned c = xb_ld(&bar[XB_XCNT(j)]); sum += c; cnt += (c > 0u) ? 1u : 0u; mine = (j == x) ? c : mine; }
        if (sum == G) break;
        __builtin_amdgcn_s_sleep(1);
        if ((++sp & 255u) == 0u) { if (xb_ld(&bar[XB_TMO])) break; if (sp > XB_SPIN_CAP) { atomicAdd(&bar[XB_TMO], 1u); break; } }
    }
    nloc = mine > 0u ? mine : 1u; nx = cnt > 0u ? cnt : 1u;
}

__device__ __forceinline__ void xcd_barrier(const XcdBarrier& b) {
    asm volatile("s_waitcnt vmcnt(0)" ::: "memory");
    __syncthreads();
    if (threadIdx.x == 0) {
        unsigned* bar = b.bar;
        __builtin_amdgcn_s_waitcnt(0);
        unsigned nloc = b.st[0], nx = b.st[1];
        if (nloc == 0u) { xcd_barrier_complete(bar, b.x, nloc, nx); b.st[0] = nloc; b.st[1] = nx; }
        const unsigned old = xb_add(&bar[XB_XSUB(b.x)], 1u);
        const unsigned gen = old / nloc;
        if (old + 1u == (gen + 1u) * nloc) {
            __builtin_amdgcn_fence(__ATOMIC_RELEASE, "agent");
            asm volatile("s_waitcnt vmcnt(0)" ::: "memory");
            const unsigned og = xb_add(&bar[XB_TOP], 1u);
            const unsigned tg = og / nx;
            if (og + 1u == (tg + 1u) * nx) xb_add(&bar[XB_TOPGEN], 1u);
            else XB_SPIN(xb_ld(&bar[XB_TOPGEN]) == tg, bar);
            __builtin_amdgcn_fence(__ATOMIC_ACQUIRE, "agent");
            xb_add(&bar[XB_XGEN(b.x)], 1u);
            asm volatile("s_waitcnt vmcnt(0)" ::: "memory");
        } else {
            XB_SPIN(xb_ld(&bar[XB_XGEN(b.x)]) == gen, bar);
            __builtin_amdgcn_fence(__ATOMIC_ACQUIRE, "agent");
            asm volatile("s_waitcnt vmcnt(0)" ::: "memory");
        }
    }
    __syncthreads();
}
typedef short bf16x8 __attribute__((ext_vector_type(8)));
typedef short s16x4 __attribute__((ext_vector_type(4)));
typedef float f32x16 __attribute__((ext_vector_type(16)));
typedef float f32x2 __attribute__((ext_vector_type(2)));
typedef float f32x8v __attribute__((ext_vector_type(8)));
typedef __bf16 bfv2 __attribute__((ext_vector_type(2)));
constexpr float LOG2E = 1.4426950408889634f;
constexpr float QSCALE = SCALE * LOG2E;
constexpr int KS = 272, VS = 320;
constexpr int KTILE = 64 * KS, VTILE = 64 * VS;
constexpr int AT_K = 0, AT_V = 2 * KTILE, AT_FK = AT_V + 2 * VTILE, AT_REL = AT_FK + 512, AT_Q = AT_REL + 2064 + 48, AT_END = AT_Q + 16384;
static_assert(AT_END <= 131072 && AT_Q % 16 == 0, "attention LDS map");
constexpr int NSPLIT = 4;

__device__ __forceinline__ unsigned pkbf(float a, float b) { const f32x2 v = {a, b}; return __builtin_bit_cast(unsigned, __builtin_convertvector(v, bfv2)); }
__device__ __forceinline__ int off_b(int row, int ch) { return 256 * row + 16 * (ch ^ (((row & 3) << 2) | ((row >> 2) & 3))); }
__device__ __forceinline__ s16x4 tr_read4(const LAS unsigned char* p) { return __builtin_amdgcn_ds_read_tr16_b64_v4i16((LAS s16x4*)p); }
#define MFMA32(a, b, c) __builtin_amdgcn_mfma_f32_32x32x16_bf16((a), (b), (c), 0, 0, 0)

struct AttnCtx {
    const bf16_t* H; const float* ck; const float* cv;
    const float* F;
    const float* relb;
    bf16_t* O;
    float* PO; float* PM; float* PL;
};

struct TileRegs { f32x4 k0a, k0b, k1a, k1b, v0a, v0b, v1a, v1b; float fkr; };
struct TileGeo { int b, h, bh, kbase_row, kcol, vcol, tlast_new, ncache; };
template <int KIND>
__device__ __forceinline__ void tile_load1(f32x4& ka, f32x4& kb2, f32x4& va, f32x4& vb2, const AttnCtx& C, const TileGeo& G, int t, int c) {
    constexpr bool F32SRC = (KIND == 2 || KIND == 3);
    const int row = c >> 4, ch = c & 15;
    bool f32t = false;
    if constexpr (F32SRC) f32t = (t != G.tlast_new);
    if (f32t) {
        const size_t e = (((size_t)G.b * G.ncache + 64 * t + row) * NH + G.h) * HD + ch * 8;
        ka = *(const f32x4*)(C.ck + e); kb2 = *(const f32x4*)(C.ck + e + 4);
        va = *(const f32x4*)(C.cv + e); vb2 = *(const f32x4*)(C.cv + e + 4);
    } else {
        int hrow;
        if constexpr (KIND == 0 || KIND == 1) hrow = G.kbase_row + 64 * t + row; else hrow = TP + G.b * TS + row;
        const bf16_t* hp = C.H + (size_t)hrow * HP + ch * 8;
        ka = *(const f32x4*)(hp + G.kcol); va = *(const f32x4*)(hp + G.vcol);
    }
}
template <int KIND>
__device__ __forceinline__ void tile_load(TileRegs& TR, const AttnCtx& C, const TileGeo& G, int t, int tid) {
    constexpr bool FOX = (KIND == 0 || KIND == 3);
    tile_load1<KIND>(TR.k0a, TR.k0b, TR.v0a, TR.v0b, C, G, t, tid);
    tile_load1<KIND>(TR.k1a, TR.k1b, TR.v1a, TR.v1b, C, G, t, tid + 512);
    if constexpr (FOX) { if (tid < 64) TR.fkr = C.F[(size_t)G.bh * (KIND == 0 ? SEQ : PAST + TS) + 64 * t + tid]; }
}
template <int KIND, int KOFF = AT_K, int VOFF = AT_V>
__device__ __forceinline__ void tile_store1(const f32x4& ka, const f32x4& kb2, const f32x4& va, const f32x4& vb2, LAS unsigned char* lds, const TileGeo& G, int t, int buf, int c) {
    constexpr bool F32SRC = (KIND == 2 || KIND == 3);
    const int row = c >> 4, ch = c & 15;
    bool f32t = false;
    if constexpr (F32SRC) f32t = (t != G.tlast_new);
    u32x4 kc, vc;
    if (f32t) {
        kc.x = pkbf(ka.x, ka.y); kc.y = pkbf(ka.z, ka.w); kc.z = pkbf(kb2.x, kb2.y); kc.w = pkbf(kb2.z, kb2.w);
        vc.x = pkbf(va.x, va.y); vc.y = pkbf(va.z, va.w); vc.z = pkbf(vb2.x, vb2.y); vc.w = pkbf(vb2.z, vb2.w);
    } else { kc = __builtin_bit_cast(u32x4, ka); vc = __builtin_bit_cast(u32x4, va); }
    *(LAS u32x4*)(lds + KOFF + buf * KTILE + KS * row + 16 * ch) = kc; *(LAS u32x4*)(lds + VOFF + buf * VTILE + VS * row + 16 * ch) = vc;
}
template <int KIND, int KOFF = AT_K, int VOFF = AT_V, int FKOFF = AT_FK>
__device__ __forceinline__ void tile_store(const TileRegs& TR, LAS unsigned char* lds, const TileGeo& G, int t, int buf, int tid) {
    constexpr bool FOX = (KIND == 0 || KIND == 3);
    tile_store1<KIND, KOFF, VOFF>(TR.k0a, TR.k0b, TR.v0a, TR.v0b, lds, G, t, buf, tid);
    tile_store1<KIND, KOFF, VOFF>(TR.k1a, TR.k1b, TR.v1a, TR.v1b, lds, G, t, buf, tid + 512);
    if constexpr (FOX) { if (tid < 64) ((LAS float*)(lds + FKOFF))[buf * 64 + tid] = -LOG2E * TR.fkr; }
}
template <int KIND>
__device__ __forceinline__ void attn_item(LAS unsigned char* lds, const AttnCtx& C, int p0, int p1, int p2) {
    int tid_ = threadIdx.x; asm volatile("" : "+v"(tid_));
    const int tid = tid_, lane = tid & 63, wave = __builtin_amdgcn_readfirstlane(tid >> 6), lq = lane & 31, lh = lane >> 5;
    constexpr bool FOX = (KIND == 0 || KIND == 3), F32SRC = (KIND == 2 || KIND == 3);
    int b, h, bh = 0, t0, t1, qrow0, kbase_row = 0;
    if constexpr (KIND == 0) { bh = p0; b = bh >> 2; h = bh & 3; t0 = 0; t1 = 4 * p1 + 4; qrow0 = b * SEQ + 256 * p1 + 32 * wave; kbase_row = b * SEQ; }
    else if constexpr (KIND == 1) { b = p0; h = p2; t0 = (8 - 4 * p1) > 0 ? (8 - 4 * p1) : 0; t1 = 12; qrow0 = b * SEQ + 256 * p1 + 32 * wave; kbase_row = b * SEQ + 64 * (4 * p1 - 8); }
    else if constexpr (KIND == 2) { b = p0; h = p1; t0 = 0; t1 = 9; qrow0 = TP + b * TS + 32 * (wave & 1); }
    else { bh = p0; b = bh >> 2; h = bh & 3; t0 = 16 * p1; t1 = 16 * p1 + 16 + (p1 == NSPLIT - 1 ? 1 : 0); qrow0 = TP + b * TS + 32 * (wave & 1); }
    const int qcol = (FOX ? C_CQ : C_BQ) + h * HD, kcol = (FOX ? C_CK : C_BK) + h * HD, vcol = (FOX ? C_CV : C_BV) + h * HD;
    const bool qwave = (KIND <= 1) ? true : (wave < 2);
    const int tlast_new = (KIND == 2) ? 8 : 64;
    const int ncache = (KIND == 2) ? BAND : PAST;
    constexpr bool QLDS = (KIND >= 2);
    bf16x8 qf[QLDS ? 1 : 8];
    if (qwave) {
        const bf16_t* qp = C.H + (size_t)(qrow0 + lq) * HP + qcol + 8 * lh;
#pragma unroll
        for (int s = 0; s < 8; ++s) {
            const u32x4 raw = *(const u32x4*)(qp + 16 * s);
            u32x4 o; o.x = pkbf(bflo(raw.x) * QSCALE, bfhi(raw.x) * QSCALE); o.y = pkbf(bflo(raw.y) * QSCALE, bfhi(raw.y) * QSCALE);
            o.z = pkbf(bflo(raw.z) * QSCALE, bfhi(raw.z) * QSCALE); o.w = pkbf(bflo(raw.w) * QSCALE, bfhi(raw.w) * QSCALE);
            if constexpr (QLDS) *(LAS u32x4*)(lds + AT_Q + (wave & 1) * 8192 + s * 1024 + lane * 16) = o;
            else qf[s] = __builtin_bit_cast(bf16x8, o);
        }
    } else if constexpr (!QLDS) {
#pragma unroll
        for (int s = 0; s < 8; ++s) qf[s] = (bf16x8){0, 0, 0, 0, 0, 0, 0, 0};
    }
    const LAS unsigned char* Qb = lds + AT_Q + (wave & 1) * 8192 + lane * 16;
    if constexpr (!FOX) { LAS float* rel = (LAS float*)(lds + AT_REL); for (int i = tid; i < NREL; i += NTHREADS) rel[i] = C.relb[h * NREL + i] * LOG2E; }
    TileRegs TR; TR.fkr = 0.f; TR.k0b = TR.k1b = TR.v0b = TR.v1b = (f32x4){0.f, 0.f, 0.f, 0.f};
    constexpr bool DEEP = false && (KIND <= 1);
    TileRegs TR2; TR2.fkr = 0.f; TR2.k0a = TR2.k1a = TR2.v0a = TR2.v1a = TR2.k0b = TR2.k1b = TR2.v0b = TR2.v1b = (f32x4){0.f, 0.f, 0.f, 0.f};
    const TileGeo TG{b, h, bh, kbase_row, kcol, vcol, tlast_new, ncache};
#define load_tile(t) tile_load<KIND>(TR, C, TG, (t), tid)
#define store_tile(t, buf) tile_store<KIND>(TR, lds, TG, (t), (buf), tid)
#define load_tile2(t) tile_load<KIND>(TR2, C, TG, (t), tid)
#define store_tile2(t, buf) tile_store<KIND>(TR2, lds, TG, (t), (buf), tid)
    f32x16 oacc[4];
#pragma unroll
    for (int c = 0; c < 4; ++c)
#pragma unroll
        for (int r = 0; r < 16; ++r) oacc[c][r] = 0.f;
    float m_run = -1e30f, l_run = 0.f;
    const int wh = (KIND <= 1) ? (wave >> 1) : 0;
    const int qi = 32 * (wave & 1) + lq;
    const int q4 = (lane & 15) >> 2, p4 = lane & 3, blk = (lane >> 4) & 1;

    const int kofs0 = AT_K + KS * lq + 16 * lh;
    const int vofs0 = AT_V + VS * (4 * lh + q4) + 32 * blk + 8 * p4;
    load_tile(t0); store_tile(t0, 0);
    if (DEEP && t0 + 1 < t1) load_tile2(t0 + 1);
    __syncthreads();
#pragma unroll 2
    for (int st_ = 0; st_ < t1 - t0; ++st_) {
        const int t = t0 + st_;
        const int buf = st_ & 1;
        if constexpr (DEEP) { if (t + 2 < t1) { if (buf) load_tile2(t + 2); else load_tile(t + 2); } }
        else { if (t + 1 < t1) load_tile(t + 1); }
        bool active;
        if constexpr (KIND == 0) active = (t <= 4 * p1 + wh);
        else if constexpr (KIND == 1) active = (wh <= t) && (t <= wh + 8);
        else active = (wave < 2);
        if (active) {
            const LAS unsigned char* Kb = lds + kofs0 + buf * KTILE; const LAS unsigned char* Vb = lds + vofs0 + buf * VTILE;
            f32x16 sacc[2];
#pragma unroll
            for (int r = 0; r < 16; ++r) { sacc[0][r] = 0.f; sacc[1][r] = 0.f; }
            if constexpr (!QLDS) {
                constexpr int KR = 4;
                bf16x8 kf[KR];
#pragma unroll
                for (int s = 0; s < KR; ++s) kf[s] = *(const LAS bf16x8*)(Kb + 32 * s);
#pragma unroll
                for (int s = 0; s < 16; ++s) {
                    const int kb = s >> 3, ss = s & 7;
                    sacc[kb] = MFMA32(kf[s % KR], qf[ss], sacc[kb]);
                    if (s + KR < 16) kf[s % KR] = *(const LAS bf16x8*)(Kb + 32 * ((s + KR) & 7) + 32 * KS * ((s + KR) >> 3));
                }
            } else {
#pragma unroll
                for (int s = 0; s < 8; ++s) {
                    const bf16x8 q = *(const LAS bf16x8*)(Qb + 1024 * s);
                    const bf16x8 k0 = *(const LAS bf16x8*)(Kb + 32 * s), k1 = *(const LAS bf16x8*)(Kb + 32 * s + 32 * KS);
                    sacc[0] = MFMA32(k0, q, sacc[0]); sacc[1] = MFMA32(k1, q, sacc[1]);
                }
            }
            s16x4 vlo[4], vhi[4];
#define AT_VREAD(kb_, s2_) do { _Pragma("unroll") for (int c = 0; c < 4; ++c) { \
                vlo[c] = tr_read4(Vb + VS * (32 * (kb_) + 16 * (s2_)) + 64 * c); vhi[c] = tr_read4(Vb + VS * (32 * (kb_) + 16 * (s2_) + 8) + 64 * c); } } while (0)
            AT_VREAD(0, 0);
            if constexpr (FOX) {
                const LAS float* fk = (const LAS float*)(lds + AT_FK) + buf * 64;
                bool need_mask;
                if constexpr (KIND == 0) need_mask = (t == 4 * p1 + wh); else need_mask = (t == tlast_new);
#pragma unroll
                for (int kb = 0; kb < 2; ++kb) {
                    { const f32x4 fa = *(const LAS f32x4*)(fk + 32 * kb + 4 * lh), fb = *(const LAS f32x4*)(fk + 32 * kb + 8 + 4 * lh), fc = *(const LAS f32x4*)(fk + 32 * kb + 16 + 4 * lh), fd = *(const LAS f32x4*)(fk + 32 * kb + 24 + 4 * lh);
                      sacc[kb] += __builtin_shufflevector(__builtin_shufflevector(fa, fb, 0, 1, 2, 3, 4, 5, 6, 7), __builtin_shufflevector(fc, fd, 0, 1, 2, 3, 4, 5, 6, 7), 0, 1, 2, 3, 4, 5, 6, 7, 8, 9, 10, 11, 12, 13, 14, 15); }
                    __builtin_amdgcn_sched_barrier(0);
                }
                if (need_mask) {
                    asm volatile("" ::: "memory");
#pragma unroll
                    for (int kb = 0; kb < 2; ++kb)
#pragma unroll
                        for (int r = 0; r < 16; ++r) { const int key = 32 * kb + 8 * (r >> 2) + 4 * lh + (r & 3); if (key > qi) sacc[kb][r] = -__builtin_inff(); }
                }
            } else {
                const LAS float* rel = (const LAS float*)(lds + AT_REL);
                const int dchunk = wh + 8 - t;
                if (dchunk >= 5) {
                    const float cb = rel[512];
#pragma unroll
                    for (int kb = 0; kb < 2; ++kb)
#pragma unroll
                        for (int r = 0; r < 16; ++r) sacc[kb][r] += cb;
                } else {
                    const int d0 = 64 * dchunk + qi - 4 * lh;
#pragma unroll
                    for (int kb = 0; kb < 2; ++kb)
#pragma unroll
                        for (int r = 0; r < 16; ++r) {
                            int idx = d0 - (32 * kb + 8 * (r >> 2) + (r & 3));
                            idx = idx < -256 ? -256 : (idx > 256 ? 256 : idx);
                            sacc[kb][r] += rel[idx + 256];
                        }
                }
            }
            float mx = sacc[0][0];
#pragma unroll
            for (int kb = 0; kb < 2; ++kb)
#pragma unroll
                for (int r = 0; r < 16; ++r) mx = fmaxf(mx, sacc[kb][r]);
            mx = fmaxf(mx, xshfl32(mx, lane));
            const float m_new = fmaxf(m_run, mx);
            if (__any(m_new > m_run)) {
                const float corr = __builtin_amdgcn_exp2f(m_run - m_new);
                l_run *= corr;
#pragma unroll
                for (int c = 0; c < 4; ++c)
#pragma unroll
                    for (int r = 0; r < 16; ++r) oacc[c][r] *= corr;
            }
            m_run = m_new;
            sacc[0] -= m_new; sacc[1] -= m_new;
#pragma unroll
            for (int kb = 0; kb < 2; ++kb)
#pragma unroll
                for (int r = 0; r < 16; ++r) sacc[kb][r] = __builtin_amdgcn_exp2f(sacc[kb][r]);
            float ps;
            { const f32x16 t16 = sacc[0] + sacc[1];
              const f32x8v t8 = __builtin_shufflevector(t16, t16, 0, 1, 2, 3, 4, 5, 6, 7) + __builtin_shufflevector(t16, t16, 8, 9, 10, 11, 12, 13, 14, 15);
              const f32x4 t4 = __builtin_shufflevector(t8, t8, 0, 1, 2, 3) + __builtin_shufflevector(t8, t8, 4, 5, 6, 7);
              ps = (t4.x + t4.y) + (t4.z + t4.w); }
            ps += xshfl32(ps, lane);
            l_run += ps;
#pragma unroll
            for (int kk = 0; kk < 4; ++kk) {
                const int kb = kk >> 1, s2 = kk & 1;
                u32x4 pw; pw.x = pkbf(sacc[kb][8 * s2 + 0], sacc[kb][8 * s2 + 1]); pw.y = pkbf(sacc[kb][8 * s2 + 2], sacc[kb][8 * s2 + 3]);
                pw.z = pkbf(sacc[kb][8 * s2 + 4], sacc[kb][8 * s2 + 5]); pw.w = pkbf(sacc[kb][8 * s2 + 6], sacc[kb][8 * s2 + 7]);
                const bf16x8 pf = __builtin_bit_cast(bf16x8, pw);
#pragma unroll
                for (int c = 0; c < 4; ++c) oacc[c] = MFMA32(__builtin_shufflevector(vlo[c], vhi[c], 0, 1, 2, 3, 4, 5, 6, 7), pf, oacc[c]);
                if (kk < 3) { AT_VREAD((kk + 1) >> 1, (kk + 1) & 1); }
            }
#undef AT_VREAD
        }
        if constexpr (DEEP) { if (t + 1 < t1) { if (buf) store_tile(t + 1, 0); else store_tile2(t + 1, 1); } }
        else { if (t + 1 < t1) store_tile(t + 1, buf ^ 1); }
        __syncthreads();
    }
    if (qwave) {
        if constexpr (KIND == 3) {
            const size_t pr = ((size_t)bh * NSPLIT + p1) * TS + qi;
#pragma unroll
            for (int c = 0; c < 4; ++c)
#pragma unroll
                for (int g = 0; g < 4; ++g) { const f32x4 v = {oacc[c][4 * g], oacc[c][4 * g + 1], oacc[c][4 * g + 2], oacc[c][4 * g + 3]}; *(f32x4*)(C.PO + pr * HD + 32 * c + 8 * g + 4 * lh) = v; }
            if (lh == 0) { C.PM[pr] = m_run; C.PL[pr] = l_run; }
        } else {
            const float inv = 1.f / l_run;
            bf16_t* op = C.O + (size_t)(qrow0 + lq) * DB + h * HD + 4 * lh;
#pragma unroll
            for (int c = 0; c < 4; ++c)
#pragma unroll
                for (int g = 0; g < 4; ++g) { u32x2 w; w.x = pkbf(oacc[c][4 * g] * inv, oacc[c][4 * g + 1] * inv); w.y = pkbf(oacc[c][4 * g + 2] * inv, oacc[c][4 * g + 3] * inv); *(u32x2*)(op + 32 * c + 8 * g) = w; }
        }
    }
}
#undef load_tile
#undef store_tile
#undef load_tile2
#undef store_tile2


__device__ __forceinline__ void fox_combine_row(const float* PO, const float* PM, const float* PL, float* OC, int idx, int lane) {
    const int bh = idx >> 6, qi = idx & 63, b = bh >> 2, h = bh & 3;
    float m = -1e30f;
#pragma unroll
    for (int s = 0; s < NSPLIT; ++s) m = fmaxf(m, PM[((size_t)bh * NSPLIT + s) * TS + qi]);
    float l = 0.f, o0 = 0.f, o1 = 0.f;
#pragma unroll
    for (int s = 0; s < NSPLIT; ++s) {
        const size_t pr = ((size_t)bh * NSPLIT + s) * TS + qi;
        const float w = __builtin_amdgcn_exp2f(PM[pr] - m);
        l += PL[pr] * w; o0 += PO[pr * HD + lane] * w; o1 += PO[pr * HD + lane + 64] * w;
    }
    const float inv = 1.f / l;
    float* op = OC + (size_t)(TP + b * TS + qi) * DB + h * HD;
    op[lane] = o0 * inv; op[lane + 64] = o1 * inv;
}

constexpr int FS_K = 0, FS_V = 3 * KTILE, FS_FK = FS_V + 3 * VTILE, FS_Q = FS_FK + 768, FS_END = FS_Q + 16384;
static_assert(FS_END <= RING_BYTES && FS_Q % 16 == 0, "fox-sample LDS map");
#define FS_BAR() do { asm volatile("s_waitcnt lgkmcnt(0)" ::: "memory"); __builtin_amdgcn_s_barrier(); asm volatile("" ::: "memory"); } while (0)

__device__ __forceinline__ void fox_sample_item(LAS unsigned char* lds, const AttnCtx& C, int bh, int sp) {
    int tid_ = threadIdx.x; asm volatile("" : "+v"(tid_));
    const int tid = tid_, lane = tid & 63, wave = __builtin_amdgcn_readfirstlane(tid >> 6);
    const int b = bh >> 2, h = bh & 3, t0 = 16 * sp;
    const bool has_new = (sp == NSPLIT - 1);
    const int nsteps = 16 + (has_new ? 1 : 0);
    if (wave >= 2) {
        const int ltid = tid - 128;
        const float* kbase = C.ck + (((size_t)b * PAST) * NH + h) * HD; const float* vbase = C.cv + (((size_t)b * PAST) * NH + h) * HD;
        const bool six = ltid < 128;
        constexpr int FD = 3;
        f32x4 R[FD][12]; float fk[FD];
#define FS_LOAD(SET, T) do { _Pragma("unroll") for (int i = 0; i < 6; ++i) { if (i < 5 || six) { const int it = ltid + 384 * i, isv = it >> 10, ii = it & 1023, row = ii >> 4, ch = ii & 15; \
            const float* src = (isv ? vbase : kbase) + ((size_t)(64 * (T) + row) * NH) * HD + 8 * ch; R[SET][2 * i] = *(const f32x4*)src; R[SET][2 * i + 1] = *(const f32x4*)(src + 4); } } \
            if (ltid < 64) fk[SET] = C.F[(size_t)bh * (PAST + TS) + 64 * (T) + ltid]; } while (0)
#define FS_STORE(SET, BUF) do { _Pragma("unroll") for (int i = 0; i < 6; ++i) { if (i < 5 || six) { const int it = ltid + 384 * i, isv = it >> 10, ii = it & 1023, row = ii >> 4, ch = ii & 15; \
            const f32x4 a = R[SET][2 * i], c4 = R[SET][2 * i + 1]; u32x4 w; w.x = pkbf(a.x, a.y); w.y = pkbf(a.z, a.w); w.z = pkbf(c4.x, c4.y); w.w = pkbf(c4.z, c4.w); \
            if (isv) *(LAS u32x4*)(lds + FS_V + (BUF) * VTILE + VS * row + 16 * ch) = w; else *(LAS u32x4*)(lds + FS_K + (BUF) * KTILE + KS * row + 16 * ch) = w; } } \
            if (ltid < 64) ((LAS float*)(lds + FS_FK))[(BUF) * 64 + ltid] = -LOG2E * fk[SET]; } while (0)
#pragma unroll
        for (int d = 0; d < FD; ++d) FS_LOAD(d, t0 + d);
#pragma unroll
        for (int s = 0; s < 16; ++s) {
            FS_STORE(s % FD, s % 3);
            if (s + FD < 16) FS_LOAD(s % FD, t0 + s + FD);
            FS_BAR();
        }
#undef FS_LOAD
#undef FS_STORE
        if (has_new) {
            for (int it = ltid; it < 2048; it += 384) {
                const int isv = it >> 10, ii = it & 1023, row = ii >> 4, ch = ii & 15;
                const u32x4 w = *(const u32x4*)(C.H + (size_t)(TP + b * TS + row) * HP + (isv ? C_CV : C_CK) + h * HD + 8 * ch);
                if (isv) *(LAS u32x4*)(lds + FS_V + 1 * VTILE + VS * row + 16 * ch) = w; else *(LAS u32x4*)(lds + FS_K + 1 * KTILE + KS * row + 16 * ch) = w;
            }
            if (ltid < 64) ((LAS float*)(lds + FS_FK))[1 * 64 + ltid] = -LOG2E * C.F[(size_t)bh * (PAST + TS) + PAST + ltid];
            FS_BAR();
        }
    } else {
        const int lq = lane & 31, lh = lane >> 5, qi = 32 * wave + lq;
        const int q4 = (lane & 15) >> 2, p4 = lane & 3, blk = (lane >> 4) & 1;
        {
            const bf16_t* qp = C.H + (size_t)(TP + b * TS + qi) * HP + C_CQ + h * HD + 8 * lh;
#pragma unroll
            for (int s = 0; s < 8; ++s) {
                const u32x4 raw = *(const u32x4*)(qp + 16 * s);
                u32x4 o; o.x = pkbf(bflo(raw.x) * QSCALE, bfhi(raw.x) * QSCALE); o.y = pkbf(bflo(raw.y) * QSCALE, bfhi(raw.y) * QSCALE);
                o.z = pkbf(bflo(raw.z) * QSCALE, bfhi(raw.z) * QSCALE); o.w = pkbf(bflo(raw.w) * QSCALE, bfhi(raw.w) * QSCALE);
                *(LAS u32x4*)(lds + FS_Q + wave * 8192 + s * 1024 + lane * 16) = o;
            }
        }
        const LAS unsigned char* Qb = lds + FS_Q + wave * 8192 + lane * 16;
        const int kofs0 = FS_K + KS * lq + 16 * lh, vofs0 = FS_V + VS * (4 * lh + q4) + 32 * blk + 8 * p4;
        f32x16 oacc[4];
#pragma unroll
        for (int c = 0; c < 4; ++c)
#pragma unroll
            for (int r = 0; r < 16; ++r) oacc[c][r] = 0.f;
        float m_run = -1e30f, l_run = 0.f;
        for (int s = 0; s < nsteps; ++s) {
            FS_BAR();
            const int buf = s % 3;
            const LAS unsigned char* Kb = lds + kofs0 + buf * KTILE; const LAS unsigned char* Vb = lds + vofs0 + buf * VTILE;
            f32x16 sacc[2];
#pragma unroll
            for (int r = 0; r < 16; ++r) { sacc[0][r] = 0.f; sacc[1][r] = 0.f; }
#pragma unroll
            for (int ss = 0; ss < 8; ++ss) {
                const bf16x8 q = *(const LAS bf16x8*)(Qb + 1024 * ss);
                const bf16x8 k0 = *(const LAS bf16x8*)(Kb + 32 * ss), k1 = *(const LAS bf16x8*)(Kb + 32 * ss + 32 * KS);
                sacc[0] = MFMA32(k0, q, sacc[0]); sacc[1] = MFMA32(k1, q, sacc[1]);
            }
            s16x4 vlo[4], vhi[4];
#define FS_VREAD(kb_, s2_) do { _Pragma("unroll") for (int c = 0; c < 4; ++c) { \
                vlo[c] = tr_read4(Vb + VS * (32 * (kb_) + 16 * (s2_)) + 64 * c); vhi[c] = tr_read4(Vb + VS * (32 * (kb_) + 16 * (s2_) + 8) + 64 * c); } } while (0)
            FS_VREAD(0, 0);
            {
                const LAS float* fkp = (const LAS float*)(lds + FS_FK) + buf * 64;
#pragma unroll
                for (int kb = 0; kb < 2; ++kb) {
                    { const f32x4 fa = *(const LAS f32x4*)(fkp + 32 * kb + 4 * lh), fb = *(const LAS f32x4*)(fkp + 32 * kb + 8 + 4 * lh), fc = *(const LAS f32x4*)(fkp + 32 * kb + 16 + 4 * lh), fd = *(const LAS f32x4*)(fkp + 32 * kb + 24 + 4 * lh);
                      sacc[kb] += __builtin_shufflevector(__builtin_shufflevector(fa, fb, 0, 1, 2, 3, 4, 5, 6, 7), __builtin_shufflevector(fc, fd, 0, 1, 2, 3, 4, 5, 6, 7), 0, 1, 2, 3, 4, 5, 6, 7, 8, 9, 10, 11, 12, 13, 14, 15); }
                    __builtin_amdgcn_sched_barrier(0);
                }
                if (s == 16) {
                    asm volatile("" ::: "memory");
#pragma unroll
                    for (int kb = 0; kb < 2; ++kb)
#pragma unroll
                        for (int r = 0; r < 16; ++r) { const int key = 32 * kb + 8 * (r >> 2) + 4 * lh + (r & 3); if (key > qi) sacc[kb][r] = -__builtin_inff(); }
                }
            }
            float mx = sacc[0][0];
#pragma unroll
            for (int kb = 0; kb < 2; ++kb)
#pragma unroll
                for (int r = 0; r < 16; ++r) mx = fmaxf(mx, sacc[kb][r]);
            mx = fmaxf(mx, xshfl32(mx, lane));
            const float m_new = fmaxf(m_run, mx);
            if (__any(m_new > m_run)) {
                const float corr = __builtin_amdgcn_exp2f(m_run - m_new);
                l_run *= corr;
#pragma unroll
                for (int c = 0; c < 4; ++c)
#pragma unroll
                    for (int r = 0; r < 16; ++r) oacc[c][r] *= corr;
            }
            m_run = m_new;
            sacc[0] -= m_new; sacc[1] -= m_new;
#pragma unroll
            for (int kb = 0; kb < 2; ++kb)
#pragma unroll
                for (int r = 0; r < 16; ++r) sacc[kb][r] = __builtin_amdgcn_exp2f(sacc[kb][r]);
            float ps;
            { const f32x16 t16 = sacc[0] + sacc[1];
              const f32x8v t8 = __builtin_shufflevector(t16, t16, 0, 1, 2, 3, 4, 5, 6, 7) + __builtin_shufflevector(t16, t16, 8, 9, 10, 11, 12, 13, 14, 15);
              const f32x4 t4 = __builtin_shufflevector(t8, t8, 0, 1, 2, 3) + __builtin_shufflevector(t8, t8, 4, 5, 6, 7);
              ps = (t4.x + t4.y) + (t4.z + t4.w); }
            ps += xshfl32(ps, lane);
            l_run += ps;
#pragma unroll
            for (int kk = 0; kk < 4; ++kk) {
                const int kb = kk >> 1, s2 = kk & 1;
                u32x4 pw; pw.x = pkbf(sacc[kb][8 * s2 + 0], sacc[kb][8 * s2 + 1]); pw.y = pkbf(sacc[kb][8 * s2 + 2], sacc[kb][8 * s2 + 3]);
                pw.z = pkbf(sacc[kb][8 * s2 + 4], sacc[kb][8 * s2 + 5]); pw.w = pkbf(sacc[kb][8 * s2 + 6], sacc[kb][8 * s2 + 7]);
                const bf16x8 pf = __builtin_bit_cast(bf16x8, pw);
#pragma unroll
                for (int c = 0; c < 4; ++c) oacc[c] = MFMA32(__builtin_shufflevector(vlo[c], vhi[c], 0, 1, 2, 3, 4, 5, 6, 7), pf, oacc[c]);
                if (kk < 3) { FS_VREAD((kk + 1) >> 1, (kk + 1) & 1); }
            }
#undef FS_VREAD
        }
        const size_t pr = ((size_t)bh * NSPLIT + sp) * TS + qi;
#pragma unroll
        for (int c = 0; c < 4; ++c)
#pragma unroll
            for (int g = 0; g < 4; ++g) { const f32x4 v = {oacc[c][4 * g], oacc[c][4 * g + 1], oacc[c][4 * g + 2], oacc[c][4 * g + 3]}; *(f32x4*)(C.PO + pr * HD + 32 * c + 8 * g + 4 * lh) = v; }
        if (lh == 0) { C.PM[pr] = m_run; C.PL[pr] = l_run; }
    }
}
constexpr int LR_XCF = 0  , LR_XCB = 32768, LR_A = 49152, LR_AG = 81920  ,
              LR_QS = 98304, LR_SS = 102400, LR_H0 = 102912, LR_CW = 107008  , LR_GC = 127488  , LR_GM = 139776  , LR_END = 143872;
static_assert(LR_END <= RING_BYTES, "lru LDS map");
constexpr bool LRU_STREAM = false;
struct LruCtx { const bf16_t* H; const float* sconv; const float* slru; const float* wconv; const float* bconv; const bf16_t* WgT; const float* bra; const float* brx; const float* lam;
                const float* gm; float* SA; float* SH; bf16_t* Y; float* out; int l; int nb; int pf; const bf16_t* OB; const bf16_t* OC; float* AG_; bf16_t* UG_; };

__device__ __forceinline__ float fast_sigmoid(float x) { return __builtin_amdgcn_rcpf(1.f + __builtin_amdgcn_exp2f(-1.4426950408889634f * x)); }
__device__ __forceinline__ float fast_gelu_tanh(float x) {
    const float z2 = 1.5957691216057308f * (x + 0.044715f * x * x * x);
    return x * __builtin_amdgcn_rcpf(1.f + __builtin_amdgcn_exp2f(-1.4426950408889634f * z2));
}
__device__ __forceinline__ float fast_gelu_tanh2(float x) {
    constexpr float c1 = -1.4426950408889634f * 1.5957691216057308f, c2 = c1 * 0.044715f;
    return x * __builtin_amdgcn_rcpf(1.f + __builtin_amdgcn_exp2f(x * (c2 * (x * x) + c1)));
}
__device__ __forceinline__ float one_minus_exp(float x, float ehalf  ) {
    const float big = 1.f - ehalf * ehalf;
    const float small = -x * (1.f + x * (0.5f + x * (0.16666667f + x * (0.041666668f + x * 0.0083333338f))));
    return (x > -0.25f) ? small : big;
}

struct LruRows { u32x4 r[4][2]; u32x4 ag[2]; };

template <bool PASS2>
__device__ __forceinline__ void lru_fetch(u32x4 (&r)[4][2], u32x4 (&ag)[2], const LruCtx& C, bool prm, int b, int c, int row0, int n, int t, int cg) {
    const int col = n * HD + 16 * cg;
#pragma unroll
    for (int j = 0; j < 4; ++j) {
        const int tt = t + j - 3, tpos = (prm ? 64 * c : 0) + tt;
        if (tpos >= 0) { const bf16_t* hp = C.H + (size_t)(row0 + tt) * HP + C_AX + col; r[j][0] = *(const u32x4*)hp; r[j][1] = *(const u32x4*)(hp + 8); }
        else { r[j][0] = (u32x4){0u, 0u, 0u, 0u}; r[j][1] = (u32x4){0u, 0u, 0u, 0u}; }
    }
    if constexpr (PASS2) { const bf16_t* gp = C.H + (size_t)(row0 + t) * HP + C_AG + col; ag[0] = *(const u32x4*)gp; ag[1] = *(const u32x4*)(gp + 8); }
}

template <bool PASS2>
__device__ __forceinline__ void lru_item(LAS unsigned char* lds, const LruCtx& C, int chunk) {
    int tid_ = threadIdx.x; asm volatile("" : "+v"(tid_));
    const int tid = tid_, lane = tid & 63, wave = __builtin_amdgcn_readfirstlane(tid >> 6);
    const bool prm = chunk < 256; const int b = prm ? (chunk >> 6) : (chunk - 256), c = prm ? (chunk & 63) : 0;
    const int row0 = prm ? b * SEQ + 64 * c : TP + b * TS;
    LAS float* XCF = (LAS float*)(lds + LR_XCF); LAS unsigned char* XCB = lds + LR_XCB; LAS float* AA = (LAS float*)(lds + LR_A); LAS float* UU = XCF;
    LAS float* QS = (LAS float*)(lds + LR_QS); LAS float* SS = (LAS float*)(lds + LR_SS); LAS float* H0 = (LAS float*)(lds + LR_H0); LAS bf16_t* AG = (LAS bf16_t*)(lds + LR_AG); LAS float* CW = (LAS float*)(lds + LR_CW); LAS float* GC = (LAS float*)(lds + LR_GC);
    const int st_ = tid >> 3, scg_ = tid & 7;
    u32x4 rr[4][2], rag[2];
    lru_fetch<PASS2>(rr, rag, C, prm, b, c, row0, 0, st_, scg_);
#pragma unroll
    for (int i = 0; i < 2; ++i) {
        const int ch = tid + 512 * i;
        CW[ch] = C.bconv[ch];
#pragma unroll
        for (int j = 0; j < 4; ++j) CW[(1 + j) * DA + ch] = C.wconv[(size_t)j * DA + ch];
        GC[ch] = C.bra[ch]; GC[DA + ch] = C.brx[ch]; GC[2 * DA + ch] = log1pf(expf(-C.lam[ch]));
        if constexpr (PASS2) ((LAS float*)(lds + LR_GM))[ch] = C.gm[ch];
    }
    if constexpr (PASS2) {
#pragma unroll
        for (int i = 0; i < 2; ++i) {
            const int ch = tid + 512 * i; float h;
            if (prm && !(C.pf & 1)) { h = 0.f; const float* sa = C.SA + (size_t)b * 64 * DA + ch; const float* sh = C.SH + (size_t)b * 64 * DA + ch;
                for (int j0 = 0; j0 < c; j0 += 16) {
                    float av[16], hv[16];
#pragma unroll
                    for (int k = 0; k < 16; ++k) { av[k] = sa[(size_t)(j0 + k) * DA]; hv[k] = sh[(size_t)(j0 + k) * DA]; }
#pragma unroll
                    for (int k = 0; k < 16; ++k) if (j0 + k < c) h = av[k] * h + hv[k];
                } }
            else h = prm ? 0.f : C.slru[(size_t)b * DA + ch];
            H0[ch] = h;
        }
        if (tid < 64) SS[tid] = 0.f;
    }
    __syncthreads();
    for (int n = 0; n < C.nb; ++n) {
        u32x4 wq0[8], wq1[8];
        { int ln = lane; asm volatile("" : "+v"(ln));
          const int ch = 32 * (wave >> 1) + (ln & 31);
          const bf16_t* b0p = C.WgT + ((size_t)(0 * 8 + n) * HD + ch) * HD + 8 * (ln >> 5); const bf16_t* b1p = C.WgT + ((size_t)(1 * 8 + n) * HD + ch) * HD + 8 * (ln >> 5);
#pragma unroll
          for (int s = 0; s < 8; ++s) { wq0[s] = *(const u32x4*)(b0p + 16 * s); wq1[s] = *(const u32x4*)(b1p + 16 * s); } }
        {
            int st = st_, scg = scg_; asm volatile("" : "+v"(st), "+v"(scg));
            const int col = n * HD + 16 * scg;
            f32x4 acc[4];
#pragma unroll
            for (int k = 0; k < 4; ++k) acc[k] = *(const LAS f32x4*)(CW + col + 4 * k);
#pragma unroll
            for (int j = 0; j < 4; ++j) {
                const int tpos = (prm ? 64 * c : 0) + st + j - 3;
                f32x4 x[4];
                if (tpos >= 0 || prm) {
                    const u32x4 r0 = rr[j][0], r1 = rr[j][1];
                    x[0] = (f32x4){bflo(r0.x), bfhi(r0.x), bflo(r0.y), bfhi(r0.y)}; x[1] = (f32x4){bflo(r0.z), bfhi(r0.z), bflo(r0.w), bfhi(r0.w)};
                    x[2] = (f32x4){bflo(r1.x), bfhi(r1.x), bflo(r1.y), bfhi(r1.y)}; x[3] = (f32x4){bflo(r1.z), bfhi(r1.z), bflo(r1.w), bfhi(r1.w)};
                } else {
                    const float* sp = C.sconv + ((size_t)b * 3 + (tpos + 3)) * DA + col;
#pragma unroll
                    for (int k = 0; k < 4; ++k) x[k] = *(const f32x4*)(sp + 4 * k);
                }
#pragma unroll
                for (int k = 0; k < 4; ++k) { const f32x4 w = *(const LAS f32x4*)(CW + (1 + j) * DA + col + 4 * k); acc[k] += w * x[k]; }
            }
#pragma unroll
            for (int k = 0; k < 4; ++k) *(LAS f32x4*)(XCF + st * HD + 16 * scg + 4 * k) = acc[k];
            u32x4 w0, w1;
            w0.x = pkbf(acc[0].x, acc[0].y); w0.y = pkbf(acc[0].z, acc[0].w); w0.z = pkbf(acc[1].x, acc[1].y); w0.w = pkbf(acc[1].z, acc[1].w);
            w1.x = pkbf(acc[2].x, acc[2].y); w1.y = pkbf(acc[2].z, acc[2].w); w1.z = pkbf(acc[3].x, acc[3].y); w1.w = pkbf(acc[3].z, acc[3].w);
            *(LAS u32x4*)(XCB + off_b(st, 2 * scg)) = w0; *(LAS u32x4*)(XCB + off_b(st, 2 * scg + 1)) = w1;
            if constexpr (PASS2) { *(LAS u32x4*)(AG + st * HD + 16 * scg) = rag[0]; *(LAS u32x4*)(AG + st * HD + 16 * scg + 8) = rag[1]; }
            if (n + 1 < 8) { int st2 = st, cg2 = scg; asm volatile("" : "+v"(st2), "+v"(cg2)); lru_fetch<PASS2>(rr, rag, C, prm, b, c, row0, n + 1, st2, cg2); }
        }
        {
            int ln = lane; asm volatile("" : "+v"(ln));
            const int lq = ln & 31, lh = ln >> 5;
            const int rt = wave & 1, ct = wave >> 1, ch = 32 * ct + lq, gch = n * HD + ch;
            const float bra = GC[gch], brx = GC[DA + gch], sp = GC[2 * DA + gch];
            __syncthreads();
            f32x16 g0, g1;
#pragma unroll
            for (int r = 0; r < 16; ++r) { g0[r] = 0.f; g1[r] = 0.f; }
#pragma unroll
            for (int s = 0; s < 8; ++s) {
                const bf16x8 a = *(const LAS bf16x8*)(XCB + off_b(32 * rt + lq, 2 * s + lh));
                g0 = MFMA32(a, __builtin_bit_cast(bf16x8, wq0[s]), g0); g1 = MFMA32(a, __builtin_bit_cast(bf16x8, wq1[s]), g1);
            }
#pragma unroll
            for (int r = 0; r < 16; ++r) {
                const int t = 32 * rt + 8 * (r >> 2) + 4 * lh + (r & 3);
                const float rg = fast_sigmoid(g0[r] + bra), ig = fast_sigmoid(g1[r] + brx);
                const float log_a = -8.0f * rg * sp, a = __builtin_amdgcn_exp2f(1.4426950408889634f * log_a);
                float mult = __builtin_amdgcn_sqrtf(one_minus_exp(2.0f * log_a, a));
                if (prm && c == 0 && t == 0) mult = 1.0f;
                const float uv = mult * (ig * XCF[t * HD + ch]);
                AA[t * HD + ch] = a; UU[t * HD + ch] = uv;
                if constexpr (!PASS2 && LRU_STREAM) { C.AG_[(size_t)(row0 + t) * DA + gch] = a; C.UG_[(size_t)(row0 + t) * DA + gch] = f2bf(uv); }
            }
        }
        __syncthreads();
        {
            int tn = tid; asm volatile("" : "+v"(tn));
            const int ch = tn & 127, q = tn >> 7, gch = n * HD + ch;
            const LAS float* ap = AA + (16 * q) * HD + ch; const LAS float* up = UU + (16 * q) * HD + ch;
            float ra = 1.f, rh = 0.f;
#pragma unroll 4
            for (int i = 0; i < 16; ++i) { const float a = ap[i * HD], u = up[i * HD]; rh = a * rh + u; ra *= a; }
            QS[(q * HD + ch) * 2] = ra; QS[(q * HD + ch) * 2 + 1] = rh;
            __syncthreads();
            float cin = PASS2 ? H0[gch] : 0.f;
            for (int qq = 0; qq < q; ++qq) cin = QS[(qq * HD + ch) * 2] * cin + QS[(qq * HD + ch) * 2 + 1];
            if constexpr (!PASS2) {
                if (q == 3) {
                    const float atot = QS[(0 * HD + ch) * 2] * QS[(1 * HD + ch) * 2] * QS[(2 * HD + ch) * 2] * ra;
                    C.SA[((size_t)b * 64 + c) * DA + gch] = atot; C.SH[((size_t)b * 64 + c) * DA + gch] = ra * cin + rh;
                }
            } else {
                float h = cin;
                LAS bf16_t* agp = AG + (16 * q) * HD + ch;
#pragma unroll 4
                for (int i = 0; i < 16; ++i) {
                    h = ap[i * HD] * h + up[i * HD];
                    agp[i * HD] = f2bf(h * fast_gelu_tanh(bf2f(agp[i * HD])));
                }
                if (q == 3 && (!prm || c == 63)) { if (prm) C.out[O_PLRU + (size_t)(C.l * NB_P + b) * DA + gch] = h; else C.out[O_SLRU + (size_t)(C.l * NB_S + b) * DA + gch] = h; }
            }
        }
        __syncthreads();
        if constexpr (PASS2) {
            int st = st_, scg = scg_; asm volatile("" : "+v"(st), "+v"(scg));
            const u32x4 y0 = *(const LAS u32x4*)(AG + st * HD + 16 * scg), y1 = *(const LAS u32x4*)(AG + st * HD + 16 * scg + 8);
            bf16_t* yp = C.Y + (size_t)(row0 + st) * DM + n * HD + 16 * scg;
            *(u32x4*)yp = y0; *(u32x4*)(yp + 8) = y1;
            float q = 0.f;
            { const unsigned w[8] = {y0.x, y0.y, y0.z, y0.w, y1.x, y1.y, y1.z, y1.w};
#pragma unroll
              for (int k = 0; k < 8; ++k) { const float a = bflo(w[k]), bq = bfhi(w[k]); q += a * a + bq * bq; } }
            q += __builtin_bit_cast(float, __builtin_amdgcn_update_dpp(0, __builtin_bit_cast(int, q), 0xB1, 0xF, 0xF, true));
            q += __builtin_bit_cast(float, __builtin_amdgcn_update_dpp(0, __builtin_bit_cast(int, q), 0x4E, 0xF, 0xF, true));
            q += __builtin_bit_cast(float, __builtin_amdgcn_update_dpp(0, __builtin_bit_cast(int, q), 0x141, 0xF, 0xF, true));
            if (scg == 0) SS[st] += q;
            __syncthreads();
        }
    }
    if (PASS2 && !(C.pf & 2)) {
        VM_WAIT();
        __syncthreads();
#pragma unroll
        for (int hf = 0; hf < 2; ++hf) {
            u32x4 raw[8];
#pragma unroll
            for (int i = 0; i < 8; ++i) { const int k = tid + 512 * (8 * hf + i), t = k >> 7, cc = k & 127; raw[i] = *(const u32x4*)(C.Y + (size_t)(row0 + t) * DM + 8 * cc); }
#pragma unroll
            for (int i = 0; i < 8; ++i) {
                const int k = tid + 512 * (8 * hf + i), t = k >> 7, cc = k & 127;
                const float rstd = rsqrtf(SS[t] * (1.f / DA) + LN_EPS);
                const LAS float* gp = (const LAS float*)(lds + LR_GM) + 8 * cc;
                const f32x4 ga = *(const LAS f32x4*)gp, gb = *(const LAS f32x4*)(gp + 4);
                u32x4 o; o.x = pkbf(bflo(raw[i].x) * rstd * ga.x, bfhi(raw[i].x) * rstd * ga.y); o.y = pkbf(bflo(raw[i].y) * rstd * ga.z, bfhi(raw[i].y) * rstd * ga.w);
                o.z = pkbf(bflo(raw[i].z) * rstd * gb.x, bfhi(raw[i].z) * rstd * gb.y); o.w = pkbf(bflo(raw[i].w) * rstd * gb.z, bfhi(raw[i].w) * rstd * gb.w);
                *(u32x4*)(C.Y + (size_t)(row0 + t) * DM + 8 * cc) = o;
            }
        }
        __syncthreads();
    }
    if constexpr (PASS2) {
        if (C.OB) {
#pragma unroll
            for (int which = 0; which < 2; ++which) {
                int st = st_, scg = scg_; asm volatile("" : "+v"(st), "+v"(scg));
                const bf16_t* src = (which ? C.OC : C.OB) + (size_t)(row0 + st) * DB + 64 * scg;
                f32x4 v[16]; float q = 0.f;
#pragma unroll
                for (int k = 0; k < 8; ++k) { const u32x4 w = *(const u32x4*)(src + 8 * k);
                    v[2 * k] = (f32x4){bflo(w.x), bfhi(w.x), bflo(w.y), bfhi(w.y)}; v[2 * k + 1] = (f32x4){bflo(w.z), bfhi(w.z), bflo(w.w), bfhi(w.w)}; }
#pragma unroll
                for (int k = 0; k < 16; ++k) q += (v[k].x * v[k].x + v[k].y * v[k].y) + (v[k].z * v[k].z + v[k].w * v[k].w);
                q += __builtin_bit_cast(float, __builtin_amdgcn_update_dpp(0, __builtin_bit_cast(int, q), 0xB1, 0xF, 0xF, true));
                q += __builtin_bit_cast(float, __builtin_amdgcn_update_dpp(0, __builtin_bit_cast(int, q), 0x4E, 0xF, 0xF, true));
                q += __builtin_bit_cast(float, __builtin_amdgcn_update_dpp(0, __builtin_bit_cast(int, q), 0x141, 0xF, 0xF, true));
                const float rstd = rsqrtf(q * (1.f / DB) + LN_EPS);
                const float* gp = C.gm + DA + which * DB + 64 * scg;
                bf16_t* yp = C.Y + (size_t)(row0 + st) * DM + DA + which * DB + 64 * scg;
#pragma unroll
                for (int k = 0; k < 8; ++k) {
                    const f32x4 ga = *(const f32x4*)(gp + 8 * k), gb = *(const f32x4*)(gp + 8 * k + 4);
                    const f32x4 a = v[2 * k] * rstd * ga, bq = v[2 * k + 1] * rstd * gb;
                    u32x4 o; o.x = pkbf(a.x, a.y); o.y = pkbf(a.z, a.w); o.z = pkbf(bq.x, bq.y); o.w = pkbf(bq.z, bq.w);
                    *(u32x4*)(yp + 8 * k) = o;
                }
            }
        }
    }
}

constexpr int L2_YT = 0, L2_QS = 131072, L2_H0 = 139264, L2_SS = 143360, L2_END = 143616;
static_assert(L2_END <= RING_BYTES, "lru pass-2 LDS map");
__device__ __forceinline__ void lru_pass2_stream(LAS unsigned char* lds, const LruCtx& C, int chunk) {
    int tid_ = threadIdx.x; asm volatile("" : "+v"(tid_));
    const int tid = tid_;
    const int b = chunk >> 6, c = chunk & 63, row0 = b * SEQ + 64 * c;
    LAS bf16_t* YT = (LAS bf16_t*)(lds + L2_YT); LAS float* QS = (LAS float*)(lds + L2_QS); LAS float* H0 = (LAS float*)(lds + L2_H0);
    const int ch = tid & 127, q = tid >> 7;
    float av[16], uv[16], gv[16];
#define L2_LOAD(n_) do { const size_t e0 = (size_t)(row0 + 16 * q) * DA + (n_) * HD + ch; const bf16_t* gp = C.H + (size_t)(row0 + 16 * q) * HP + C_AG + (n_) * HD + ch; \
        _Pragma("unroll") for (int i = 0; i < 16; ++i) { av[i] = C.AG_[e0 + (size_t)i * DA]; uv[i] = bf2f(C.UG_[e0 + (size_t)i * DA]); gv[i] = bf2f(gp[(size_t)i * HP]); } } while (0)
    L2_LOAD(0);
#pragma unroll
    for (int i = 0; i < 2; ++i) {
        const int cc = tid + 512 * i; float h = 0.f; const float* sa = C.SA + (size_t)b * 64 * DA + cc; const float* sh = C.SH + (size_t)b * 64 * DA + cc;
        for (int j0 = 0; j0 < c; j0 += 16) {
            float fa[16], fh[16];
#pragma unroll
            for (int k = 0; k < 16; ++k) { fa[k] = sa[(size_t)(j0 + k) * DA]; fh[k] = sh[(size_t)(j0 + k) * DA]; }
#pragma unroll
            for (int k = 0; k < 16; ++k) if (j0 + k < c) h = fa[k] * h + fh[k];
        }
        H0[cc] = h;
    }
    for (int n = 0; n < 8; ++n) {
        float ra = 1.f, rh = 0.f;
#pragma unroll
        for (int i = 0; i < 16; ++i) { rh = av[i] * rh + uv[i]; ra *= av[i]; }
        LAS float* qs = QS + (n & 1) * 1024;
        qs[(q * HD + ch) * 2] = ra; qs[(q * HD + ch) * 2 + 1] = rh;
        __syncthreads();
        float h = H0[n * HD + ch];
        for (int qq = 0; qq < q; ++qq) h = qs[(qq * HD + ch) * 2] * h + qs[(qq * HD + ch) * 2 + 1];
        LAS bf16_t* yp = YT + (16 * q) * DA + n * HD + ch;
#pragma unroll
        for (int i = 0; i < 16; ++i) { h = av[i] * h + uv[i]; yp[i * DA] = f2bf(h * fast_gelu_tanh(gv[i])); }
        if (q == 3 && c == 63) C.out[O_PLRU + (size_t)(C.l * NB_P + b) * DA + n * HD + ch] = h;
        if (n + 1 < 8) L2_LOAD(n + 1);
    }
#undef L2_LOAD
    __syncthreads();
    {
        const int st = tid >> 3, scg = tid & 7;
        const LAS bf16_t* rp = YT + st * DA + 128 * scg;
        u32x4 w[16]; float s2 = 0.f;
#pragma unroll
        for (int k = 0; k < 16; ++k) { w[k] = *(const LAS u32x4*)(rp + 8 * ((k + scg + 2 * st) & 15));
            const unsigned ww[4] = {w[k].x, w[k].y, w[k].z, w[k].w};
#pragma unroll
            for (int e = 0; e < 4; ++e) { const float a = bflo(ww[e]), bq = bfhi(ww[e]); s2 += a * a + bq * bq; } }
        s2 += __builtin_bit_cast(float, __builtin_amdgcn_update_dpp(0, __builtin_bit_cast(int, s2), 0xB1, 0xF, 0xF, true));
        s2 += __builtin_bit_cast(float, __builtin_amdgcn_update_dpp(0, __builtin_bit_cast(int, s2), 0x4E, 0xF, 0xF, true));
        s2 += __builtin_bit_cast(float, __builtin_amdgcn_update_dpp(0, __builtin_bit_cast(int, s2), 0x141, 0xF, 0xF, true));
        const float rstd = rsqrtf(s2 * (1.f / DA) + LN_EPS);
        const float* gp = C.gm + 128 * scg;
        bf16_t* yo = C.Y + (size_t)(row0 + st) * DM + 128 * scg;
#pragma unroll
        for (int k = 0; k < 16; ++k) {
            const int kk = (k + scg + 2 * st) & 15;
            const f32x4 ga = *(const f32x4*)(gp + 8 * kk), gb = *(const f32x4*)(gp + 8 * kk + 4);
            u32x4 o; o.x = pkbf(bflo(w[k].x) * rstd * ga.x, bfhi(w[k].x) * rstd * ga.y); o.y = pkbf(bflo(w[k].y) * rstd * ga.z, bfhi(w[k].y) * rstd * ga.w);
            o.z = pkbf(bflo(w[k].z) * rstd * gb.x, bfhi(w[k].z) * rstd * gb.y); o.w = pkbf(bflo(w[k].w) * rstd * gb.z, bfhi(w[k].w) * rstd * gb.w);
            *(u32x4*)(yo + 8 * kk) = o;
        }
    }
    __syncthreads();
}

constexpr int W2_XCB = 0  , W2_AG = 32768  , W2_SS = 65536, W2_H0 = 65792,
              W2_CW = 69888  , W2_GC = 90368  , W2_GM = 102656  , W2_AP = 106752  , W2_END = 139520;
static_assert(W2_END <= RING_BYTES, "lru strip LDS map");

template <bool PASS2, bool AB = false>
__device__ __forceinline__ void lru_item2(LAS unsigned char* lds, const LruCtx& C, int chunk) {
    int tid_ = threadIdx.x; asm volatile("" : "+v"(tid_));
    const int tid = tid_, lane = tid & 63, wave = __builtin_amdgcn_readfirstlane(tid >> 6);
    const bool prm = chunk < 256; const int b = prm ? (chunk >> 6) : (chunk - 256), c = prm ? (chunk & 63) : 0;
    const int row0 = prm ? b * SEQ + 64 * c : TP + b * TS;
    LAS float* SS = (LAS float*)(lds + W2_SS); LAS float* H0 = (LAS float*)(lds + W2_H0); LAS float* CW = (LAS float*)(lds + W2_CW); LAS float* GC = (LAS float*)(lds + W2_GC);
    const int st_ = tid >> 3, scg_ = tid & 7;
#pragma unroll
    for (int i = 0; i < 2; ++i) {
        const int ch = tid + 512 * i;
        CW[ch] = C.bconv[ch];
#pragma unroll
        for (int j = 0; j < 4; ++j) CW[(1 + j) * DA + ch] = C.wconv[(size_t)j * DA + ch];
        GC[ch] = C.bra[ch]; GC[DA + ch] = C.brx[ch]; GC[2 * DA + ch] = log1pf(expf(-C.lam[ch]));
        if constexpr (PASS2) ((LAS float*)(lds + W2_GM))[ch] = C.gm[ch];
    }
    if constexpr (PASS2) {
#pragma unroll
        for (int i = 0; i < 2; ++i) {
            const int ch = tid + 512 * i; float h;
            if (prm) { h = 0.f; const float* sa = C.SA + (size_t)b * 64 * DA + ch; const float* sh = C.SH + (size_t)b * 64 * DA + ch;
                for (int j0 = 0; j0 < c; j0 += 16) {
                    float av[16], hv[16];
#pragma unroll
                    for (int k = 0; k < 16; ++k) { av[k] = sa[(size_t)(j0 + k) * DA]; hv[k] = sh[(size_t)(j0 + k) * DA]; }
#pragma unroll
                    for (int k = 0; k < 16; ++k) if (j0 + k < c) h = av[k] * h + hv[k];
                } }
            else h = C.slru[(size_t)b * DA + ch];
            H0[ch] = h;
        }
        if (tid < 64) SS[tid] = 0.f;
    }
    __syncthreads();
    for (int rd = 0; rd < 4; ++rd) {
#pragma unroll
        for (int nb = 0; nb < 2; ++nb) {
            int st = st_, scg = scg_; asm volatile("" : "+v"(st), "+v"(scg));
            const int n = 2 * rd + nb, col = n * HD + 16 * scg;
            f32x4 acc[4];
#pragma unroll
            for (int k = 0; k < 4; ++k) acc[k] = *(const LAS f32x4*)(CW + col + 4 * k);
#pragma unroll
            for (int j = 0; j < 4; ++j) {
                const int tt = st + j - 3, tpos = (prm ? 64 * c : 0) + tt;
                f32x4 x[4];
                if (tpos >= 0) {
                    const bf16_t* hp = C.H + (size_t)(row0 + tt) * HP + C_AX + col;
                    const u32x4 r0 = *(const u32x4*)hp, r1 = *(const u32x4*)(hp + 8);
                    x[0] = (f32x4){bflo(r0.x), bfhi(r0.x), bflo(r0.y), bfhi(r0.y)}; x[1] = (f32x4){bflo(r0.z), bfhi(r0.z), bflo(r0.w), bfhi(r0.w)};
                    x[2] = (f32x4){bflo(r1.x), bfhi(r1.x), bflo(r1.y), bfhi(r1.y)}; x[3] = (f32x4){bflo(r1.z), bfhi(r1.z), bflo(r1.w), bfhi(r1.w)};
                } else if (!prm) {
                    const float* sp = C.sconv + ((size_t)b * 3 + (tpos + 3)) * DA + col;
#pragma unroll
                    for (int k = 0; k < 4; ++k) x[k] = *(const f32x4*)(sp + 4 * k);
                } else {
#pragma unroll
                    for (int k = 0; k < 4; ++k) x[k] = (f32x4){0.f, 0.f, 0.f, 0.f};
                }
#pragma unroll
                for (int k = 0; k < 4; ++k) { const f32x4 w = *(const LAS f32x4*)(CW + (1 + j) * DA + col + 4 * k); acc[k] += w * x[k]; }
            }
            u32x4 w0, w1;
            w0.x = pkbf(acc[0].x, acc[0].y); w0.y = pkbf(acc[0].z, acc[0].w); w0.z = pkbf(acc[1].x, acc[1].y); w0.w = pkbf(acc[1].z, acc[1].w);
            w1.x = pkbf(acc[2].x, acc[2].y); w1.y = pkbf(acc[2].z, acc[2].w); w1.z = pkbf(acc[3].x, acc[3].y); w1.w = pkbf(acc[3].z, acc[3].w);
            LAS unsigned char* XCB = lds + W2_XCB + nb * 16384;
            *(LAS u32x4*)(XCB + off_b(st, 2 * scg)) = w0; *(LAS u32x4*)(XCB + off_b(st, 2 * scg + 1)) = w1;
            { LAS unsigned char* XP = lds + W2_AP + nb * 16384 + st * 256 + 32 * scg; *(LAS u32x4*)XP = w0; *(LAS u32x4*)(XP + 16) = w1; }
            if constexpr (PASS2 || AB) {
                const bf16_t* gp = C.H + (size_t)(row0 + st) * HP + C_AG + col;
                LAS bf16_t* AG = (LAS bf16_t*)(lds + W2_AG + nb * 16384);
                *(LAS u32x4*)(AG + st * HD + 16 * scg) = *(const u32x4*)gp; *(LAS u32x4*)(AG + st * HD + 16 * scg + 8) = *(const u32x4*)(gp + 8);
            }
        }
        {
            int ln = lane; asm volatile("" : "+v"(ln));
            const int lq = ln & 31, lh = ln >> 5;
            const int nb = wave >> 2, ct = wave & 3, n = 2 * rd + nb, ch = 32 * ct + lq, gch = n * HD + ch;
            u32x4 wq0[8], wq1[8];
            { const bf16_t* b0p = C.WgT + ((size_t)(0 * 8 + n) * HD + ch) * HD + 8 * lh; const bf16_t* b1p = C.WgT + ((size_t)(1 * 8 + n) * HD + ch) * HD + 8 * lh;
#pragma unroll
              for (int s = 0; s < 8; ++s) { wq0[s] = *(const u32x4*)(b0p + 16 * s); wq1[s] = *(const u32x4*)(b1p + 16 * s); } }
            __syncthreads();
            const LAS unsigned char* XCB = lds + W2_XCB + nb * 16384;
            f32x16 g[2][2];
#pragma unroll
            for (int r = 0; r < 16; ++r) { g[0][0][r] = 0.f; g[0][1][r] = 0.f; g[1][0][r] = 0.f; g[1][1][r] = 0.f; }
#pragma unroll
            for (int s = 0; s < 8; ++s) {
                const bf16x8 w0 = __builtin_bit_cast(bf16x8, wq0[s]), w1 = __builtin_bit_cast(bf16x8, wq1[s]);
                const bf16x8 a0 = *(const LAS bf16x8*)(XCB + off_b(lq, 2 * s + lh)), a1 = *(const LAS bf16x8*)(XCB + off_b(32 + lq, 2 * s + lh));
                g[0][0] = MFMA32(a0, w0, g[0][0]); g[1][0] = MFMA32(a0, w1, g[1][0]); g[0][1] = MFMA32(a1, w0, g[0][1]); g[1][1] = MFMA32(a1, w1, g[1][1]);
            }
            const float bra = GC[gch], brx = GC[DA + gch], sp = GC[2 * DA + gch];
            {
                constexpr float L2E = 1.4426950408889634f;
                const LAS unsigned char* XPL = lds + W2_AP + nb * 16384;
                const float nb0 = -L2E * bra, nb1 = -L2E * brx, ka = -8.0f * L2E * sp, kx = -16.0f * sp;
#pragma unroll
                for (int rt = 0; rt < 2; ++rt)
#pragma unroll
                    for (int rp = 0; rp < 8; ++rp) {
                        const int r = 2 * rp, t = 32 * rt + 8 * (r >> 2) + 4 * lh + (r & 3);
                        const f32x2 e0 = (f32x2){g[0][rt][r], g[0][rt][r + 1]} * -L2E + nb0, e1 = (f32x2){g[1][rt][r], g[1][rt][r + 1]} * -L2E + nb1;
                        const f32x2 d0 = (f32x2){__builtin_amdgcn_exp2f(e0.x), __builtin_amdgcn_exp2f(e0.y)} + 1.f, d1 = (f32x2){__builtin_amdgcn_exp2f(e1.x), __builtin_amdgcn_exp2f(e1.y)} + 1.f;
                        const f32x2 rg = {__builtin_amdgcn_rcpf(d0.x), __builtin_amdgcn_rcpf(d0.y)}, ig = {__builtin_amdgcn_rcpf(d1.x), __builtin_amdgcn_rcpf(d1.y)};
                        const f32x2 la = rg * ka;
                        const f32x2 a = {__builtin_amdgcn_exp2f(la.x), __builtin_amdgcn_exp2f(la.y)};
                        const f32x2 x = rg * kx;
                        const f32x2 big = 1.f - a * a;
                        const f32x2 sm = -x * (1.f + x * (0.5f + x * (0.16666667f + x * (0.041666668f + x * 0.0083333338f))));
                        const f32x2 om = {(x.x > -0.25f) ? sm.x : big.x, (x.y > -0.25f) ? sm.y : big.y};
                        f32x2 mult = {__builtin_amdgcn_sqrtf(om.x), __builtin_amdgcn_sqrtf(om.y)};
                        if (prm && c == 0 && t == 0) mult.x = 1.0f;
                        const f32x2 xc = {bf2f(*(const LAS bf16_t*)(XPL + t * 256 + 2 * ch)), bf2f(*(const LAS bf16_t*)(XPL + (t + 1) * 256 + 2 * ch))};
                        const f32x2 u = mult * (ig * xc);
                        g[0][rt][r] = a.x; g[0][rt][r + 1] = a.y; g[1][rt][r] = u.x; g[1][rt][r + 1] = u.y;
                    }
            }
            float sa[8], sh[8];
#pragma unroll
            for (int k = 0; k < 8; ++k) {
                float A = 1.f, Hh = 0.f;
#pragma unroll
                for (int i = 0; i < 4; ++i) { const float a = g[0][k >> 2][4 * (k & 3) + i], u = g[1][k >> 2][4 * (k & 3) + i]; Hh = a * Hh + u; A *= a; }
                sa[k] = A; sh[k] = Hh;
            }
            float cin = PASS2 ? H0[gch] : 0.f;
            float ck[8];
            float cA = 1.f, pk[8];
#pragma unroll
            for (int k = 0; k < 8; ++k) {
                const float pa = xshfl32(sa[k], ln), ph = xshfl32(sh[k], ln);
                const float a_even = lh ? pa : sa[k], h_even = lh ? ph : sh[k], a_odd = lh ? sa[k] : pa, h_odd = lh ? sh[k] : ph;
                const float c_even = cin, c_odd = a_even * cin + h_even;
                ck[k] = lh ? c_odd : c_even;
                cin = a_odd * c_odd + h_odd;
                if constexpr (AB) { const float q_odd = a_even * cA; pk[k] = lh ? q_odd : cA; cA = a_odd * q_odd; }
            }
            if constexpr (!PASS2) {
                float atot = 1.f;
                if constexpr (AB) atot = cA;
                else {
#pragma unroll
                    for (int k = 0; k < 8; ++k) atot *= sa[k];
                    atot *= xshfl32(atot, ln);
                }
                if (lh == 0) { C.SA[((size_t)b * 64 + c) * DA + gch] = atot; C.SH[((size_t)b * 64 + c) * DA + gch] = cin; }
                if constexpr (AB) {
                    LAS bf16_t* AG = (LAS bf16_t*)(lds + W2_AG + nb * 16384); LAS bf16_t* AP = (LAS bf16_t*)(lds + W2_AP + nb * 16384);
#pragma unroll
                    for (int k = 0; k < 8; ++k) {
                        float h = ck[k], p = pk[k];
#pragma unroll
                        for (int i = 0; i < 4; ++i) {
                            const int r = 4 * (k & 3) + i, rt = k >> 2, t = 32 * rt + 8 * (k & 3) + 4 * lh + i;
                            h = g[0][rt][r] * h + g[1][rt][r]; p *= g[0][rt][r];
                            LAS bf16_t* yp = AG + t * HD + ch;
                            const float gl = fast_gelu_tanh2(bf2f(*yp));
                            const unsigned w2 = pkbf(h * gl, p * gl);
                            *yp = (bf16_t)w2; AP[t * HD + ch] = (bf16_t)(w2 >> 16);
                        }
                    }
                }
            } else {
                LAS bf16_t* AG = (LAS bf16_t*)(lds + W2_AG + nb * 16384);
#pragma unroll
                for (int k = 0; k < 8; ++k) {
                    float h = ck[k];
#pragma unroll
                    for (int i = 0; i < 4; ++i) {
                        const int r = 4 * (k & 3) + i, rt = k >> 2, t = 32 * rt + 8 * (k & 3) + 4 * lh + i;
                        h = g[0][rt][r] * h + g[1][rt][r];
                        LAS bf16_t* yp = AG + t * HD + ch;
                        *yp = (bf16_t)pkbf(h * fast_gelu_tanh2(bf2f(*yp)), 0.f);
                    }
                }
                if (lh == 1 && (!prm || c == 63)) { if (prm) C.out[O_PLRU + (size_t)(C.l * NB_P + b) * DA + gch] = cin; else C.out[O_SLRU + (size_t)(C.l * NB_S + b) * DA + gch] = cin; }
            }
        }
        __syncthreads();
        if constexpr (AB) {
            int st = st_, scg = scg_; asm volatile("" : "+v"(st), "+v"(scg));
#pragma unroll
            for (int nb = 0; nb < 2; ++nb) {
                const LAS bf16_t* AG = (const LAS bf16_t*)(lds + W2_AG + nb * 16384); const LAS bf16_t* AP = (const LAS bf16_t*)(lds + W2_AP + nb * 16384);
                const u32x4 y0 = *(const LAS u32x4*)(AG + st * HD + 16 * scg), y1 = *(const LAS u32x4*)(AG + st * HD + 16 * scg + 8);
                const u32x4 p0 = *(const LAS u32x4*)(AP + st * HD + 16 * scg), p1 = *(const LAS u32x4*)(AP + st * HD + 16 * scg + 8);
                const size_t o = (size_t)(row0 + st) * DA + (2 * rd + nb) * HD + 16 * scg;
                bf16_t* bp = C.UG_ + o; bf16_t* ap = bp - (WS_UU - WS_AA) / 2;
                *(u32x4*)bp = y0; *(u32x4*)(bp + 8) = y1; *(u32x4*)ap = p0; *(u32x4*)(ap + 8) = p1;
            }
            __syncthreads();
        }
        if constexpr (PASS2) {
            int st = st_, scg = scg_; asm volatile("" : "+v"(st), "+v"(scg));
            float q = 0.f;
#pragma unroll
            for (int nb = 0; nb < 2; ++nb) {
                const LAS bf16_t* AG = (const LAS bf16_t*)(lds + W2_AG + nb * 16384);
                const u32x4 y0 = *(const LAS u32x4*)(AG + st * HD + 16 * scg), y1 = *(const LAS u32x4*)(AG + st * HD + 16 * scg + 8);
                bf16_t* yp = C.Y + (size_t)(row0 + st) * DM + (2 * rd + nb) * HD + 16 * scg;
                *(u32x4*)yp = y0; *(u32x4*)(yp + 8) = y1;
                const unsigned w[8] = {y0.x, y0.y, y0.z, y0.w, y1.x, y1.y, y1.z, y1.w};
#pragma unroll
                for (int k = 0; k < 8; ++k) { const float a = bflo(w[k]), bq = bfhi(w[k]); q += a * a + bq * bq; }
            }
            q += __builtin_bit_cast(float, __builtin_amdgcn_update_dpp(0, __builtin_bit_cast(int, q), 0xB1, 0xF, 0xF, true));
            q += __builtin_bit_cast(float, __builtin_amdgcn_update_dpp(0, __builtin_bit_cast(int, q), 0x4E, 0xF, 0xF, true));
            q += __builtin_bit_cast(float, __builtin_amdgcn_update_dpp(0, __builtin_bit_cast(int, q), 0x141, 0xF, 0xF, true));
            if (scg == 0) SS[st] += q;
            __syncthreads();
        }
    }
    if constexpr (PASS2) {
        VM_WAIT();
        __syncthreads();
#pragma unroll
        for (int hf = 0; hf < 2; ++hf) {
            u32x4 raw[8];
#pragma unroll
            for (int i = 0; i < 8; ++i) { const int k = tid + 512 * (8 * hf + i), t = k >> 7, cc = k & 127; raw[i] = *(const u32x4*)(C.Y + (size_t)(row0 + t) * DM + 8 * cc); }
#pragma unroll
            for (int i = 0; i < 8; ++i) {
                const int k = tid + 512 * (8 * hf + i), t = k >> 7, cc = k & 127;
                const float rstd = rsqrtf(SS[t] * (1.f / DA) + LN_EPS);
                const LAS float* gp = (const LAS float*)(lds + W2_GM) + 8 * cc;
                const f32x4 ga = *(const LAS f32x4*)gp, gb = *(const LAS f32x4*)(gp + 4);
                u32x4 o; o.x = pkbf(bflo(raw[i].x) * rstd * ga.x, bfhi(raw[i].x) * rstd * ga.y); o.y = pkbf(bflo(raw[i].y) * rstd * ga.z, bfhi(raw[i].y) * rstd * ga.w);
                o.z = pkbf(bflo(raw[i].z) * rstd * gb.x, bfhi(raw[i].z) * rstd * gb.y); o.w = pkbf(bflo(raw[i].w) * rstd * gb.z, bfhi(raw[i].w) * rstd * gb.w);
                *(u32x4*)(C.Y + (size_t)(row0 + t) * DM + 8 * cc) = o;
            }
        }
        if (C.OB) {
#pragma unroll
            for (int which = 0; which < 2; ++which) {
                int st = st_, scg = scg_; asm volatile("" : "+v"(st), "+v"(scg));
                const bf16_t* src = (which ? C.OC : C.OB) + (size_t)(row0 + st) * DB + 64 * scg;
                f32x4 v[16]; float q = 0.f;
#pragma unroll
                for (int k = 0; k < 8; ++k) { const u32x4 w = *(const u32x4*)(src + 8 * k);
                    v[2 * k] = (f32x4){bflo(w.x), bfhi(w.x), bflo(w.y), bfhi(w.y)}; v[2 * k + 1] = (f32x4){bflo(w.z), bfhi(w.z), bflo(w.w), bfhi(w.w)}; }
#pragma unroll
                for (int k = 0; k < 16; ++k) q += (v[k].x * v[k].x + v[k].y * v[k].y) + (v[k].z * v[k].z + v[k].w * v[k].w);
                q += __builtin_bit_cast(float, __builtin_amdgcn_update_dpp(0, __builtin_bit_cast(int, q), 0xB1, 0xF, 0xF, true));
                q += __builtin_bit_cast(float, __builtin_amdgcn_update_dpp(0, __builtin_bit_cast(int, q), 0x4E, 0xF, 0xF, true));
                q += __builtin_bit_cast(float, __builtin_amdgcn_update_dpp(0, __builtin_bit_cast(int, q), 0x141, 0xF, 0xF, true));
                const float rstd = rsqrtf(q * (1.f / DB) + LN_EPS);
                const float* gp = C.gm + DA + which * DB + 64 * scg;
                bf16_t* yp = C.Y + (size_t)(row0 + st) * DM + DA + which * DB + 64 * scg;
#pragma unroll
                for (int k = 0; k < 8; ++k) {
                    const f32x4 ga = *(const f32x4*)(gp + 8 * k), gb = *(const f32x4*)(gp + 8 * k + 4);
                    const f32x4 a = v[2 * k] * rstd * ga, bq = v[2 * k + 1] * rstd * gb;
                    u32x4 o; o.x = pkbf(a.x, a.y); o.y = pkbf(a.z, a.w); o.z = pkbf(bq.x, bq.y); o.w = pkbf(bq.z, bq.w);
                    *(u32x4*)(yp + 8 * k) = o;
                }
            }
        }
    }
    __syncthreads();
}

__device__ __forceinline__ void lru_fin(LAS unsigned char* lds, const LruCtx& C, int chunk) {
    int tid_ = threadIdx.x; asm volatile("" : "+v"(tid_));
    const int tid = tid_;
    const int b = chunk >> 6, c = chunk & 63, row0 = b * SEQ + 64 * c;
    LAS float* H0 = (LAS float*)(lds + W2_H0); LAS float* GM = (LAS float*)(lds + W2_GM);
    int st = tid >> 3, scg = tid & 7; asm volatile("" : "+v"(st), "+v"(scg));
    const bf16_t* bp = C.UG_ + (size_t)(row0 + st) * DA + 8 * scg;
    const bf16_t* ap = bp - (WS_UU - WS_AA) / 2;
    u32x4 av[8], bv[8];
#pragma unroll
    for (int i = 0; i < 8; ++i) { av[i] = *(const u32x4*)(ap + 64 * i); bv[i] = *(const u32x4*)(bp + 64 * i); }
    {
        float h0 = 0.f, h1 = 0.f;
        const float* sa = C.SA + (size_t)b * 64 * DA + tid; const float* sh = C.SH + (size_t)b * 64 * DA + tid;
        for (int j0 = 0; j0 < c; j0 += 16) {
            float a0[16], s0[16], a1[16], s1[16];
#pragma unroll
            for (int k = 0; k < 16; ++k) { a0[k] = sa[(size_t)(j0 + k) * DA]; s0[k] = sh[(size_t)(j0 + k) * DA]; a1[k] = sa[(size_t)(j0 + k) * DA + 512]; s1[k] = sh[(size_t)(j0 + k) * DA + 512]; }
#pragma unroll
            for (int k = 0; k < 16; ++k) if (j0 + k < c) { h0 = a0[k] * h0 + s0[k]; h1 = a1[k] * h1 + s1[k]; }
        }
        H0[tid] = h0; H0[tid + 512] = h1; GM[tid] = C.gm[tid]; GM[tid + 512] = C.gm[tid + 512];
        if (c == 63) { float* op = C.out + O_PLRU + (size_t)(C.l * NB_P + b) * DA + tid;
                       op[0] = sa[(size_t)63 * DA] * h0 + sh[(size_t)63 * DA]; op[512] = sa[(size_t)63 * DA + 512] * h1 + sh[(size_t)63 * DA + 512]; }
    }
    __syncthreads();
    {
        u32x4 y[16]; float q = 0.f;
#pragma unroll
        for (int kb = 0; kb < 2; ++kb) {
            if (kb == 1) {
#pragma unroll
                for (int i = 0; i < 8; ++i) { av[i] = *(const u32x4*)(ap + 64 * (8 + i)); bv[i] = *(const u32x4*)(bp + 64 * (8 + i)); }
            }
#pragma unroll
            for (int i = 0; i < 8; ++i) {
                const LAS float* hp = H0 + 8 * scg + 64 * (8 * kb + i);
                const f32x4 h0 = *(const LAS f32x4*)hp, h1 = *(const LAS f32x4*)(hp + 4);
                const float r0 = bflo(bv[i].x) + bflo(av[i].x) * h0.x, r1 = bfhi(bv[i].x) + bfhi(av[i].x) * h0.y, r2 = bflo(bv[i].y) + bflo(av[i].y) * h0.z, r3 = bfhi(bv[i].y) + bfhi(av[i].y) * h0.w;
                const float r4 = bflo(bv[i].z) + bflo(av[i].z) * h1.x, r5 = bfhi(bv[i].z) + bfhi(av[i].z) * h1.y, r6 = bflo(bv[i].w) + bflo(av[i].w) * h1.z, r7 = bfhi(bv[i].w) + bfhi(av[i].w) * h1.w;
                q += (r0 * r0 + r1 * r1) + (r2 * r2 + r3 * r3) + (r4 * r4 + r5 * r5) + (r6 * r6 + r7 * r7);
                u32x4 o; o.x = pkbf(r0, r1); o.y = pkbf(r2, r3); o.z = pkbf(r4, r5); o.w = pkbf(r6, r7);
                y[8 * kb + i] = o;
            }
            __builtin_amdgcn_sched_barrier(0);
        }
        q += __builtin_bit_cast(float, __builtin_amdgcn_update_dpp(0, __builtin_bit_cast(int, q), 0xB1, 0xF, 0xF, true));
        q += __builtin_bit_cast(float, __builtin_amdgcn_update_dpp(0, __builtin_bit_cast(int, q), 0x4E, 0xF, 0xF, true));
        q += __builtin_bit_cast(float, __builtin_amdgcn_update_dpp(0, __builtin_bit_cast(int, q), 0x141, 0xF, 0xF, true));
        const float rstd = rsqrtf(q * (1.f / DA) + LN_EPS);
        bf16_t* yo = C.Y + (size_t)(row0 + st) * DM + 8 * scg;
#pragma unroll
        for (int k = 0; k < 16; ++k) {
            const LAS float* gp = GM + 8 * scg + 64 * k;
            const f32x4 ga = *(const LAS f32x4*)gp, gb = *(const LAS f32x4*)(gp + 4);
            u32x4 o; o.x = pkbf(bflo(y[k].x) * rstd * ga.x, bfhi(y[k].x) * rstd * ga.y); o.y = pkbf(bflo(y[k].y) * rstd * ga.z, bfhi(y[k].y) * rstd * ga.w);
            o.z = pkbf(bflo(y[k].z) * rstd * gb.x, bfhi(y[k].z) * rstd * gb.y); o.w = pkbf(bflo(y[k].w) * rstd * gb.z, bfhi(y[k].w) * rstd * gb.w);
            *(u32x4*)(yo + 64 * k) = o;
            if ((k & 3) == 3) __builtin_amdgcn_sched_barrier(0);
        }
    }
    __builtin_amdgcn_sched_barrier(0);
    if (C.OB) {
#pragma unroll
        for (int which = 0; which < 2; ++which) {
            int st = tid >> 3, scg = tid & 7; asm volatile("" : "+v"(st), "+v"(scg));
            const bf16_t* src = (which ? C.OC : C.OB) + (size_t)(row0 + st) * DB + 64 * scg;
            f32x4 v[16]; float q = 0.f;
#pragma unroll
            for (int k = 0; k < 8; ++k) { const u32x4 w = *(const u32x4*)(src + 8 * k);
                v[2 * k] = (f32x4){bflo(w.x), bfhi(w.x), bflo(w.y), bfhi(w.y)}; v[2 * k + 1] = (f32x4){bflo(w.z), bfhi(w.z), bflo(w.w), bfhi(w.w)}; }
#pragma unroll
            for (int k = 0; k < 16; ++k) q += (v[k].x * v[k].x + v[k].y * v[k].y) + (v[k].z * v[k].z + v[k].w * v[k].w);
            q += __builtin_bit_cast(float, __builtin_amdgcn_update_dpp(0, __builtin_bit_cast(int, q), 0xB1, 0xF, 0xF, true));
            q += __builtin_bit_cast(float, __builtin_amdgcn_update_dpp(0, __builtin_bit_cast(int, q), 0x4E, 0xF, 0xF, true));
            q += __builtin_bit_cast(float, __builtin_amdgcn_update_dpp(0, __builtin_bit_cast(int, q), 0x141, 0xF, 0xF, true));
            const float rstd = rsqrtf(q * (1.f / DB) + LN_EPS);
            const float* gp = C.gm + DA + which * DB + 64 * scg;
            bf16_t* yp = C.Y + (size_t)(row0 + st) * DM + DA + which * DB + 64 * scg;
#pragma unroll
            for (int k = 0; k < 8; ++k) {
                const f32x4 ga = *(const f32x4*)(gp + 8 * k), gb = *(const f32x4*)(gp + 8 * k + 4);
                const f32x4 a = v[2 * k] * rstd * ga, bq = v[2 * k + 1] * rstd * gb;
                u32x4 o; o.x = pkbf(a.x, a.y); o.y = pkbf(a.z, a.w); o.z = pkbf(bq.x, bq.y); o.w = pkbf(bq.z, bq.w);
                *(u32x4*)(yp + 8 * k) = o;
            }
        }
    }
    __syncthreads();
}
constexpr int CW_BAR = 4096;
constexpr int N_MV = 8192;
constexpr int CV_I_IN = (DM / 64) * (DINP / 32), CV_I_OUT = (DM / 64) * (DM / 32), CV_I_UP = (DM / 64) * (DFF / 32), CV_I_DN = (DFF / 64) * (DM / 32), CV_I_G = 16 * 8, CV_I_L = CV_I_IN + CV_I_OUT + CV_I_UP + CV_I_DN + CV_I_G;
constexpr int CV2_A0 = CV_I_IN + N_MV, CV2_AN = CV_I_OUT + CV_I_UP - N_MV + CV_I_DN, CV2_B0 = CV_I_L, CV2_BN = 4096, N_MV2 = CV2_AN + CV2_BN;
static_assert(CV2_A0 + CV2_AN == CV_I_IN + CV_I_OUT + CV_I_UP + CV_I_DN && CV2_BN <= CV_I_IN && CV2_AN % 2048 == 0 && CV2_BN % 2048 == 0, "filler ranges");
constexpr int CW_QUEUE = 65536;
constexpr int CW_LRUCNT = 98304;
constexpr int CW_SPLITK = 131072;
constexpr size_t CTL_ZERO_BYTES = 1 * MiB;
constexpr int NPH = 2 + 8 * DEPTH;

__device__ __forceinline__ unsigned pk2(float lo, float hi) { return pg8::cvt_pk_bf16(lo, hi); }

struct Args { const float* in[27]; float* out; unsigned char* ws; int ph_lo, ph_hi, li, flags; };

__device__ __forceinline__ void tr_item(const float* W, int K, int ld, int ncols, bf16_t* WT, LAS float* scr, int item, int lane) {
    const int nblk = ncols / 32, kb = item / nblk, nb = item % nblk, k0 = 64 * kb, n0 = 32 * nb;
    float wv[32];
#pragma unroll
    for (int i = 0; i < 32; ++i) wv[i] = W[(size_t)(k0 + 2 * i + (lane >> 5)) * ld + n0 + (lane & 31)];
#pragma unroll
    for (int i = 0; i < 32; ++i) scr[(2 * i + (lane >> 5)) * 33 + (lane & 31)] = wv[i];
    LDS_WAIT(); asm volatile("" ::: "memory");
    const int c = lane & 7;
#pragma unroll
    for (int j = 0; j < 4; ++j) { const int n = (lane >> 3) + 8 * j; const LAS float* s = scr + (8 * c) * 33 + n;
        u32x4 o; o.x = pk2(s[0 * 33], s[1 * 33]); o.y = pk2(s[2 * 33], s[3 * 33]); o.z = pk2(s[4 * 33], s[5 * 33]); o.w = pk2(s[6 * 33], s[7 * 33]);
        *(u32x4*)(WT + (size_t)(n0 + n) * K + k0 + 8 * c) = o; }
    LDS_WAIT(); asm volatile("" ::: "memory");
}
__device__ __forceinline__ void conv_item(int it, const float* w_in, const float* w_out, const float* w_up, const float* w_dn, const float* w_ra, const float* w_rx,
                                          bf16_t* WinT, bf16_t* WoutT, bf16_t* WupT, bf16_t* WdnT, bf16_t* WgT, LAS float* scr, int lane) {
    const int l = it / CV_I_L; int r = it % CV_I_L;
    if (r < CV_I_IN) { tr_item(w_in + (size_t)l * DM * DIN, DM, DIN, DINP, WinT + (size_t)l * DINP * DM, scr, r, lane); return; } r -= CV_I_IN;
    if (r < CV_I_OUT) { tr_item(w_out + (size_t)l * DM * DM, DM, DM, DM, WoutT + (size_t)l * DM * DM, scr, r, lane); return; } r -= CV_I_OUT;
    if (r < CV_I_UP) { tr_item(w_up + (size_t)l * DM * DFF, DM, DFF, DFF, WupT + (size_t)l * DFF * DM, scr, r, lane); return; } r -= CV_I_UP;
    if (r < CV_I_DN) { tr_item(w_dn + (size_t)l * DFF * DM, DFF, DM, DM, WdnT + (size_t)l * DM * DFF, scr, r, lane); return; } r -= CV_I_DN;
    { const int mat = r >> 3, sub = r & 7, gate = mat >> 3, n = mat & 7;
      const float* src = (gate ? w_rx : w_ra) + ((size_t)l * 8 + n) * HD * HD;
      tr_item(src, HD, HD, HD, WgT + (((size_t)l * 2 + gate) * 8 + n) * HD * HD, scr, sub, lane); }
}
__device__ __forceinline__ void logf_store(float d0, float d1, float d2, float d3, const float* bfg, float* out, int l, int row, int lane) {
    d0 = wave_sum(d0); d1 = wave_sum(d1); d2 = wave_sum(d2); d3 = wave_sum(d3);
    if (lane < 4) {
        const float d = lane == 0 ? d0 : lane == 1 ? d1 : lane == 2 ? d2 : d3;
        const float lf = log_sigmoid_f(d + bfg[lane]);
        bool prm; int b, t; row_bt(row, prm, b, t);
        if (prm) out[O_PFL + ((size_t)(l * NB_P + b) * SEQ + t) * NH + lane] = lf;
        else out[O_SFL + ((size_t)(l * NB_S + b) * TS + t) * NH + lane] = lf;
    }
}
template <int NR>
__device__ __forceinline__ void xcvt_rows(const float* x_p, const float* x_s, const float* wf, const float* bfg, bf16_t* xb, float* out, int l, int row0, int rstep, int nvalid, int lane) {
    f32x4 v[NR][8];
#pragma unroll
    for (int r = 0; r < NR; ++r) {
        const float* xr = xrow0(x_p, x_s, (r < nvalid) ? row0 + r * rstep : row0);
#pragma unroll
        for (int j = 0; j < 8; ++j) v[r][j] = ((const f32x4*)xr)[lane + 64 * j];
    }
    float d[NR][4];
#pragma unroll
    for (int r = 0; r < NR; ++r) { d[r][0] = 0.f; d[r][1] = 0.f; d[r][2] = 0.f; d[r][3] = 0.f; }
#pragma unroll
    for (int j = 0; j < 8; ++j) {
        const int c = lane + 64 * j;
        const f32x4 w0 = ((const f32x4*)wf)[c], w1 = ((const f32x4*)(wf + DM))[c], w2 = ((const f32x4*)(wf + 2 * DM))[c], w3 = ((const f32x4*)(wf + 3 * DM))[c];
#pragma unroll
        for (int r = 0; r < NR; ++r) {
            if (r < nvalid) {
                const f32x4 o = v[r][j];
                u32x2 p; p.x = pk2(o.x, o.y); p.y = pk2(o.z, o.w);
                ((u32x2*)(xb + (size_t)(row0 + r * rstep) * DM))[c] = p;
                d[r][0] += o.x * w0.x + o.y * w0.y + o.z * w0.z + o.w * w0.w; d[r][1] += o.x * w1.x + o.y * w1.y + o.z * w1.z + o.w * w1.w;
                d[r][2] += o.x * w2.x + o.y * w2.y + o.z * w2.z + o.w * w2.w; d[r][3] += o.x * w3.x + o.y * w3.y + o.z * w3.z + o.w * w3.w;
            }
        }
    }
#pragma unroll
    for (int r = 0; r < NR; ++r) if (r < nvalid) logf_store(d[r][0], d[r][1], d[r][2], d[r][3], bfg, out, l, row0 + r * rstep, lane);
}
template <int NR>
__device__ __forceinline__ void ln_rows(const bf16_t* z, const float* g, const float* bta, float* xf, bf16_t* xb, const float* wf_next, const float* bfg_next, float* out, int lnext, int row0, int rstep, int nvalid, int lane) {
    u32x4 w[NR][4]; float s[NR];
#pragma unroll
    for (int r = 0; r < NR; ++r) {
        const int row = (r < nvalid) ? row0 + r * rstep : row0;
#pragma unroll
        for (int jj = 0; jj < 4; ++jj) w[r][jj] = ((const u32x4*)(z + (size_t)row * DM))[lane + 64 * jj];
    }
#define LN_V(r, j) ((j & 1) ? (f32x4){bflo(w[r][(j) >> 1].z), bfhi(w[r][(j) >> 1].z), bflo(w[r][(j) >> 1].w), bfhi(w[r][(j) >> 1].w)} : (f32x4){bflo(w[r][(j) >> 1].x), bfhi(w[r][(j) >> 1].x), bflo(w[r][(j) >> 1].y), bfhi(w[r][(j) >> 1].y)})
    float mu[NR], rstd[NR];
#pragma unroll
    for (int r = 0; r < NR; ++r) {
        s[r] = 0.f;
#pragma unroll
        for (int j = 0; j < 8; ++j) { const f32x4 v = LN_V(r, j); s[r] += (v.x + v.y) + (v.z + v.w); }
        mu[r] = wave_sum(s[r]) * (1.f / DM); float q = 0.f;
#pragma unroll
        for (int j = 0; j < 8; ++j) { const f32x4 v = LN_V(r, j) - mu[r]; q += (v.x * v.x + v.y * v.y) + (v.z * v.z + v.w * v.w); }
        rstd[r] = rsqrtf(wave_sum(q) * (1.f / DM) + LN_EPS);
    }
    float d[NR][4];
#pragma unroll
    for (int r = 0; r < NR; ++r) { d[r][0] = 0.f; d[r][1] = 0.f; d[r][2] = 0.f; d[r][3] = 0.f; }
#pragma unroll
    for (int j = 0; j < 8; ++j) {
        const int c = 2 * (lane + 64 * (j >> 1)) + (j & 1);
        const f32x4 gg = ((const f32x4*)g)[c], bb = ((const f32x4*)bta)[c];
        f32x4 w0, w1, w2, w3;
        if (wf_next) { w0 = ((const f32x4*)wf_next)[c]; w1 = ((const f32x4*)(wf_next + DM))[c]; w2 = ((const f32x4*)(wf_next + 2 * DM))[c]; w3 = ((const f32x4*)(wf_next + 3 * DM))[c]; }
#pragma unroll
        for (int r = 0; r < NR; ++r) {
            if (r < nvalid) {
                const int row = row0 + r * rstep;
                const f32x4 o = (LN_V(r, j) - mu[r]) * rstd[r] * gg + bb;
                if (xf) ((f32x4*)(xf + (size_t)row * DM))[c] = o;
                u32x2 p; p.x = pk2(o.x, o.y); p.y = pk2(o.z, o.w);
                if (xb) ((u32x2*)(xb + (size_t)row * DM))[c] = p;
                if (wf_next) { d[r][0] += o.x * w0.x + o.y * w0.y + o.z * w0.z + o.w * w0.w; d[r][1] += o.x * w1.x + o.y * w1.y + o.z * w1.z + o.w * w1.w;
                               d[r][2] += o.x * w2.x + o.y * w2.y + o.z * w2.z + o.w * w2.w; d[r][3] += o.x * w3.x + o.y * w3.y + o.z * w3.z + o.w * w3.w; }
            }
        }
    }
#undef LN_V
    if (wf_next) {
#pragma unroll
        for (int r = 0; r < NR; ++r) if (r < nvalid) logf_store(d[r][0], d[r][1], d[r][2], d[r][3], bfg_next, out, lnext, row0 + r * rstep, lane);
    }
}
__device__ __forceinline__ void mixnorm_row(const float* OA, const bf16_t* OB, const bf16_t* OC, const float* PO, const float* PM, const float* PL, const float* gm, bf16_t* Y, bool with_a, int row, int lane) {
    if (with_a) {
        f32x4 a[4]; float sa = 0.f;
#pragma unroll
        for (int j = 0; j < 4; ++j) { a[j] = ((const f32x4*)(OA + (size_t)row * DA))[lane + 64 * j]; sa += (a[j].x * a[j].x + a[j].y * a[j].y) + (a[j].z * a[j].z + a[j].w * a[j].w); }
        const float ra = rsqrtf(wave_sum(sa) * (1.f / DA) + LN_EPS);
#pragma unroll
        for (int j = 0; j < 4; ++j) { const int c = lane + 64 * j; const f32x4 gg = ((const f32x4*)gm)[c]; const f32x4 o = a[j] * ra * gg;
            u32x2 p; p.x = pk2(o.x, o.y); p.y = pk2(o.z, o.w); ((u32x2*)(Y + (size_t)row * DM))[c] = p; }
    }
    {
        f32x4 b[2]; float sb = 0.f;
        { const u32x4 w = ((const u32x4*)(OB + (size_t)row * DB))[lane]; b[0] = (f32x4){bflo(w.x), bfhi(w.x), bflo(w.y), bfhi(w.y)}; b[1] = (f32x4){bflo(w.z), bfhi(w.z), bflo(w.w), bfhi(w.w)}; }
#pragma unroll
        for (int j = 0; j < 2; ++j) sb += (b[j].x * b[j].x + b[j].y * b[j].y) + (b[j].z * b[j].z + b[j].w * b[j].w);
        const float rb = rsqrtf(wave_sum(sb) * (1.f / DB) + LN_EPS);
#pragma unroll
        for (int j = 0; j < 2; ++j) { const int c = 2 * lane + j; const f32x4 gb = ((const f32x4*)(gm + DA))[c]; const f32x4 ob = b[j] * rb * gb;
            u32x2 p; p.x = pk2(ob.x, ob.y); p.y = pk2(ob.z, ob.w); ((u32x2*)(Y + (size_t)row * DM + DA))[c] = p; }
    }
    if (row < TP) {
        f32x4 cc[2]; float sc = 0.f;
        { const u32x4 w = ((const u32x4*)(OC + (size_t)row * DB))[lane]; cc[0] = (f32x4){bflo(w.x), bfhi(w.x), bflo(w.y), bfhi(w.y)}; cc[1] = (f32x4){bflo(w.z), bfhi(w.z), bflo(w.w), bfhi(w.w)}; }
#pragma unroll
        for (int j = 0; j < 2; ++j) sc += (cc[j].x * cc[j].x + cc[j].y * cc[j].y) + (cc[j].z * cc[j].z + cc[j].w * cc[j].w);
        const float rc = rsqrtf(wave_sum(sc) * (1.f / DB) + LN_EPS);
#pragma unroll
        for (int j = 0; j < 2; ++j) { const int c = 2 * lane + j; const f32x4 gc = ((const f32x4*)(gm + DA + DB))[c]; const f32x4 oc = cc[j] * rc * gc;
            u32x2 q; q.x = pk2(oc.x, oc.y); q.y = pk2(oc.z, oc.w); ((u32x2*)(Y + (size_t)row * DM + DA + DB))[c] = q; }
    } else {
        const int r = row - TP, b = r >> 6, qi = r & 63;
        float cv[NH][2]; float sc = 0.f;
#pragma unroll
        for (int hh = 0; hh < NH; ++hh) {
            const int bh = b * NH + hh;
            float m = -1e30f;
#pragma unroll
            for (int sp = 0; sp < NSPLIT; ++sp) m = fmaxf(m, PM[((size_t)bh * NSPLIT + sp) * TS + qi]);
            float l = 0.f, o0 = 0.f, o1 = 0.f;
#pragma unroll
            for (int sp = 0; sp < NSPLIT; ++sp) {
                const size_t pr = ((size_t)bh * NSPLIT + sp) * TS + qi;
                const float w = __builtin_amdgcn_exp2f(PM[pr] - m);
                l += PL[pr] * w; o0 += PO[pr * HD + lane] * w; o1 += PO[pr * HD + lane + 64] * w;
            }
            const float inv = 1.f / l;
            cv[hh][0] = o0 * inv; cv[hh][1] = o1 * inv; sc += cv[hh][0] * cv[hh][0] + cv[hh][1] * cv[hh][1];
        }
        const float rc = rsqrtf(wave_sum(sc) * (1.f / DB) + LN_EPS);
#pragma unroll
        for (int hh = 0; hh < NH; ++hh) {
            const int c0 = DA + DB + hh * HD + lane;
            Y[(size_t)row * DM + c0] = f2bf(cv[hh][0] * rc * gm[c0]); Y[(size_t)row * DM + c0 + 64] = f2bf(cv[hh][1] * rc * gm[c0 + 64]);
        }
    }
}
__device__ __forceinline__ void cumsum_seq(LAS float* scr, const float* out, const float* cfl_l, float* Fp, float* Fs, int l, int seq, int tid) {
    const int lane = tid & 63, wave = tid >> 6;
    const bool prm = seq < 16; const int bh = prm ? seq : seq - 16, b = bh >> 2, h = bh & 3;
    const int n = prm ? SEQ : PAST + TS, seg = prm ? 8 : 9;
    const int i0 = tid * seg, i1 = min(n, i0 + seg);
    float s = 0.f;
    for (int i = i0; i < i1; ++i) s += logf_get(out, cfl_l, l, prm, b, h, i);
    float v = s;
#pragma unroll
    for (int o = 1; o < 64; o <<= 1) { const float t = __builtin_bit_cast(float, __builtin_amdgcn_ds_bpermute((lane - o) << 2, __builtin_bit_cast(int, v))); if (lane >= o) v += t; }
    __syncthreads();
    if (lane == 63) scr[wave] = v;
    __syncthreads();
    float pre = 0.f;
    for (int w = 0; w < wave; ++w) pre += scr[w];
    float run = pre + v - s;
    float* dst = prm ? Fp + (size_t)bh * SEQ : Fs + (size_t)bh * (PAST + TS);
    for (int i = i0; i < i1; ++i) { run += logf_get(out, cfl_l, l, prm, b, h, i); dst[i] = run; }
}

__global__ void __launch_bounds__(NTHREADS, 2) mk_fwd(Args args) {
    extern __shared__ __attribute__((aligned(16))) unsigned char lds_raw[];
    LAS unsigned char* lds = (LAS unsigned char*)lds_raw;
    volatile LAS unsigned* MISC = (volatile LAS unsigned*)(lds + MISC_OFF);
    const int wave = __builtin_amdgcn_readfirstlane((int)threadIdx.x >> 6);
#define TIDF() ([]() __attribute__((always_inline)) { int t_ = threadIdx.x; asm volatile("" : "+v"(t_)); return t_; }())
#define tid TIDF()
#define lane (TIDF() & 63)
    typedef const __attribute__((address_space(4))) Args* KArgs;
#define KA() ([]() __attribute__((always_inline)) { KArgs a_ = (KArgs)__builtin_amdgcn_kernarg_segment_ptr(); asm volatile("" : "+s"(a_)); return a_; }())
    { unsigned* ctl0 = (unsigned*)(args.ws + WS_CTL);
      for (int u = tid; u < (LDS_BYTES - RING_BYTES) / 4; u += NTHREADS) ((LAS unsigned*)(lds + RING_BYTES))[u] = 0u;
      __syncthreads();
      (void)xcd_barrier_post(ctl0 + CW_BAR + args.li * XCD_BAR_WORDS, MISC + 8); }
#ifdef PROBE_PHASE
#define NB_LRU ((KA()->flags >> 16) & 15 ? ((KA()->flags >> 16) & 15) - 1 : 8)
#define PF_LRU ((KA()->flags >> 21) & 3)
#define ATT_SKIP ((KA()->flags >> 24) & 7)
#else
#define NB_LRU 8
#define PF_LRU 0
#define ATT_SKIP 0
#endif
#define IN(k) (KA()->ph_lo <= (k) && (k) < KA()->ph_hi)
#define SEAM(k) do { if (IN(k) && IN((k) + 1)) { XcdBarrier b_; b_.bar = (unsigned*)(KA()->ws + WS_CTL) + CW_BAR + KA()->li * XCD_BAR_WORDS; b_.x = xb_xcc_id(); b_.st = MISC + 8; xcd_barrier(b_); } } while (0)
#define PHASE_PTRS \
    KArgs A_ = KA(); \
    const int G = gridDim.x, gw = blockIdx.x * NWAVES + wave, NGW = G * NWAVES; unsigned* ctl = (unsigned*)(A_->ws + WS_CTL); (void)G; (void)gw; (void)NGW; (void)ctl; \
    unsigned char* ws = A_->ws; float* out = A_->out; \
    const float *x_p = A_->in[0], *x_s = A_->in[1], *st_conv = A_->in[2], *st_lru = A_->in[3], *c_bk = A_->in[4], *c_bv = A_->in[5], *c_fk = A_->in[6], *c_fv = A_->in[7], *c_fl = A_->in[8], *w_in = A_->in[9]; \
    const float *w_conv = A_->in[10], *b_conv = A_->in[11], *w_ra = A_->in[12], *b_ra = A_->in[13], *w_rx = A_->in[14], *b_rx = A_->in[15], *lam = A_->in[16], *relb = A_->in[17], *bfg = A_->in[18], *gmix = A_->in[19], *w_out = A_->in[20]; \
    const float *ln1g = A_->in[21], *ln1b = A_->in[22], *w_up = A_->in[23], *w_dn = A_->in[24], *ln2g = A_->in[25], *ln2b = A_->in[26]; \
    bf16_t* WinT = (bf16_t*)(ws + WS_WIN); bf16_t* WoutT = (bf16_t*)(ws + WS_WOUT); bf16_t* WupT = (bf16_t*)(ws + WS_WUP); bf16_t* WdnT = (bf16_t*)(ws + WS_WDN); bf16_t* WgT = (bf16_t*)(ws + WS_WG); \
    float* WF = (float*)(ws + WS_WF); bf16_t* Xb = (bf16_t*)(ws + WS_XB); float* X1f = (float*)(ws + WS_X1F); bf16_t* X1b = (bf16_t*)(ws + WS_X1B); float* X2f = (float*)(ws + WS_X2F); \
    bf16_t* Z = (bf16_t*)(ws + WS_Z); bf16_t* H = (bf16_t*)(ws + WS_H); bf16_t* Y = (bf16_t*)(ws + WS_Y); bf16_t* HDN = (bf16_t*)(ws + WS_HDN); \
    bf16_t* OB = (bf16_t*)(ws + WS_OB); bf16_t* OC = (bf16_t*)(ws + WS_OC); float* Fp = (float*)(ws + WS_FP); float* Fs = (float*)(ws + WS_FS); float* OA = (float*)(ws + WS_OA); \
    float* PO = (float*)(ws + WS_PO); float* PM = (float*)(ws + WS_PM); float* PL = (float*)(ws + WS_PL); float* SA = (float*)(ws + WS_SA); float* SH = (float*)(ws + WS_SH); \
    (void)x_p; (void)x_s; (void)st_conv; (void)st_lru; (void)c_bk; (void)c_bv; (void)c_fk; (void)c_fv; (void)c_fl; (void)w_in; (void)w_conv; (void)b_conv; (void)w_ra; (void)b_ra; (void)w_rx; (void)b_rx; (void)lam; (void)relb; (void)bfg; (void)gmix; (void)w_out; \
    (void)ln1g; (void)ln1b; (void)w_up; (void)w_dn; (void)ln2g; (void)ln2b; (void)WinT; (void)WoutT; (void)WupT; (void)WdnT; (void)WgT; (void)WF; (void)Xb; (void)X1f; (void)X1b; (void)X2f; (void)Z; (void)H; (void)Y; (void)HDN; (void)OB; (void)OC; (void)Fp; (void)Fs; (void)OA; \
    (void)PO; (void)PM; (void)PL; (void)SA; (void)SH; (void)out;

    if (IN(0)) {
        PHASE_PTRS
        LAS float* scr = (LAS float*)(lds + wave * 16384);
        const bool mv = (G > 0) && (1440 % G) != 0;
        const bool mv2 = (G > 0) && (576 % G) != 0;
        for (int it = gw; it < DEPTH * CV_I_L; it += NGW) {
            const int r = it % CV_I_L;
            if (mv && r >= CV_I_IN && r < CV_I_IN + N_MV) continue;
            if (mv2 && ((r >= CV2_A0 && r < CV2_A0 + CV2_AN) || (it >= CV2_B0 && it < CV2_B0 + CV2_BN))) continue;
            conv_item(it, w_in, w_out, w_up, w_dn, w_ra, w_rx, WinT, WoutT, WupT, WdnT, WgT, scr, lane);
        }
        for (int i = blockIdx.x * NTHREADS + tid; i < DEPTH * 4 * DM; i += G * NTHREADS) { const int l = i / (4 * DM), r = i % (4 * DM), j = r / DM, k = r % DM; WF[i] = w_in[(size_t)l * DM * DIN + (size_t)k * DIN + DINP + j]; }
        VM_WAIT(); __syncthreads();
    }
    SEAM(0);
    if (IN(1)) {
        PHASE_PTRS
        int ln = lane; asm volatile("" : "+v"(ln));
        for (int row = gw; row < TT; row += 2 * NGW) { const int nv = (TT - row + NGW - 1) / NGW; xcvt_rows<2>(x_p, x_s, WF, bfg, Xb, out, 0, row, NGW, nv < 3 ? nv : 3, ln); }
    }
    SEAM(1);

    for (int l = 0; l < DEPTH; ++l) {
        const int pb = 2 + 8 * l;
        if (IN(pb + 0)) {
            PHASE_PTRS
            int td = tid; asm volatile("" : "+v"(td));
            { const int spare0 = (G > 0) ? (1440 % G) : 0, nspare = (spare0 > 0) ? G - spare0 : G;
              if ((int)blockIdx.x >= ((spare0 > 0) ? spare0 : 0)) for (int seq = (int)blockIdx.x - ((spare0 > 0) ? spare0 : 0); seq < 144; seq += nspare) cumsum_seq((LAS float*)lds, out, c_fl + (size_t)l * NB_S * PAST * NH, Fp, Fs, l, seq, td); }
            __syncthreads();
            pg8::Gemm g{Xb, WinT + (size_t)l * DINP * DM, TT, DINP, DM}; pg8::StaticOrder S; S.init(TT, DINP, DM, G, (int)blockIdx.x, false);
            pg8::EpiInP E{H, out, l};
            pg8::gemm_phase<pg8::EpiInP, pg8::StaticOrder, true, true>(lds, g, S, E);
            { const int spare0 = (G > 0) ? (1440 % G) : 0;
              if (spare0 > 0 && (int)blockIdx.x >= spare0) {
                  VM_WAIT(); __syncthreads();
                  LAS float* scr = (LAS float*)(lds + wave * 16384);
                  const int nsw = (G - spare0) * NWAVES;
                  for (int r = nsw - 1 - (((int)blockIdx.x - spare0) * NWAVES + wave); r < N_MV; r += nsw)
                      conv_item(l * CV_I_L + CV_I_IN + r, w_in, w_out, w_up, w_dn, w_ra, w_rx, WinT, WoutT, WupT, WdnT, WgT, scr, lane);
                  VM_WAIT(); __syncthreads();
              } }
        }
        SEAM(pb + 0);
        if (IN(pb + 1)) {
            constexpr int N_AT = 256 + 512 + 256 + 32 + 256 + 128;
            for (;;) {
                if (tid == 0) MISC[16] = atomicAdd((unsigned*)(KA()->ws + WS_CTL) + CW_QUEUE + 64 * (l + 2 * ((KA()->flags >> 1) & 7)), 1u);
                __syncthreads();
                const int item = __builtin_amdgcn_readfirstlane((int)MISC[16]);
                __syncthreads();
                if (item >= N_AT) break;
                int kind, j;
                if (item < 128) { kind = 0; j = item; }
                else if (item < 1056) { const int m = item - 128, per = m / 29, p = m - 29 * per, cs0 = (p * 16) / 29, cs1 = ((p + 1) * 16) / 29;
                    if (cs1 > cs0) { kind = 1; j = 16 * per + cs0; }
                    else { const int o = 13 * per + (p - cs0); if (o < 288) { kind = 2; j = o; } else { kind = 0; j = (o < 352) ? 128 + (o - 288) : 192 + (o - 352); } } }
                else if (item < 1312) { kind = 3; j = item - 1056; } else { kind = 4; j = item - 1312; }
#ifdef PROBE_PHASE
                { const int mask = (KA()->flags >> 8) & 255; if (mask && !((mask >> kind) & 1)) continue; }
#endif
                if (kind == 0) { PHASE_PTRS const AttnCtx Cfp{H, nullptr, nullptr, Fp, nullptr, OC, nullptr, nullptr, nullptr}; attn_item<0>(lds, Cfp, j & 15, 15 - (j >> 4), 0); }
                else if (kind == 1) { PHASE_PTRS const AttnCtx Cfs{H, c_fk + (size_t)l * NB_S * PAST * DB, c_fv + (size_t)l * NB_S * PAST * DB, Fs, nullptr, nullptr, PO, PM, PL};
                                      fox_sample_item(lds, Cfs, j >> 2, j & 3); }
                else if (kind == 2) { PHASE_PTRS const LruCtx CL{H, st_conv + (size_t)l * NB_S * 3 * DA, st_lru + (size_t)l * NB_S * DA, w_conv + (size_t)l * 4 * DA, b_conv + (size_t)l * DA, WgT + (size_t)l * 2 * 8 * HD * HD,
                                          b_ra + (size_t)l * DA, b_rx + (size_t)l * DA, lam + (size_t)l * DA, gmix + (size_t)l * DM, SA, SH, Y, out, l, NB_LRU, PF_LRU, nullptr, nullptr, (float*)(ws + WS_AA), (bf16_t*)(ws + WS_UU)};
                                      if (j < 256) lru_item2<false, true>(lds, CL, j); else lru_item2<true>(lds, CL, j); }
                else if (kind == 3) { PHASE_PTRS const AttnCtx Cbp{H, nullptr, nullptr, nullptr, relb + (size_t)l * NH * NREL, OB, nullptr, nullptr, nullptr};
                                      const int bh = j & 15; attn_item<1>(lds, Cbp, bh >> 2, 15 - (j >> 4), bh & 3); }
                else { PHASE_PTRS const AttnCtx Cbs{H, c_bk + (size_t)l * NB_S * BAND * DB, c_bv + (size_t)l * NB_S * BAND * DB, nullptr, relb + (size_t)l * NH * NREL, OB, nullptr, nullptr, nullptr};
                       attn_item<2>(lds, Cbs, j >> 2, j & 3, 0); }
            }
        }
        SEAM(pb + 1);
        if (IN(pb + 2)) {
            { PHASE_PTRS
              const LruCtx CL{H, st_conv + (size_t)l * NB_S * 3 * DA, st_lru + (size_t)l * NB_S * DA, w_conv + (size_t)l * 4 * DA, b_conv + (size_t)l * DA, WgT + (size_t)l * 2 * 8 * HD * HD,
                              b_ra + (size_t)l * DA, b_rx + (size_t)l * DA, lam + (size_t)l * DA, gmix + (size_t)l * DM, SA, SH, Y, out, l, NB_LRU, PF_LRU, LRU_STREAM ? nullptr : OB, LRU_STREAM ? nullptr : OC, (float*)(ws + WS_AA), (bf16_t*)(ws + WS_UU)};
              if constexpr (LRU_STREAM) { for (int chunk = blockIdx.x; chunk < 256; chunk += G) lru_pass2_stream(lds, CL, chunk); }
              else { for (int chunk = blockIdx.x; chunk < 256; chunk += G) lru_fin(lds, CL, chunk); } }
            { PHASE_PTRS
              int ln = lane; asm volatile("" : "+v"(ln));
              for (int row = (LRU_STREAM ? 0 : TP) + gw; row < TT; row += NGW) mixnorm_row(OA, OB, OC, PO, PM, PL, gmix + (size_t)l * DM, Y, false, row, ln); }
        }
        SEAM(pb + 2);
        for (int half = 0; half < 2; ++half) {
            if (IN(pb + 3 + 3 * half)) {
                PHASE_PTRS
                const int Kg = half ? DFF : DM;
                pg8::Gemm g{half ? HDN : Y, half ? WdnT + (size_t)l * DM * DFF : WoutT + (size_t)l * DM * DM, TT, DM, Kg}; pg8::StaticOrder S; const int rem2 = (G > 0) ? (576 % G) : 0; const bool fill2 = (half == 0) && rem2 > 0;
                S.init(TT, DM, Kg, G, (int)blockIdx.x, !fill2);
                pg8::EpiResP<true> E{Z, nullptr, nullptr, half ? X1b : Xb};
                pg8::gemm_phase<pg8::EpiResP<true>, pg8::StaticOrder, true, true>(lds, g, S, E, (float*)(ws + WS_SK), ctl + CW_SPLITK + (2 * l + half) * 64 * 16);
                if (fill2 && (int)blockIdx.x >= rem2) {
                    VM_WAIT(); __syncthreads();
                    LAS float* scr = (LAS float*)(lds + wave * 16384);
                    const int nsw = (G - rem2) * NWAVES;
                    const int nq = CV2_AN + (l == 0 ? CV2_BN : 0);
                    for (int q = ((int)blockIdx.x - rem2) * NWAVES + wave; q < nq; q += nsw)
                        conv_item(q < CV2_AN ? l * CV_I_L + CV2_A0 + q : CV2_B0 + (q - CV2_AN), w_in, w_out, w_up, w_dn, w_ra, w_rx, WinT, WoutT, WupT, WdnT, WgT, scr, lane);
                    VM_WAIT(); __syncthreads();
                }
            }
            SEAM(pb + 3 + 3 * half);
            if (IN(pb + 4 + 3 * half)) {
                PHASE_PTRS
                const bool nxt = half && (l + 1 < DEPTH), last = half && (l == DEPTH - 1);
                const float* gg = (half ? ln2g : ln1g) + (size_t)l * DM; const float* bb = (half ? ln2b : ln1b) + (size_t)l * DM;
                float* xf = last ? out + O_YP : nullptr; bf16_t* xbo = half ? (last ? nullptr : Xb) : X1b;
                int ln = lane; asm volatile("" : "+v"(ln));
                for (int row = gw; row < TT; row += 3 * NGW) { const int nv = (TT - row + NGW - 1) / NGW; int l2 = ln; asm volatile("" : "+v"(l2));
                    ln_rows<3>(Z, gg, bb, xf, xbo, nxt ? WF + (size_t)(l + 1) * 4 * DM : nullptr, nxt ? bfg + (l + 1) * NH : nullptr, out, l + 1, row, NGW, nv < 3 ? nv : 3, l2); }
            }
            SEAM(pb + 4 + 3 * half);
            if (half == 0) {
                if (IN(pb + 5)) {
                    PHASE_PTRS
                    pg8::Gemm g{X1b, WupT + (size_t)l * DFF * DM, TT, DFF, DM}; pg8::StaticOrder S; S.init(TT, DFF, DM, G, (int)blockIdx.x, false);
                    pg8::EpiUpP E{HDN};
                    pg8::gemm_phase<pg8::EpiUpP, pg8::StaticOrder, true, true>(lds, g, S, E);
                }
                SEAM(pb + 5);
            }
        }
    }
#undef IN
#undef SEAM
#undef PHASE_PTRS
#undef tid
#undef lane
#undef TIDF
}
extern "C" void kernel_launch(void* const* d_in, const int* in_sizes, int n_in, void* d_out, int out_size, void* d_ws, size_t ws_size, hipStream_t stream) {
    static int grid = 0;
    if (grid == 0) {
        if (n_in != 27 || (size_t)out_size != O_END || ws_size < WS_END) { fprintf(stderr, "kernel_launch: unexpected sizes n_in %d out %d ws %zu (need %zu)\n", n_in, out_size, ws_size, (size_t)WS_END); grid = -1; return; }
        int dev = 0, cus = 0, per_cu = 0;
        if (hipGetDevice(&dev) != hipSuccess || hipDeviceGetAttribute(&cus, hipDeviceAttributeMultiprocessorCount, dev) != hipSuccess) { grid = -1; return; }
        if (hipFuncSetAttribute((const void*)mk_fwd, hipFuncAttributeMaxDynamicSharedMemorySize, LDS_BYTES) != hipSuccess) { fprintf(stderr, "kernel_launch: hipFuncSetAttribute failed\n"); grid = -1; return; }
        if (hipOccupancyMaxActiveBlocksPerMultiprocessor(&per_cu, (const void*)mk_fwd, NTHREADS, LDS_BYTES) != hipSuccess || per_cu < 1) fprintf(stderr, "kernel_launch: occupancy query says %d\n", per_cu);
        (void)hipGetLastError();
        grid = cus;
    }
    if (grid < 0) return;
    (void)hipMemsetAsync((unsigned char*)d_ws + WS_CTL, 0, CTL_ZERO_BYTES, stream);
    Args a{};
    for (int i = 0; i < 27; ++i) a.in[i] = (const float*)d_in[i];
    a.out = (float*)d_out; a.ws = (unsigned char*)d_ws; a.ph_lo = 0; a.ph_hi = NPH; a.li = 0; a.flags = 0;
    hipLaunchKernelGGL(mk_fwd, dim3(grid), dim3(NTHREADS), LDS_BYTES, stream, a);
#ifdef PROBE_PHASE
    { Args p = a; p.ph_lo = PROBE_PHASE; p.ph_hi = PROBE_PHASE + 1; p.li = 1; p.flags = 2;
      for (int r = 0; r < PROBE_REPS; ++r) { p.flags = 2 + 4 * r + (PROBE_MASK << 8) + (PROBE_NB << 16) + (PROBE_SKIP << 24); hipLaunchKernelGGL(mk_fwd, dim3(grid), dim3(NTHREADS), LDS_BYTES, stream, p); } }
#endif
    const hipError_t le = hipPeekAtLastError();
    if (le != hipSuccess) fprintf(stderr, "kernel_launch: mk_fwd launch failed: %s\n", hipGetErrorName(le));
}
```

```cpp
#include <hip/hip_runtime.h>
#include <cstdio>
#include <cstdint>

typedef unsigned short bf16_t;

constexpr int DM = 2048, NB_P = 4, SEQ = 4096, DEPTH = 2, NB_S = 32, TS = 64, PAST = 4096;
constexpr int TP = NB_P * SEQ;
constexpr int TT = TP + NB_S * TS;
constexpr int DA = 1024, HD = 128, NH = 4, DB = 512, DIN = 5124, DINP = 5120, DFF = 8192, NREL = 513, BAND = 512;
constexpr int HP = DINP;
constexpr float ALPHA = 1.41421356237309515f, SCALE = 0.08838834764831845f, LN_EPS = 1e-5f, NEGBIG = -1e30f;
constexpr int C_AX = 0, C_AG = 1024, C_BQ = 2048, C_BK = 2560, C_BV = 3072, C_CQ = 3584, C_CK = 4096, C_CV = 4608;

constexpr size_t O_YP = 0;
constexpr size_t O_YS = O_YP + (size_t)NB_P * SEQ * DM;
constexpr size_t O_PCONV = O_YS + (size_t)NB_S * TS * DM;
constexpr size_t O_PLRU = O_PCONV + (size_t)DEPTH * NB_P * 3 * DA;
constexpr size_t O_PBK = O_PLRU + (size_t)DEPTH * NB_P * DA;
constexpr size_t O_PBV = O_PBK + (size_t)DEPTH * NB_P * BAND * DB;
constexpr size_t O_PFK = O_PBV + (size_t)DEPTH * NB_P * BAND * DB;
constexpr size_t O_PFV = O_PFK + (size_t)DEPTH * NB_P * SEQ * DB;
constexpr size_t O_PFL = O_PFV + (size_t)DEPTH * NB_P * SEQ * DB;
constexpr size_t O_SCONV = O_PFL + (size_t)DEPTH * NB_P * SEQ * NH;
constexpr size_t O_SLRU = O_SCONV + (size_t)DEPTH * NB_S * 3 * DA;
constexpr size_t O_SBK = O_SLRU + (size_t)DEPTH * NB_S * DA;
constexpr size_t O_SBV = O_SBK + (size_t)DEPTH * NB_S * TS * DB;
constexpr size_t O_SFK = O_SBV + (size_t)DEPTH * NB_S * TS * DB;
constexpr size_t O_SFV = O_SFK + (size_t)DEPTH * NB_S * TS * DB;
constexpr size_t O_SFL = O_SFV + (size_t)DEPTH * NB_S * TS * DB;
constexpr size_t O_END = O_SFL + (size_t)DEPTH * NB_S * TS * NH;
static_assert(O_END == 84328448ull, "output size");

constexpr size_t MiB = 1ull << 20;
constexpr size_t WS_CTL = 0;
constexpr size_t WS_WIN = 1 * MiB;
constexpr size_t WS_WOUT = WS_WIN + 40 * MiB;
constexpr size_t WS_WUP = WS_WOUT + 16 * MiB;
constexpr size_t WS_WDN = WS_WUP + 64 * MiB;
constexpr size_t WS_WF = WS_WDN + 64 * MiB;
constexpr size_t WS_XB = WS_WF + 1 * MiB;
constexpr size_t WS_X1F = WS_XB + 72 * MiB;
constexpr size_t WS_X1B = WS_X1F + 144 * MiB;
constexpr size_t WS_X2F = WS_X1B + 72 * MiB;
constexpr size_t WS_Z = WS_X2F + 144 * MiB;
constexpr size_t WS_H = WS_Z + 144 * MiB;
constexpr size_t WS_Y = WS_H + 186 * MiB;
constexpr size_t WS_HDN = WS_Y + 72 * MiB;
constexpr size_t WS_OB = WS_HDN + 288 * MiB;
constexpr size_t WS_OC = WS_OB + 36 * MiB;
constexpr size_t WS_FP = WS_OC + 36 * MiB;
constexpr size_t WS_FS = WS_FP + 1 * MiB;
constexpr size_t WS_OA = WS_FS + 3 * MiB;
constexpr size_t WS_XC = WS_OA + 72 * MiB;
constexpr size_t WS_AA = WS_XC + 72 * MiB;
constexpr size_t WS_UU = WS_AA + 72 * MiB;
constexpr size_t WS_WG = WS_UU + 72 * MiB;
constexpr size_t WS_PO = WS_WG + 1 * MiB;
constexpr size_t WS_PM = WS_PO + 16 * MiB;
constexpr size_t WS_PL = WS_PM + 1 * MiB;
constexpr size_t WS_SA = WS_PL + 1 * MiB;
constexpr size_t WS_SH = WS_SA + 1 * MiB;
constexpr size_t WS_SK = WS_SH + 1 * MiB;
constexpr size_t WS_END = WS_SK + 64 * MiB;
static_assert(WS_END <= 2048 * MiB, "workspace");

__device__ __forceinline__ float bf2f(bf16_t b) { return __uint_as_float(((unsigned)b) << 16); }
__device__ __forceinline__ float bflo(unsigned w) { return __uint_as_float(w << 16); }
__device__ __forceinline__ float bfhi(unsigned w) { return __uint_as_float(w & 0xffff0000u); }
__device__ __forceinline__ bf16_t f2bf(float f) { unsigned u = __float_as_uint(f); u += 0x7fffu + ((u >> 16) & 1u); return (bf16_t)(u >> 16); }
__device__ __forceinline__ float xshfl32(float v, int lane) { return __builtin_bit_cast(float, __builtin_amdgcn_ds_bpermute((lane ^ 32) << 2, __builtin_bit_cast(int, v))); }
__device__ __forceinline__ float wave_sum(float v) {
#define WS_DPP(x, ctrl, rmask) __builtin_bit_cast(float, __builtin_amdgcn_update_dpp(0, __builtin_bit_cast(int, (x)), (ctrl), (rmask), 0xF, false))
    v += WS_DPP(v, 0xB1, 0xF);
    v += WS_DPP(v, 0x4E, 0xF);
    v += WS_DPP(v, 0x141, 0xF);
    v += WS_DPP(v, 0x140, 0xF);
    v += WS_DPP(v, 0x142, 0xA);
    v += WS_DPP(v, 0x143, 0xC);
#undef WS_DPP
    return __builtin_bit_cast(float, __builtin_amdgcn_readlane(__builtin_bit_cast(int, v), 63));
}
__device__ __forceinline__ float wave_max(float v) {
#pragma unroll
    for (int o = 1; o < 64; o <<= 1) v = fmaxf(v, __shfl_xor(v, o));
    return v;
}
__device__ __forceinline__ float log_sigmoid_f(float z) { return fminf(z, 0.f) - log1pf(expf(-fabsf(z))); }
__device__ __forceinline__ float sigmoid_f(float z) { return 1.f / (1.f + expf(-z)); }
__device__ __forceinline__ float gelu_tanh_f(float x) { return 0.5f * x * (1.f + tanhf(0.7978845608028654f * (x + 0.044715f * x * x * x))); }
__device__ __forceinline__ const float* xrow0(const float* xp, const float* xs, int row) { return row < TP ? xp + (size_t)row * DM : xs + (size_t)(row - TP) * DM; }
__device__ __forceinline__ void row_bt(int row, bool& prm, int& b, int& t) { prm = row < TP; if (prm) { b = row >> 12; t = row & 4095; } else { const int r = row - TP; b = r >> 6; t = r & 63; } }

__device__ __forceinline__ float logf_get(const float* out, const float* cfl_l, int l, bool prm, int b, int h, int i) {
    if (prm) return out[O_PFL + ((size_t)(l * NB_P + b) * SEQ + i) * NH + h];
    if (i < PAST) return cfl_l[((size_t)b * PAST + i) * NH + h];
    return out[O_SFL + ((size_t)(l * NB_S + b) * TS + (i - PAST)) * NH + h];
}
namespace pg8 {
#define PG8_LAS __attribute__((address_space(3)))
typedef unsigned short bf16_t;
typedef short bf16x8 __attribute__((ext_vector_type(8)));
typedef float f32x4 __attribute__((ext_vector_type(4)));
typedef unsigned u32x4 __attribute__((ext_vector_type(4)));
constexpr int BM = 256, BK = 64, HALF = 128, HTB = HALF * BK * 2  , STAGE_BYTES = 8 * HTB, NXCD = 8, WGM = 8;

__host__ __device__ __forceinline__ int lds_byte(int r, int c) { const int st = (r >> 4) * 2 + (c >> 5), rr = r & 15, cc = c & 31, ob = rr * 64 + cc * 2; return st * 1024 + (ob ^ (((ob >> 9) & 1) << 5)); }
__host__ __device__ __forceinline__ void stage_rc(int b, int& R, int& C) { const int st = b / 1024, sb = b % 1024, swz = sb ^ (((sb >> 9) & 1) << 5); R = (st >> 1) * 16 + swz / 64; C = (st & 1) * 32 + (swz % 64) / 2; }
__host__ __device__ __forceinline__ int perm32(int rho) { const int n = rho >> 4, i = rho & 15; return 8 * (i >> 2) + 4 * n + (i & 3); }

struct Unit { int pm, pn, k0, nt, part, slot; };
struct Gemm { const bf16_t* A; const bf16_t* Bt; int M, N, K; };

struct StaticOrder {
    int nM, nN, nwg, G, c, ntk, R, SF;
    __host__ __device__ __forceinline__ void init(int M, int N, int K, int G_, int c_, bool split) {
        nM = M / BM; nN = N / BM; nwg = nM * nN; G = G_; c = c_; ntk = K / BK; R = nwg / G;
        const int rem = nwg - R * G; SF = rem ? 1 : 0;
        if (split && rem && (G % rem) == 0) { const int sf = G / rem; if (sf == 4 && (ntk % (2 * sf)) == 0 && ntk / sf >= 4) SF = sf; }
    }
    __host__ __device__ __forceinline__ Unit tile_of(int L, int k0, int nt, int part, int slot) const {
        int wgid = L; { const int q = nwg / NXCD, r = nwg % NXCD, xcd = wgid % NXCD, off = wgid / NXCD; wgid = (xcd < r ? xcd * (q + 1) : r * (q + 1) + (xcd - r) * q) + off; }
        const int nig = WGM * nN, gid = wgid / nig, fm = gid * WGM, gsz = (nM - fm) < WGM ? (nM - fm) : WGM;
        return Unit{fm + ((wgid % nig) % gsz), (wgid % nig) / gsz, k0, nt, part, slot};
    }
    __host__ __device__ __forceinline__ Unit next(int i) const {
        if (SF >= 2) {
            if (i == 0) { const int j = c / SF, part = c % SF, ntp = ntk / SF; return tile_of(R * G + j, part * ntp, ntp, part, j); }
            if (i <= R) return tile_of((i - 1) * G + c, 0, ntk, -1, 0);
            return Unit{0, 0, 0, 0, -1, 0};
        }
        if (i < R) return tile_of(i * G + c, 0, ntk, -1, 0);
        if (i > R || SF == 0) return Unit{0, 0, 0, 0, -1, 0};
        { const int L = R * G + c; if (L >= nwg) return Unit{0, 0, 0, 0, -1, 0}; return tile_of(L, 0, ntk, -1, 0); }
    }
    __device__ __forceinline__ void a_ready(const Unit&) const {}
    __device__ __forceinline__ void done(const Unit&) const {}
};
typedef unsigned u32x2 __attribute__((ext_vector_type(2)));
__device__ __forceinline__ unsigned cvt_pk_bf16(float lo, float hi) { unsigned r; asm volatile("v_cvt_pk_bf16_f32 %0, %1, %2" : "=v"(r) : "v"(lo), "v"(hi)); return r; }

struct EpiInP {
    static constexpr bool PERM = true, AFTER_DRAIN = false, HAS_FRAG = false;
    bf16_t* H; float* out; int l;
    __device__ __forceinline__ void operator()(const f32x4 (&acc)[2][2][4][2], const Unit& u, int wr, int wc, int fr, int fq) const {
        const int pn = u.pn, pm = u.pm;
        const bool prm = pm < 64;
        const int ccol = (pn & 1) * 256 + wc * 32 + 8 * fq;
        const int col0 = pn * 256 + wc * 32 + 8 * fq;
        const int kind = (pn < 4) ? 3 : ((pn >= 10 && pn < 14) ? 1 : ((pn >= 16) ? 2 : 0));
        const bool isv = (kind == 1) ? (pn >= 12) : (pn >= 18);
#pragma unroll
        for (int ai = 0; ai < 2; ++ai)
#pragma unroll
            for (int m = 0; m < 4; ++m) {
                const int rloc = ai * 128 + wr * 64 + m * 16 + fr;
                const int row = pm * 256 + rloc;
                int b, t; if (prm) { b = pm >> 4; t = (pm & 15) * 256 + rloc; } else { const int r = row - TP; b = r >> 6; t = r & 63; }
                float* fp = nullptr;
                if (kind == 1) { if (prm) { if (t >= SEQ - BAND) fp = out + (isv ? O_PBV : O_PBK) + ((size_t)(l * NB_P + b) * BAND + (t - (SEQ - BAND))) * DB + ccol; }
                                 else fp = out + (isv ? O_SBV : O_SBK) + ((size_t)(l * NB_S + b) * TS + t) * DB + ccol; }
                else if (kind == 2) { if (prm) fp = out + (isv ? O_PFV : O_PFK) + ((size_t)(l * NB_P + b) * SEQ + t) * DB + ccol;
                                      else fp = out + (isv ? O_SFV : O_SFK) + ((size_t)(l * NB_S + b) * TS + t) * DB + ccol; }
                else if (kind == 3) { if (prm) { if (t >= SEQ - 3) fp = out + O_PCONV + ((size_t)(l * NB_P + b) * 3 + (t - (SEQ - 3))) * DA + col0; }
                                      else { if (t >= TS - 3) fp = out + O_SCONV + ((size_t)(l * NB_S + b) * 3 + (t - (TS - 3))) * DA + col0; } }
                bf16_t* hp = H + (size_t)row * HP + col0;
#pragma unroll
                for (int bj = 0; bj < 2; ++bj) {
                    const f32x4 v0 = acc[ai][bj][m][0], v1 = acc[ai][bj][m][1];
                    u32x4 w; w.x = cvt_pk_bf16(v0[0], v0[1]); w.y = cvt_pk_bf16(v0[2], v0[3]); w.z = cvt_pk_bf16(v1[0], v1[1]); w.w = cvt_pk_bf16(v1[2], v1[3]);
                    *(u32x4*)(hp + bj * HALF) = w;
                    if (fp) { *(f32x4*)(fp + bj * HALF) = v0; *(f32x4*)(fp + bj * HALF + 4) = v1; }
                }
            }
    }
};
template <bool XB16> struct EpiResP {
    static constexpr bool PERM = true, AFTER_DRAIN = false, HAS_FRAG = true;
    bf16_t* Z; const float* xa; const float* xb; const bf16_t* xh;
    __device__ __forceinline__ f32x4 xload(const Unit& u, size_t o) const {
        if constexpr (XB16) { const unsigned long long w = *(const unsigned long long*)(xh + (size_t)u.pm * BM * DM + o); const unsigned lo = (unsigned)w, hi = (unsigned)(w >> 32);
                              return (f32x4){__uint_as_float(lo << 16), __uint_as_float(lo & 0xffff0000u), __uint_as_float(hi << 16), __uint_as_float(hi & 0xffff0000u)}; }
        else { const float* xbase = (u.pm < TP / BM) ? xa + (size_t)u.pm * BM * DM : xb + (size_t)(u.pm - TP / BM) * BM * DM; return *(const f32x4*)(xbase + o); }
    }
    __device__ __forceinline__ void frag(const f32x4 v, const Unit& u, int ai, int bj, int m, int n, int wr, int wc, int fr, int fq) const {
        const size_t o = (size_t)(wr * 64 + fr + ai * HALF + m * 16) * DM + u.pn * BM + wc * 32 + 8 * fq + bj * HALF + 4 * n;
        const f32x4 r = xload(u, o) * ALPHA + v;
        u32x2 w; w.x = cvt_pk_bf16(r[0], r[1]); w.y = cvt_pk_bf16(r[2], r[3]);
        *(u32x2*)(Z + (size_t)u.pm * BM * DM + o) = w;
    }
    __device__ __forceinline__ void operator()(const f32x4 (&acc)[2][2][4][2], const Unit& u, int wr, int wc, int fr, int fq) const {
        const int rloc0 = wr * 64 + fr, col0 = u.pn * BM + wc * 32 + 8 * fq;
        bf16_t* zbase = Z + (size_t)u.pm * BM * DM;
#pragma unroll
        for (int ai = 0; ai < 2; ++ai)
#pragma unroll
            for (int m = 0; m < 4; ++m) {
                const size_t ro = (size_t)(rloc0 + ai * HALF + m * 16) * DM + col0;
#pragma unroll
                for (int bj = 0; bj < 2; ++bj) {
                    const f32x4 r0 = xload(u, ro + bj * HALF) * ALPHA + acc[ai][bj][m][0], r1 = xload(u, ro + bj * HALF + 4) * ALPHA + acc[ai][bj][m][1];
                    u32x4 w; w.x = cvt_pk_bf16(r0[0], r0[1]); w.y = cvt_pk_bf16(r0[2], r0[3]); w.z = cvt_pk_bf16(r1[0], r1[1]); w.w = cvt_pk_bf16(r1[2], r1[3]);
                    *(u32x4*)(zbase + ro + bj * HALF) = w;
                }
            }
    }
};
struct EpiUpP {
    static constexpr bool PERM = true, AFTER_DRAIN = false, HAS_FRAG = false;
    bf16_t* HDN;
    __device__ __forceinline__ void operator()(const f32x4 (&acc)[2][2][4][2], const Unit& u, int wr, int wc, int fr, int fq) const {
        const int row0 = u.pm * BM + wr * 64 + fr, col0 = u.pn * BM + wc * 32 + 8 * fq;
#pragma unroll
        for (int ai = 0; ai < 2; ++ai)
#pragma unroll
            for (int m = 0; m < 4; ++m) {
                bf16_t* rowp = HDN + (size_t)(row0 + ai * HALF + m * 16) * DFF + col0;
#pragma unroll
                for (int bj = 0; bj < 2; ++bj) {
                    f32x4 v0 = acc[ai][bj][m][0], v1 = acc[ai][bj][m][1];
#pragma unroll
                    for (int j = 0; j < 4; ++j) { const float a = fmaxf(v0[j], 0.f), b = fmaxf(v1[j], 0.f); v0[j] = a * a; v1[j] = b * b; }
                    u32x4 w; w.x = cvt_pk_bf16(v0[0], v0[1]); w.y = cvt_pk_bf16(v0[2], v0[3]); w.z = cvt_pk_bf16(v1[0], v1[1]); w.w = cvt_pk_bf16(v1[2], v1[3]);
                    *(u32x4*)(rowp + bj * HALF) = w;
                }
            }
    }
};
#ifdef PROBE_PLAIN_SLAB
#define SK_AUX 0
#else
#define SK_AUX 16
#endif
template <class Epi, class Sched, bool ALIGN_EPI = false, bool SP2 = false>
__device__ __forceinline__ void gemm_phase(PG8_LAS unsigned char* lds, const Gemm g, const Sched& S, const Epi& E, float* sk_slab = nullptr, unsigned* sk_cnt = nullptr) {
    int tid_ = threadIdx.x; asm volatile("" : "+v"(tid_));
    const int tid = tid_, wid = __builtin_amdgcn_readfirstlane(tid >> 6), lane = tid & 63, wr = wid >> 2, wc = wid & 3, fr = lane & 15, fq = lane >> 4;
    const int K = g.K;
    unsigned voffA[2], voffB[2];
#pragma unroll
    for (int i = 0; i < 2; ++i) { int R, C; stage_rc(tid * 16 + i * 8192, R, C); const int Rb = Epi::PERM ? ((R & ~31) + perm32(R & 31)) : R;
        voffA[i] = (unsigned)(R * K + C) * 2u; voffB[i] = (unsigned)(Rb * K + C) * 2u; }
    const size_t kstep = (size_t)(BK * 2);
    const size_t hstep = (size_t)HALF * K * 2;
    const size_t tstep = 2 * hstep;
    const unsigned ldsw = (unsigned)wid * 1024u;
    const int aoff = lds_byte(wr * 64 + fr, fq * 8), boff = lds_byte(wc * 32 + fr, fq * 8);
#define PG8_SA(b, h) (((b) * 2 + (h)) * HTB)
#define PG8_SB(b, h) ((4 + (b) * 2 + (h)) * HTB)
#define PG8_STAGE(bufoff, gbase, voff) do { _Pragma("unroll") for (int _i = 0; _i < 2; ++_i) \
        __builtin_amdgcn_global_load_lds((const unsigned*)((const char*)(gbase) + (voff)[_i]), (PG8_LAS unsigned*)(lds + (bufoff) + ldsw + _i * 8192), 16, 0, 0); } while (0)
#define PG8_LDA(dst, b, h) do { _Pragma("unroll") for (int m = 0; m < 4; ++m) _Pragma("unroll") for (int k = 0; k < 2; ++k) dst[m][k] = *(const PG8_LAS bf16x8*)(lds + PG8_SA(b, h) + aoff + m * 2048 + k * 1024); } while (0)
#define PG8_LDB(dst, b, h) do { _Pragma("unroll") for (int n = 0; n < 2; ++n) _Pragma("unroll") for (int k = 0; k < 2; ++k) dst[n][k] = *(const PG8_LAS bf16x8*)(lds + PG8_SB(b, h) + boff + n * 2048 + k * 1024); } while (0)
#define PG8_MMA(ai, bj, At, Bt) do { __builtin_amdgcn_s_setprio(1); _Pragma("unroll") for (int m = 0; m < 4; ++m) _Pragma("unroll") for (int n = 0; n < 2; ++n) _Pragma("unroll") for (int k = 0; k < 2; ++k) \
        acc[ai][bj][m][n] = __builtin_amdgcn_mfma_f32_16x16x32_bf16(Bt[n][k], At[m][k], acc[ai][bj][m][n], 0, 0, 0); __builtin_amdgcn_s_setprio(0); } while (0)
#define PG8_WAIT_V(n) asm volatile("s_waitcnt vmcnt(" #n ")" ::: "memory")
#define PG8_WAIT_L(n) asm volatile("s_waitcnt lgkmcnt(" #n ")" ::: "memory")
#define PG8_BAR __builtin_amdgcn_s_barrier()
#define PG8_SCHED __builtin_amdgcn_sched_barrier(0)
    int ui = 0;
    Unit cur = S.next(0), nxt = cur;
    if (cur.nt == 0) return;
    const Unit first = cur;
    f32x4 acc[2][2][4][2];
#pragma unroll
    for (int a = 0; a < 2; ++a)
#pragma unroll
        for (int b = 0; b < 2; ++b)
#pragma unroll
            for (int m = 0; m < 4; ++m)
#pragma unroll
                for (int n = 0; n < 2; ++n) acc[a][b][m][n] = (f32x4){0.f, 0.f, 0.f, 0.f};
    bf16x8 At[4][2], B0[2][2], B1[2][2];
    const char* cA = (const char*)g.A + (size_t)cur.pm * tstep + (size_t)cur.k0 * kstep; const char* cB = (const char*)g.Bt + (size_t)cur.pn * tstep + (size_t)cur.k0 * kstep;
    S.a_ready(cur);
    if constexpr (SP2) {
        PG8_STAGE(PG8_SB(0, 0), cB, voffB); PG8_STAGE(PG8_SB(0, 1), cB + hstep, voffB); PG8_STAGE(PG8_SA(0, 0), cA, voffA); PG8_STAGE(PG8_SA(0, 1), cA + hstep, voffA);
        if (wr == 1) PG8_BAR;
        PG8_WAIT_V(2); PG8_BAR;
        PG8_STAGE(PG8_SB(1, 0), cB + kstep, voffB); PG8_STAGE(PG8_SA(1, 0), cA + kstep, voffA); PG8_STAGE(PG8_SB(1, 1), cB + hstep + kstep, voffB);
        PG8_WAIT_V(6); PG8_BAR;
    } else {
        PG8_STAGE(PG8_SB(0, 0), cB, voffB); PG8_STAGE(PG8_SA(0, 0), cA, voffA); PG8_STAGE(PG8_SB(0, 1), cB + hstep, voffB); PG8_STAGE(PG8_SA(0, 1), cA + hstep, voffA);
        if (wr == 1) PG8_BAR;
        PG8_WAIT_V(4); PG8_BAR;
        PG8_STAGE(PG8_SB(1, 0), cB + kstep, voffB); PG8_STAGE(PG8_SA(1, 0), cA + kstep, voffA); PG8_STAGE(PG8_SB(1, 1), cB + hstep + kstep, voffB);
        PG8_WAIT_V(6); PG8_BAR;
    }
    for (;;) {
        nxt = S.next(ui + 1); const bool has_next = nxt.nt != 0;
        const char* nA = has_next ? (const char*)g.A + (size_t)nxt.pm * tstep + (size_t)nxt.k0 * kstep : cA; const char* nB = has_next ? (const char*)g.Bt + (size_t)nxt.pn * tstep + (size_t)nxt.k0 * kstep : cB;
        const int nt = cur.nt;
        for (int t = 0; t < nt; t += 2) {
            const bool last = (t == nt - 2);
            const char* a1 = cA + (size_t)(t + 1) * kstep;
            const char* a2 = last ? nA : cA + (size_t)(t + 2) * kstep; const char* b2 = last ? nB : cB + (size_t)(t + 2) * kstep;
            const char* a3 = a2 + kstep; const char* b3 = b2 + kstep;
            if (last && has_next) S.a_ready(nxt);
            if constexpr (SP2) {
            PG8_LDB(B0, 0, 0); PG8_LDB(B1, 0, 1); PG8_SCHED; PG8_LDA(At, 0, 0); PG8_STAGE(PG8_SA(1, 1), a1 + hstep, voffA);
            PG8_WAIT_V(8); PG8_WAIT_L(0); PG8_BAR; PG8_MMA(0, 0, At, B0); PG8_MMA(0, 1, At, B1); PG8_BAR; PG8_SCHED;
            PG8_LDA(At, 0, 1); PG8_STAGE(PG8_SB(0, 0), b2, voffB); PG8_STAGE(PG8_SB(0, 1), b2 + hstep, voffB); PG8_STAGE(PG8_SA(0, 0), a2, voffA);
            PG8_WAIT_V(8); PG8_WAIT_L(0); PG8_BAR; PG8_MMA(1, 0, At, B0); PG8_MMA(1, 1, At, B1); PG8_BAR; PG8_SCHED;
            PG8_LDB(B0, 1, 0); PG8_LDB(B1, 1, 1); PG8_SCHED; PG8_LDA(At, 1, 0); PG8_STAGE(PG8_SA(0, 1), a2 + hstep, voffA);
            PG8_WAIT_V(8); PG8_WAIT_L(0); PG8_BAR; PG8_MMA(0, 0, At, B0); PG8_MMA(0, 1, At, B1); PG8_BAR; PG8_SCHED;
            PG8_LDA(At, 1, 1); PG8_STAGE(PG8_SB(1, 0), b3, voffB); PG8_STAGE(PG8_SB(1, 1), b3 + hstep, voffB); PG8_STAGE(PG8_SA(1, 0), a3, voffA);
            PG8_WAIT_V(8); PG8_WAIT_L(0); PG8_BAR; PG8_MMA(1, 0, At, B0); PG8_MMA(1, 1, At, B1); PG8_BAR; PG8_SCHED;
            } else {
            PG8_LDB(B0, 0, 0); PG8_SCHED; PG8_LDA(At, 0, 0); PG8_STAGE(PG8_SA(1, 1), a1 + hstep, voffA);
            PG8_WAIT_L(8); PG8_BAR; PG8_WAIT_L(0); PG8_MMA(0, 0, At, B0); PG8_BAR; PG8_SCHED;
            PG8_LDB(B1, 0, 1); PG8_STAGE(PG8_SB(0, 0), b2, voffB);
            PG8_BAR; PG8_WAIT_L(0); PG8_MMA(0, 1, At, B1); PG8_BAR;
            PG8_LDA(At, 0, 1); PG8_STAGE(PG8_SA(0, 0), a2, voffA);
            PG8_BAR; PG8_WAIT_L(0); PG8_MMA(1, 0, At, B0); PG8_BAR; PG8_SCHED;
            PG8_STAGE(PG8_SB(0, 1), b2 + hstep, voffB);
            PG8_WAIT_V(6); PG8_BAR; PG8_MMA(1, 1, At, B1); PG8_BAR;
            PG8_LDB(B0, 1, 0); PG8_SCHED; PG8_LDA(At, 1, 0); PG8_STAGE(PG8_SA(0, 1), a2 + hstep, voffA);
            PG8_WAIT_L(8); PG8_BAR; PG8_WAIT_L(0); PG8_MMA(0, 0, At, B0); PG8_BAR; PG8_SCHED;
            PG8_LDB(B1, 1, 1); PG8_STAGE(PG8_SB(1, 0), b3, voffB);
            PG8_BAR; PG8_WAIT_L(0); PG8_MMA(0, 1, At, B1); PG8_BAR;
            PG8_LDA(At, 1, 1); PG8_STAGE(PG8_SA(1, 0), a3, voffA);
            PG8_BAR; PG8_WAIT_L(0); PG8_MMA(1, 0, At, B0); PG8_BAR; PG8_SCHED;
            PG8_STAGE(PG8_SB(1, 1), b3 + hstep, voffB);
            PG8_WAIT_V(6); PG8_BAR; PG8_MMA(1, 1, At, B1); PG8_BAR;
            }
        }
        if constexpr (ALIGN_EPI) { if (wr == 0) PG8_BAR; }
        if constexpr (!Epi::AFTER_DRAIN) {
            if (cur.part < 0) E(acc, cur, wr, wc, fr, fq);
            else {
                const __amdgpu_buffer_rsrc_t rs = __builtin_amdgcn_make_buffer_rsrc((void*)((char*)sk_slab + ((size_t)cur.slot * 4 + cur.part) * (BM * BM * 2)), (short)0, BM * BM * 2, 0x00020000);
#pragma unroll
                for (int a = 0; a < 2; ++a)
#pragma unroll
                    for (int b = 0; b < 2; ++b)
#pragma unroll
                        for (int m = 0; m < 4; ++m) {
                            const f32x4 v0 = acc[a][b][m][0], v1 = acc[a][b][m][1];
                            u32x4 w; w.x = cvt_pk_bf16(v0[0], v0[1]); w.y = cvt_pk_bf16(v0[2], v0[3]); w.z = cvt_pk_bf16(v1[0], v1[1]); w.w = cvt_pk_bf16(v1[2], v1[3]);
                            __builtin_amdgcn_raw_buffer_store_b128(w, rs, tid * 16, (((a * 2 + b) * 4 + m) * 512) * 16, SK_AUX);
                        }
                asm volatile("s_waitcnt vmcnt(0)" ::: "memory");
                if (lane == 0) __hip_atomic_fetch_add(sk_cnt + 16 * cur.slot, 1u, __ATOMIC_RELAXED, __HIP_MEMORY_SCOPE_AGENT);
            }
            S.done(cur); }
        if (!has_next) break;
#pragma unroll
        for (int a = 0; a < 2; ++a)
#pragma unroll
            for (int b = 0; b < 2; ++b)
#pragma unroll
                for (int m = 0; m < 4; ++m)
#pragma unroll
                    for (int n = 0; n < 2; ++n) acc[a][b][m][n] = (f32x4){0.f, 0.f, 0.f, 0.f};
        cur = nxt; cA = nA; cB = nB; ++ui;
        if constexpr (ALIGN_EPI) { if (wr == 1) PG8_BAR; }
    }
    PG8_WAIT_V(0);
    if constexpr (!ALIGN_EPI) { if (wr == 0) PG8_BAR; }
    PG8_BAR;
    if constexpr (Epi::AFTER_DRAIN) { E.fused(acc, cur, wr, wc, fr, fq, lds, wid, lane); S.done(cur); }
    if constexpr (Epi::HAS_FRAG) {
        if (first.part >= 0) {
            if (wid == 0) {
                unsigned spins = 0;
                while ((unsigned)__builtin_amdgcn_readfirstlane(__hip_atomic_load(sk_cnt + 16 * first.slot, __ATOMIC_RELAXED, __HIP_MEMORY_SCOPE_AGENT)) < 32u) { __builtin_amdgcn_s_sleep(2); if (++spins > (1u << 22)) break; }
                __builtin_amdgcn_fence(__ATOMIC_ACQUIRE, "agent");
                asm volatile("s_waitcnt vmcnt(0)" ::: "memory");
            }
            asm volatile("" ::: "memory"); PG8_BAR; asm volatile("" ::: "memory");
            const __amdgpu_buffer_rsrc_t rs4 = __builtin_amdgcn_make_buffer_rsrc((void*)((char*)sk_slab + (size_t)first.slot * 4 * (BM * BM * 2)), (short)0, 4 * BM * BM * 2, 0x00020000);
            const int a = first.part >> 1, b = first.part & 1;
            u32x4 pv[4][4];
#pragma unroll
            for (int m = 0; m < 4; ++m)
#pragma unroll
                for (int q = 0; q < 4; ++q) pv[m][q] = __builtin_amdgcn_raw_buffer_load_b128(rs4, tid * 16, (((a * 2 + b) * 4 + m) * 512) * 16 + q * (BM * BM * 2), 0);
            __builtin_amdgcn_sched_barrier(0);
#pragma unroll
            for (int m = 0; m < 4; ++m) {
                f32x4 v0 = (f32x4){0.f, 0.f, 0.f, 0.f}, v1 = v0;
#pragma unroll
                for (int q = 0; q < 4; ++q) { const u32x4 w = pv[m][q];
                    v0 += (f32x4){__uint_as_float(w.x << 16), __uint_as_float(w.x & 0xffff0000u), __uint_as_float(w.y << 16), __uint_as_float(w.y & 0xffff0000u)};
                    v1 += (f32x4){__uint_as_float(w.z << 16), __uint_as_float(w.z & 0xffff0000u), __uint_as_float(w.w << 16), __uint_as_float(w.w & 0xffff0000u)}; }
                E.frag(v0, first, a, b, m, 0, wr, wc, fr, fq); E.frag(v1, first, a, b, m, 1, wr, wc, fr, fq);
            }
        }
    }
#undef PG8_SA
#undef PG8_SB
#undef PG8_STAGE
#undef PG8_LDA
#undef PG8_LDB
#undef PG8_MMA
#undef PG8_WAIT_V
#undef PG8_WAIT_L
#undef PG8_BAR
#undef PG8_SCHED
}
}
#define GAS __attribute__((address_space(1)))
#define LAS __attribute__((address_space(3)))
typedef float f32x4 __attribute__((ext_vector_type(4)));
typedef unsigned u32x2 __attribute__((ext_vector_type(2)));
typedef unsigned u32x4 __attribute__((ext_vector_type(4)));
constexpr int NWAVES = 8, NTHREADS = 512;
#define LDS_WAIT() asm volatile("s_waitcnt lgkmcnt(0)" ::: "memory")
#define VM_WAIT() asm volatile("s_waitcnt vmcnt(0)" ::: "memory")
constexpr int RING_BYTES = 145408;
constexpr int MISC_OFF = RING_BYTES + 320;
constexpr int LDS_BYTES = 147456;
#define XB_TMO      128
#define XB_XCNT(j)  (256  + 64 * (j))
#define XB_XSUB(j)  (1280 + 64 * (j))
#define XB_XGEN(j)  (2304 + 64 * (j))
#define XB_TOP      3328
#define XB_TOPGEN   3392
#define XCD_BAR_WORDS 3456
#define XB_SPIN_CAP (1u << 18)

__device__ __forceinline__ unsigned xb_ld(unsigned* p)              { return __hip_atomic_load(p, __ATOMIC_RELAXED, __HIP_MEMORY_SCOPE_AGENT); }
__device__ __forceinline__ unsigned xb_add(unsigned* p, unsigned v) { return __hip_atomic_fetch_add(p, v, __ATOMIC_RELAXED, __HIP_MEMORY_SCOPE_AGENT); }
__device__ __forceinline__ unsigned xb_xcc_id() { return (unsigned)__builtin_amdgcn_s_getreg((3 << 11) | 20) & 0xFu; }
#define XB_SPIN(cond, bar) do { unsigned _sp = 0; while (cond) { __builtin_amdgcn_s_sleep(1); \
    if ((++_sp & 255u) == 0u) { if (xb_ld(&(bar)[XB_TMO])) break; if (_sp > XB_SPIN_CAP) { atomicAdd(&(bar)[XB_TMO], 1u); break; } } } } while (0)

struct XcdBarrier {
    unsigned* bar; unsigned x;
    volatile LAS unsigned* st;
};

__device__ __forceinline__ XcdBarrier xcd_barrier_post(unsigned* bar, volatile LAS unsigned* st) {
    XcdBarrier b; b.bar = bar; b.x = xb_xcc_id(); b.st = st;
    if (threadIdx.x == 0) (void)xb_add(&bar[XB_XCNT(b.x)], 1u);
    return b;
}
__device__ __forceinline__ void xcd_barrier_complete(unsigned* bar, unsigned x, unsigned& nloc, unsigned& nx) {
    const unsigned G = gridDim.x * gridDim.y * gridDim.z;
    unsigned sum, cnt, mine, sp = 0u;
    for (;;) {
        sum = 0u; cnt = 0u; mine = 0u;
#pragma unroll
        for (unsigned j = 0; j < 16; ++j) { const unsigned c = xb_ld(&bar[XB_XCNT(j)]); sum += c; cnt += (c > 0u) ? 1u : 0u; mine = (j == x) ? c : mine; }
        if (sum == G) break;
        __builtin_amdgcn_s_sleep(1);
        if ((++sp & 255u) == 0u) { if (xb_ld(&bar[XB_TMO])) break; if (sp > XB_SPIN_CAP) { atomicAdd(&bar[XB_TMO], 1u); break; } }
    }
    nloc = mine > 0u ? mine : 1u; nx = cnt > 0u ? cnt : 1u;
}

__device__ __forceinline__ void xcd_barrier(const XcdBarrier& b) {
    asm volatile("s_waitcnt vmcnt(0)" ::: "memory");
    __syncthreads();
    if (threadIdx.x == 0) {
        unsigned* bar = b.bar;
        __builtin_amdgcn_s_waitcnt(0);
        unsigned nloc = b.st[0], nx = b.st[1];
        if (nloc == 0u) { xcd_barrier_complete(bar, b.x, nloc, nx); b.st[0] = nloc; b.st[1] = nx; }
        const unsigned old = xb_add(&bar[XB_XSUB(b.x)], 1u);
        const unsigned gen = old / nloc;
        if (old + 1u == (gen + 1u) * nloc) {
            __builtin_amdgcn_fence(__ATOMIC_RELEASE, "agent");
            asm volatile("s_waitcnt vmcnt(0)" ::: "memory");
            const unsigned og = xb_add(&bar[XB_TOP], 1u);
            const unsigned tg = og / nx;
            if (og + 1u == (tg + 1u) * nx) xb_add(&bar[XB_TOPGEN], 1u);
            else XB_SPIN(xb_ld(&bar[XB_TOPGEN]) == tg, bar);
            __builtin_amdgcn_fence(__ATOMIC_ACQUIRE, "agent");
            xb_add(&bar[XB_XGEN(b.x)], 1u);
            asm volatile("s_waitcnt vmcnt(0)" ::: "memory");
        } else {
            XB_SPIN(xb_ld(&bar[XB_XGEN(b.x)]) == gen, bar);
            __builtin_amdgcn_fence(__ATOMIC_ACQUIRE, "agent");
            asm volatile("s_waitcnt vmcnt(0)" ::: "memory");
        }
    }
    __syncthreads();
}
typedef short bf16x8 __attribute__((ext_vector_type(8)));
typedef short s16x4 __attribute__((ext_vector_type(4)));
typedef float f32x16 __attribute__((ext_vector_type(16)));
typedef float f32x2 __attribute__((ext_vector_type(2)));
typedef float f32x8v __attribute__((ext_vector_type(8)));
typedef __bf16 bfv2 __attribute__((ext_vector_type(2)));
constexpr float LOG2E = 1.4426950408889634f;
constexpr float QSCALE = SCALE * LOG2E;
constexpr int KS = 272, VS = 320;
constexpr int KTILE = 64 * KS, VTILE = 64 * VS;
constexpr int AT_K = 0, AT_V = 2 * KTILE, AT_FK = AT_V + 2 * VTILE, AT_REL = AT_FK + 512, AT_Q = AT_REL + 2064 + 48, AT_END = AT_Q + 16384;
static_assert(AT_END <= 131072 && AT_Q % 16 == 0, "attention LDS map");
constexpr int NSPLIT = 4;

__device__ __forceinline__ unsigned pkbf(float a, float b) { const f32x2 v = {a, b}; return __builtin_bit_cast(unsigned, __builtin_convertvector(v, bfv2)); }
__device__ __forceinline__ int off_b(int row, int ch) { return 256 * row + 16 * (ch ^ (((row & 3) << 2) | ((row >> 2) & 3))); }
__device__ __forceinline__ s16x4 tr_read4(const LAS unsigned char* p) { return __builtin_amdgcn_ds_read_tr16_b64_v4i16((LAS s16x4*)p); }
#define MFMA32(a, b, c) __builtin_amdgcn_mfma_f32_32x32x16_bf16((a), (b), (c), 0, 0, 0)

struct AttnCtx {
    const bf16_t* H; const float* ck; const float* cv;
    const float* F;
    const float* relb;
    bf16_t* O;
    float* PO; float* PM; float* PL;
};

struct TileRegs { f32x4 k0a, k0b, k1a, k1b, v0a, v0b, v1a, v1b; float fkr; };
struct TileGeo { int b, h, bh, kbase_row, kcol, vcol, tlast_new, ncache; };
template <int KIND>
__device__ __forceinline__ void tile_load1(f32x4& ka, f32x4& kb2, f32x4& va, f32x4& vb2, const AttnCtx& C, const TileGeo& G, int t, int c) {
    constexpr bool F32SRC = (KIND == 2 || KIND == 3);
    const int row = c >> 4, ch = c & 15;
    bool f32t = false;
    if constexpr (F32SRC) f32t = (t != G.tlast_new);
    if (f32t) {
        const size_t e = (((size_t)G.b * G.ncache + 64 * t + row) * NH + G.h) * HD + ch * 8;
        ka = *(const f32x4*)(C.ck + e); kb2 = *(const f32x4*)(C.ck + e + 4);
        va = *(const f32x4*)(C.cv + e); vb2 = *(const f32x4*)(C.cv + e + 4);
    } else {
        int hrow;
        if constexpr (KIND == 0 || KIND == 1) hrow = G.kbase_row + 64 * t + row; else hrow = TP + G.b * TS + row;
        const bf16_t* hp = C.H + (size_t)hrow * HP + ch * 8;
        ka = *(const f32x4*)(hp + G.kcol); va = *(const f32x4*)(hp + G.vcol);
    }
}
template <int KIND>
__device__ __forceinline__ void tile_load(TileRegs& TR, const AttnCtx& C, const TileGeo& G, int t, int tid) {
    constexpr bool FOX = (KIND == 0 || KIND == 3);
    tile_load1<KIND>(TR.k0a, TR.k0b, TR.v0a, TR.v0b, C, G, t, tid);
    tile_load1<KIND>(TR.k1a, TR.k1b, TR.v1a, TR.v1b, C, G, t, tid + 512);
    if constexpr (FOX) { if (tid < 64) TR.fkr = C.F[(size_t)G.bh * (KIND == 0 ? SEQ : PAST + TS) + 64 * t + tid]; }
}
template <int KIND, int KOFF = AT_K, int VOFF = AT_V>
__device__ __forceinline__ void tile_store1(const f32x4& ka, const f32x4& kb2, const f32x4& va, const f32x4& vb2, LAS unsigned char* lds, const TileGeo& G, int t, int buf, int c) {
    constexpr bool F32SRC = (KIND == 2 || KIND == 3);
    const int row = c >> 4, ch = c & 15;
    bool f32t = false;
    if constexpr (F32SRC) f32t = (t != G.tlast_new);
    u32x4 kc, vc;
    if (f32t) {
        kc.x = pkbf(ka.x, ka.y); kc.y = pkbf(ka.z, ka.w); kc.z = pkbf(kb2.x, kb2.y); kc.w = pkbf(kb2.z, kb2.w);
        vc.x = pkbf(va.x, va.y); vc.y = pkbf(va.z, va.w); vc.z = pkbf(vb2.x, vb2.y); vc.w = pkbf(vb2.z, vb2.w);
    } else { kc = __builtin_bit_cast(u32x4, ka); vc = __builtin_bit_cast(u32x4, va); }
    *(LAS u32x4*)(lds + KOFF + buf * KTILE + KS * row + 16 * ch) = kc; *(LAS u32x4*)(lds + VOFF + buf * VTILE + VS * row + 16 * ch) = vc;
}
template <int KIND, int KOFF = AT_K, int VOFF = AT_V, int FKOFF = AT_FK>
__device__ __forceinline__ void tile_store(const TileRegs& TR, LAS unsigned char* lds, const TileGeo& G, int t, int buf, int tid) {
    constexpr bool FOX = (KIND == 0 || KIND == 3);
    tile_store1<KIND, KOFF, VOFF>(TR.k0a, TR.k0b, TR.v0a, TR.v0b, lds, G, t, buf, tid);
    tile_store1<KIND, KOFF, VOFF>(TR.k1a, TR.k1b, TR.v1a, TR.v1b, lds, G, t, buf, tid + 512);
    if constexpr (FOX) { if (tid < 64) ((LAS float*)(lds + FKOFF))[buf * 64 + tid] = -LOG2E * TR.fkr; }
}
template <int KIND>
__device__ __forceinline__ void attn_item(LAS unsigned char* lds, const AttnCtx& C, int p0, int p1, int p2) {
    int tid_ = threadIdx.x; asm volatile("" : "+v"(tid_));
    const int tid = tid_, lane = tid & 63, wave = __builtin_amdgcn_readfirstlane(tid >> 6), lq = lane & 31, lh = lane >> 5;
    constexpr bool FOX = (KIND == 0 || KIND == 3), F32SRC = (KIND == 2 || KIND == 3);
    int b, h, bh = 0, t0, t1, qrow0, kbase_row = 0;
    if constexpr (KIND == 0) { bh = p0; b = bh >> 2; h = bh & 3; t0 = 0; t1 = 4 * p1 + 4; qrow0 = b * SEQ + 256 * p1 + 32 * wave; kbase_row = b * SEQ; }
    else if constexpr (KIND == 1) { b = p0; h = p2; t0 = (8 - 4 * p1) > 0 ? (8 - 4 * p1) : 0; t1 = 12; qrow0 = b * SEQ + 256 * p1 + 32 * wave; kbase_row = b * SEQ + 64 * (4 * p1 - 8); }
    else if constexpr (KIND == 2) { b = p0; h = p1; t0 = 0; t1 = 9; qrow0 = TP + b * TS + 32 * (wave & 1); }
    else { bh = p0; b = bh >> 2; h = bh & 3; t0 = 16 * p1; t1 = 16 * p1 + 16 + (p1 == NSPLIT - 1 ? 1 : 0); qrow0 = TP + b * TS + 32 * (wave & 1); }
    const int qcol = (FOX ? C_CQ : C_BQ) + h * HD, kcol = (FOX ? C_CK : C_BK) + h * HD, vcol = (FOX ? C_CV : C_BV) + h * HD;
    const bool qwave = (KIND <= 1) ? true : (wave < 2);
    const int tlast_new = (KIND == 2) ? 8 : 64;
    const int ncache = (KIND == 2) ? BAND : PAST;
    constexpr bool QLDS = (KIND >= 2);
    bf16x8 qf[QLDS ? 1 : 8];
    if (qwave) {
        const bf16_t* qp = C.H + (size_t)(qrow0 + lq) * HP + qcol + 8 * lh;
#pragma unroll
        for (int s = 0; s < 8; ++s) {
            const u32x4 raw = *(const u32x4*)(qp + 16 * s);
            u32x4 o; o.x = pkbf(bflo(raw.x) * QSCALE, bfhi(raw.x) * QSCALE); o.y = pkbf(bflo(raw.y) * QSCALE, bfhi(raw.y) * QSCALE);
            o.z = pkbf(bflo(raw.z) * QSCALE, bfhi(raw.z) * QSCALE); o.w = pkbf(bflo(raw.w) * QSCALE, bfhi(raw.w) * QSCALE);
            if constexpr (QLDS) *(LAS u32x4*)(lds + AT_Q + (wave & 1) * 8192 + s * 1024 + lane * 16) = o;
            else qf[s] = __builtin_bit_cast(bf16x8, o);
        }
    } else if constexpr (!QLDS) {
#pragma unroll
        for (int s = 0; s < 8; ++s) qf[s] = (bf16x8){0, 0, 0, 0, 0, 0, 0, 0};
    }
    const LAS unsigned char* Qb = lds + AT_Q + (wave & 1) * 8192 + lane * 16;
    if constexpr (!FOX) { LAS float* rel = (LAS float*)(lds + AT_REL); for (int i = tid; i < NREL; i += NTHREADS) rel[i] = C.relb[h * NREL + i] * LOG2E; }
    TileRegs TR; TR.fkr = 0.f; TR.k0b = TR.k1b = TR.v0b = TR.v1b = (f32x4){0.f, 0.f, 0.f, 0.f};
    constexpr bool DEEP = false && (KIND <= 1);
    TileRegs TR2; TR2.fkr = 0.f; TR2.k0a = TR2.k1a = TR2.v0a = TR2.v1a = TR2.k0b = TR2.k1b = TR2.v0b = TR2.v1b = (f32x4){0.f, 0.f, 0.f, 0.f};
    const TileGeo TG{b, h, bh, kbase_row, kcol, vcol, tlast_new, ncache};
#define load_tile(t) tile_load<KIND>(TR, C, TG, (t), tid)
#define store_tile(t, buf) tile_store<KIND>(TR, lds, TG, (t), (buf), tid)
#define load_tile2(t) tile_load<KIND>(TR2, C, TG, (t), tid)
#define store_tile2(t, buf) tile_store<KIND>(TR2, lds, TG, (t), (buf), tid)
    f32x16 oacc[4];
#pragma unroll
    for (int c = 0; c < 4; ++c)
#pragma unroll
        for (int r = 0; r < 16; ++r) oacc[c][r] = 0.f;
    float m_run = -1e30f, l_run = 0.f;
    const int wh = (KIND <= 1) ? (wave >> 1) : 0;
    const int qi = 32 * (wave & 1) + lq;
    const int q4 = (lane & 15) >> 2, p4 = lane & 3, blk = (lane >> 4) & 1;

    const int kofs0 = AT_K + KS * lq + 16 * lh;
    const int vofs0 = AT_V + VS * (4 * lh + q4) + 32 * blk + 8 * p4;
    load_tile(t0); store_tile(t0, 0);
    if (DEEP && t0 + 1 < t1) load_tile2(t0 + 1);
    __syncthreads();
#pragma unroll 2
    for (int st_ = 0; st_ < t1 - t0; ++st_) {
        const int t = t0 + st_;
        const int buf = st_ & 1;
        if constexpr (DEEP) { if (t + 2 < t1) { if (buf) load_tile2(t + 2); else load_tile(t + 2); } }
        else { if (t + 1 < t1) load_tile(t + 1); }
        bool active;
        if constexpr (KIND == 0) active = (t <= 4 * p1 + wh);
        else if constexpr (KIND == 1) active = (wh <= t) && (t <= wh + 8);
        else active = (wave < 2);
        if (active) {
            const LAS unsigned char* Kb = lds + kofs0 + buf * KTILE; const LAS unsigned char* Vb = lds + vofs0 + buf * VTILE;
            f32x16 sacc[2];
#pragma unroll
            for (int r = 0; r < 16; ++r) { sacc[0][r] = 0.f; sacc[1][r] = 0.f; }
            if constexpr (!QLDS) {
                constexpr int KR = 4;
                bf16x8 kf[KR];
#pragma unroll
                for (int s = 0; s < KR; ++s) kf[s] = *(const LAS bf16x8*)(Kb + 32 * s);
#pragma unroll
                for (int s = 0; s < 16; ++s) {
                    const int kb = s >> 3, ss = s & 7;
                    sacc[kb] = MFMA32(kf[s % KR], qf[ss], sacc[kb]);
                    if (s + KR < 16) kf[s % KR] = *(const LAS bf16x8*)(Kb + 32 * ((s + KR) & 7) + 32 * KS * ((s + KR) >> 3));
                }
            } else {
#pragma unroll
                for (int s = 0; s < 8; ++s) {
                    const bf16x8 q = *(const LAS bf16x8*)(Qb + 1024 * s);
                    const bf16x8 k0 = *(const LAS bf16x8*)(Kb + 32 * s), k1 = *(const LAS bf16x8*)(Kb + 32 * s + 32 * KS);
                    sacc[0] = MFMA32(k0, q, sacc[0]); sacc[1] = MFMA32(k1, q, sacc[1]);
                }
            }
            s16x4 vlo[4], vhi[4];
#define AT_VREAD(kb_, s2_) do { _Pragma("unroll") for (int c = 0; c < 4; ++c) { \
                vlo[c] = tr_read4(Vb + VS * (32 * (kb_) + 16 * (s2_)) + 64 * c); vhi[c] = tr_read4(Vb + VS * (32 * (kb_) + 16 * (s2_) + 8) + 64 * c); } } while (0)
            AT_VREAD(0, 0);
            if constexpr (FOX) {
                const LAS float* fk = (const LAS float*)(lds + AT_FK) + buf * 64;
                bool need_mask;
                if constexpr (KIND == 0) need_mask = (t == 4 * p1 + wh); else need_mask = (t == tlast_new);
#pragma unroll
                for (int kb = 0; kb < 2; ++kb) {
                    { const f32x4 fa = *(const LAS f32x4*)(fk + 32 * kb + 4 * lh), fb = *(const LAS f32x4*)(fk + 32 * kb + 8 + 4 * lh), fc = *(const LAS f32x4*)(fk + 32 * kb + 16 + 4 * lh), fd = *(const LAS f32x4*)(fk + 32 * kb + 24 + 4 * lh);
                      sacc[kb] += __builtin_shufflevector(__builtin_shufflevector(fa, fb, 0, 1, 2, 3, 4, 5, 6, 7), __builtin_shufflevector(fc, fd, 0, 1, 2, 3, 4, 5, 6, 7), 0, 1, 2, 3, 4, 5, 6, 7, 8, 9, 10, 11, 12, 13, 14, 15); }
                    __builtin_amdgcn_sched_barrier(0);
                }
                if (need_mask) {
                    asm volatile("" ::: "memory");
#pragma unroll
                    for (int kb = 0; kb < 2; ++kb)
#pragma unroll
                        for (int r = 0; r < 16; ++r) { const int key = 32 * kb + 8 * (r >> 2) + 4 * lh + (r & 3); if (key > qi) sacc[kb][r] = -__builtin_inff(); }
                }
            } else {
                const LAS float* rel = (const LAS float*)(lds + AT_REL);
                const int dchunk = wh + 8 - t;
                if (dchunk >= 5) {
                    const float cb = rel[512];
#pragma unroll
                    for (int kb = 0; kb < 2; ++kb)
#pragma unroll
                        for (int r = 0; r < 16; ++r) sacc[kb][r] += cb;
                } else {
                    const int d0 = 64 * dchunk + qi - 4 * lh;
#pragma unroll
                    for (int kb = 0; kb < 2; ++kb)
#pragma unroll
                        for (int r = 0; r < 16; ++r) {
                            int idx = d0 - (32 * kb + 8 * (r >> 2) + (r & 3));
                            idx = idx < -256 ? -256 : (idx > 256 ? 256 : idx);
                            sacc[kb][r] += rel[idx + 256];
                        }
                }
            }
            float mx = sacc[0][0];
#pragma unroll
            for (int kb = 0; kb < 2; ++kb)
#pragma unroll
                for (int r = 0; r < 16; ++r) mx = fmaxf(mx, sacc[kb][r]);
            mx = fmaxf(mx, xshfl32(mx, lane));
            const float m_new = fmaxf(m_run, mx);
            if (__any(m_new > m_run)) {
                const float corr = __builtin_amdgcn_exp2f(m_run - m_new);
                l_run *= corr;
#pragma unroll
                for (int c = 0; c < 4; ++c)
#pragma unroll
                    for (int r = 0; r < 16; ++r) oacc[c][r] *= corr;
            }
            m_run = m_new;
            sacc[0] -= m_new; sacc[1] -= m_new;
#pragma unroll
            for (int kb = 0; kb < 2; ++kb)
#pragma unroll
                for (int r = 0; r < 16; ++r) sacc[kb][r] = __builtin_amdgcn_exp2f(sacc[kb][r]);
            float ps;
            { const f32x16 t16 = sacc[0] + sacc[1];
              const f32x8v t8 = __builtin_shufflevector(t16, t16, 0, 1, 2, 3, 4, 5, 6, 7) + __builtin_shufflevector(t16, t16, 8, 9, 10, 11, 12, 13, 14, 15);
              const f32x4 t4 = __builtin_shufflevector(t8, t8, 0, 1, 2, 3) + __builtin_shufflevector(t8, t8, 4, 5, 6, 7);
              ps = (t4.x + t4.y) + (t4.z + t4.w); }
            ps += xshfl32(ps, lane);
            l_run += ps;
#pragma unroll
            for (int kk = 0; kk < 4; ++kk) {
                const int kb = kk >> 1, s2 = kk & 1;
                u32x4 pw; pw.x = pkbf(sacc[kb][8 * s2 + 0], sacc[kb][8 * s2 + 1]); pw.y = pkbf(sacc[kb][8 * s2 + 2], sacc[kb][8 * s2 + 3]);
                pw.z = pkbf(sacc[kb][8 * s2 + 4], sacc[kb][8 * s2 + 5]); pw.w = pkbf(sacc[kb][8 * s2 + 6], sacc[kb][8 * s2 + 7]);
                const bf16x8 pf = __builtin_bit_cast(bf16x8, pw);
#pragma unroll
                for (int c = 0; c < 4; ++c) oacc[c] = MFMA32(__builtin_shufflevector(vlo[c], vhi[c], 0, 1, 2, 3, 4, 5, 6, 7), pf, oacc[c]);
                if (kk < 3) { AT_VREAD((kk + 1) >> 1, (kk + 1) & 1); }
            }
#undef AT_VREAD
        }
        if constexpr (DEEP) { if (t + 1 < t1) { if (buf) store_tile(t + 1, 0); else store_tile2(t + 1, 1); } }
        else { if (t + 1 < t1) store_tile(t + 1, buf ^ 1); }
        __syncthreads();
    }
    if (qwave) {
        if constexpr (KIND == 3) {
            const size_t pr = ((size_t)bh * NSPLIT + p1) * TS + qi;
#pragma unroll
            for (int c = 0; c < 4; ++c)
#pragma unroll
                for (int g = 0; g < 4; ++g) { const f32x4 v = {oacc[c][4 * g], oacc[c][4 * g + 1], oacc[c][4 * g + 2], oacc[c][4 * g + 3]}; *(f32x4*)(C.PO + pr * HD + 32 * c + 8 * g + 4 * lh) = v; }
            if (lh == 0) { C.PM[pr] = m_run; C.PL[pr] = l_run; }
        } else {
            const float inv = 1.f / l_run;
            bf16_t* op = C.O + (size_t)(qrow0 + lq) * DB + h * HD + 4 * lh;
#pragma unroll
            for (int c = 0; c < 4; ++c)
#pragma unroll
                for (int g = 0; g < 4; ++g) { u32x2 w; w.x = pkbf(oacc[c][4 * g] * inv, oacc[c][4 * g + 1] * inv); w.y = pkbf(oacc[c][4 * g + 2] * inv, oacc[c][4 * g + 3] * inv); *(u32x2*)(op + 32 * c + 8 * g) = w; }
        }
    }
}
#undef load_tile
#undef store_tile
#undef load_tile2
#undef store_tile2


__device__ __forceinline__ void fox_combine_row(const float* PO, const float* PM, const float* PL, float* OC, int idx, int lane) {
    const int bh = idx >> 6, qi = idx & 63, b = bh >> 2, h = bh & 3;
    float m = -1e30f;
#pragma unroll
    for (int s = 0; s < NSPLIT; ++s) m = fmaxf(m, PM[((size_t)bh * NSPLIT + s) * TS + qi]);
    float l = 0.f, o0 = 0.f, o1 = 0.f;
#pragma unroll
    for (int s = 0; s < NSPLIT; ++s) {
        const size_t pr = ((size_t)bh * NSPLIT + s) * TS + qi;
        const float w = __builtin_amdgcn_exp2f(PM[pr] - m);
        l += PL[pr] * w; o0 += PO[pr * HD + lane] * w; o1 += PO[pr * HD + lane + 64] * w;
    }
    const float inv = 1.f / l;
    float* op = OC + (size_t)(TP + b * TS + qi) * DB + h * HD;
    op[lane] = o0 * inv; op[lane + 64] = o1 * inv;
}

constexpr int FS_K = 0, FS_V = 3 * KTILE, FS_FK = FS_V + 3 * VTILE, FS_Q = FS_FK + 768, FS_END = FS_Q + 16384;
static_assert(FS_END <= RING_BYTES && FS_Q % 16 == 0, "fox-sample LDS map");
#define FS_BAR() do { asm volatile("s_waitcnt lgkmcnt(0)" ::: "memory"); __builtin_amdgcn_s_barrier(); asm volatile("" ::: "memory"); } while (0)

__device__ __forceinline__ void fox_sample_item(LAS unsigned char* lds, const AttnCtx& C, int bh, int sp) {
    int tid_ = threadIdx.x; asm volatile("" : "+v"(tid_));
    const int tid = tid_, lane = tid & 63, wave = __builtin_amdgcn_readfirstlane(tid >> 6);
    const int b = bh >> 2, h = bh & 3, t0 = 16 * sp;
    const bool has_new = (sp == NSPLIT - 1);
    const int nsteps = 16 + (has_new ? 1 : 0);
    if (wave >= 2) {
        const int ltid = tid - 128;
        const float* kbase = C.ck + (((size_t)b * PAST) * NH + h) * HD; const float* vbase = C.cv + (((size_t)b * PAST) * NH + h) * HD;
        const bool six = ltid < 128;
        constexpr int FD = 3;
        f32x4 R[FD][12]; float fk[FD];
#define FS_LOAD(SET, T) do { _Pragma("unroll") for (int i = 0; i < 6; ++i) { if (i < 5 || six) { const int it = ltid + 384 * i, isv = it >> 10, ii = it & 1023, row = ii >> 4, ch = ii & 15; \
            const float* src = (isv ? vbase : kbase) + ((size_t)(64 * (T) + row) * NH) * HD + 8 * ch; R[SET][2 * i] = *(const f32x4*)src; R[SET][2 * i + 1] = *(const f32x4*)(src + 4); } } \
            if (ltid < 64) fk[SET] = C.F[(size_t)bh * (PAST + TS) + 64 * (T) + ltid]; } while (0)
#define FS_STORE(SET, BUF) do { _Pragma("unroll") for (int i = 0; i < 6; ++i) { if (i < 5 || six) { const int it = ltid + 384 * i, isv = it >> 10, ii = it & 1023, row = ii >> 4, ch = ii & 15; \
            const f32x4 a = R[SET][2 * i], c4 = R[SET][2 * i + 1]; u32x4 w; w.x = pkbf(a.x, a.y); w.y = pkbf(a.z, a.w); w.z = pkbf(c4.x, c4.y); w.w = pkbf(c4.z, c4.w); \
            if (isv) *(LAS u32x4*)(lds + FS_V + (BUF) * VTILE + VS * row + 16 * ch) = w; else *(LAS u32x4*)(lds + FS_K + (BUF) * KTILE + KS * row + 16 * ch) = w; } } \
            if (ltid < 64) ((LAS float*)(lds + FS_FK))[(BUF) * 64 + ltid] = -LOG2E * fk[SET]; } while (0)
#pragma unroll
        for (int d = 0; d < FD; ++d) FS_LOAD(d, t0 + d);
#pragma unroll
        for (int s = 0; s < 16; ++s) {
            FS_STORE(s % FD, s % 3);
            if (s + FD < 16) FS_LOAD(s % FD, t0 + s + FD);
            FS_BAR();
        }
#undef FS_LOAD
#undef FS_STORE
        if (has_new) {
            for (int it = ltid; it < 2048; it += 384) {
                const int isv = it >> 10, ii = it & 1023, row = ii >> 4, ch = ii & 15;
                const u32x4 w = *(const u32x4*)(C.H + (size_t)(TP + b * TS + row) * HP + (isv ? C_CV : C_CK) + h * HD + 8 * ch);
                if (isv) *(LAS u32x4*)(lds + FS_V + 1 * VTILE + VS * row + 16 * ch) = w; else *(LAS u32x4*)(lds + FS_K + 1 * KTILE + KS * row + 16 * ch) = w;
            }
            if (ltid < 64) ((LAS float*)(lds + FS_FK))[1 * 64 + ltid] = -LOG2E * C.F[(size_t)bh * (PAST + TS) + PAST + ltid];
            FS_BAR();
        }
    } else {
        const int lq = lane & 31, lh = lane >> 5, qi = 32 * wave + lq;
        const int q4 = (lane & 15) >> 2, p4 = lane & 3, blk = (lane >> 4) & 1;
        {
            const bf16_t* qp = C.H + (size_t)(TP + b * TS + qi) * HP + C_CQ + h * HD + 8 * lh;
#pragma unroll
            for (int s = 0; s < 8; ++s) {
                const u32x4 raw = *(const u32x4*)(qp + 16 * s);
                u32x4 o; o.x = pkbf(bflo(raw.x) * QSCALE, bfhi(raw.x) * QSCALE); o.y = pkbf(bflo(raw.y) * QSCALE, bfhi(raw.y) * QSCALE);
                o.z = pkbf(bflo(raw.z) * QSCALE, bfhi(raw.z) * QSCALE); o.w = pkbf(bflo(raw.w) * QSCALE, bfhi(raw.w) * QSCALE);
                *(LAS u32x4*)(lds + FS_Q + wave * 8192 + s * 1024 + lane * 16) = o;
            }
        }
        const LAS unsigned char* Qb = lds + FS_Q + wave * 8192 + lane * 16;
        const int kofs0 = FS_K + KS * lq + 16 * lh, vofs0 = FS_V + VS * (4 * lh + q4) + 32 * blk + 8 * p4;
        f32x16 oacc[4];
#pragma unroll
        for (int c = 0; c < 4; ++c)
#pragma unroll
            for (int r = 0; r < 16; ++r) oacc[c][r] = 0.f;
        float m_run = -1e30f, l_run = 0.f;
        for (int s = 0; s < nsteps; ++s) {
            FS_BAR();
            const int buf = s % 3;
            const LAS unsigned char* Kb = lds + kofs0 + buf * KTILE; const LAS unsigned char* Vb = lds + vofs0 + buf * VTILE;
            f32x16 sacc[2];
#pragma unroll
            for (int r = 0; r < 16; ++r) { sacc[0][r] = 0.f; sacc[1][r] = 0.f; }
#pragma unroll
            for (int ss = 0; ss < 8; ++ss) {
                const bf16x8 q = *(const LAS bf16x8*)(Qb + 1024 * ss);
                const bf16x8 k0 = *(const LAS bf16x8*)(Kb + 32 * ss), k1 = *(const LAS bf16x8*)(Kb + 32 * ss + 32 * KS);
                sacc[0] = MFMA32(k0, q, sacc[0]); sacc[1] = MFMA32(k1, q, sacc[1]);
            }
            s16x4 vlo[4], vhi[4];
#define FS_VREAD(kb_, s2_) do { _Pragma("unroll") for (int c = 0; c < 4; ++c) { \
                vlo[c] = tr_read4(Vb + VS * (32 * (kb_) + 16 * (s2_)) + 64 * c); vhi[c] = tr_read4(Vb + VS * (32 * (kb_) + 16 * (s2_) + 8) + 64 * c); } } while (0)
            FS_VREAD(0, 0);
            {
                const LAS float* fkp = (const LAS float*)(lds + FS_FK) + buf * 64;
#pragma unroll
                for (int kb = 0; kb < 2; ++kb) {
                    { const f32x4 fa = *(const LAS f32x4*)(fkp + 32 * kb + 4 * lh), fb = *(const LAS f32x4*)(fkp + 32 * kb + 8 + 4 * lh), fc = *(const LAS f32x4*)(fkp + 32 * kb + 16 + 4 * lh), fd = *(const LAS f32x4*)(fkp + 32 * kb + 24 + 4 * lh);
                      sacc[kb] += __builtin_shufflevector(__builtin_shufflevector(fa, fb, 0, 1, 2, 3, 4, 5, 6, 7), __builtin_shufflevector(fc, fd, 0, 1, 2, 3, 4, 5, 6, 7), 0, 1, 2, 3, 4, 5, 6, 7, 8, 9, 10, 11, 12, 13, 14, 15); }
                    __builtin_amdgcn_sched_barrier(0);
                }
                if (s == 16) {
                    asm volatile("" ::: "memory");
#pragma unroll
                    for (int kb = 0; kb < 2; ++kb)
#pragma unroll
                        for (int r = 0; r < 16; ++r) { const int key = 32 * kb + 8 * (r >> 2) + 4 * lh + (r & 3); if (key > qi) sacc[kb][r] = -__builtin_inff(); }
                }
            }
            float mx = sacc[0][0];
#pragma unroll
            for (int kb = 0; kb < 2; ++kb)
#pragma unroll
                for (int r = 0; r < 16; ++r) mx = fmaxf(mx, sacc[kb][r]);
            mx = fmaxf(mx, xshfl32(mx, lane));
            const float m_new = fmaxf(m_run, mx);
            if (__any(m_new > m_run)) {
                const float corr = __builtin_amdgcn_exp2f(m_run - m_new);
                l_run *= corr;
#pragma unroll
                for (int c = 0; c < 4; ++c)
#pragma unroll
                    for (int r = 0; r < 16; ++r) oacc[c][r] *= corr;
            }
            m_run = m_new;
            sacc[0] -= m_new; sacc[1] -= m_new;
#pragma unroll
            for (int kb = 0; kb < 2; ++kb)
#pragma unroll
                for (int r = 0; r < 16; ++r) sacc[kb][r] = __builtin_amdgcn_exp2f(sacc[kb][r]);
            float ps;
            { const f32x16 t16 = sacc[0] + sacc[1];
              const f32x8v t8 = __builtin_shufflevector(t16, t16, 0, 1, 2, 3, 4, 5, 6, 7) + __builtin_shufflevector(t16, t16, 8, 9, 10, 11, 12, 13, 14, 15);
              const f32x4 t4 = __builtin_shufflevector(t8, t8, 0, 1, 2, 3) + __builtin_shufflevector(t8, t8, 4, 5, 6, 7);
              ps = (t4.x + t4.y) + (t4.z + t4.w); }
            ps += xshfl32(ps, lane);
            l_run += ps;
#pragma unroll
            for (int kk = 0; kk < 4; ++kk) {
                const int kb = kk >> 1, s2 = kk & 1;
                u32x4 pw; pw.x = pkbf(sacc[kb][8 * s2 + 0], sacc[kb][8 * s2 + 1]); pw.y = pkbf(sacc[kb][8 * s2 + 2], sacc[kb][8 * s2 + 3]);
                pw.z = pkbf(sacc[kb][8 * s2 + 4], sacc[kb][8 * s2 + 5]); pw.w = pkbf(sacc[kb][8 * s2 + 6], sacc[kb][8 * s2 + 7]);
                const bf16x8 pf = __builtin_bit_cast(bf16x8, pw);
#pragma unroll
                for (int c = 0; c < 4; ++c) oacc[c] = MFMA32(__builtin_shufflevector(vlo[c], vhi[c], 0, 1, 2, 3, 4, 5, 6, 7), pf, oacc[c]);
                if (kk < 3) { FS_VREAD((kk + 1) >> 1, (kk + 1) & 1); }
            }
#undef FS_VREAD
        }
        const size_t pr = ((size_t)bh * NSPLIT + sp) * TS + qi;
#pragma unroll
        for (int c = 0; c < 4; ++c)
#pragma unroll
            for (int g = 0; g < 4; ++g) { const f32x4 v = {oacc[c][4 * g], oacc[c][4 * g + 1], oacc[c][4 * g + 2], oacc[c][4 * g + 3]}; *(f32x4*)(C.PO + pr * HD + 32 * c + 8 * g + 4 * lh) = v; }
        if (lh == 0) { C.PM[pr] = m_run; C.PL[pr] = l_run; }
    }
}
constexpr int LR_XCF = 0  , LR_XCB = 32768, LR_A = 49152, LR_AG = 81920  ,
              LR_QS = 98304, LR_SS = 102400, LR_H0 = 102912, LR_CW = 107008  , LR_GC = 127488  , LR_GM = 139776  , LR_END = 143872;
static_assert(LR_END <= RING_BYTES, "lru LDS map");
constexpr bool LRU_STREAM = false;
struct LruCtx { const bf16_t* H; const float* sconv; const float* slru; const float* wconv; const float* bconv; const bf16_t* WgT; const float* bra; const float* brx; const float* lam;
                const float* gm; float* SA; float* SH; bf16_t* Y; float* out; int l; int nb; int pf; const bf16_t* OB; const bf16_t* OC; float* AG_; bf16_t* UG_; };

__device__ __forceinline__ float fast_sigmoid(float x) { return __builtin_amdgcn_rcpf(1.f + __builtin_amdgcn_exp2f(-1.4426950408889634f * x)); }
__device__ __forceinline__ float fast_gelu_tanh(float x) {
    const float z2 = 1.5957691216057308f * (x + 0.044715f * x * x * x);
    return x * __builtin_amdgcn_rcpf(1.f + __builtin_amdgcn_exp2f(-1.4426950408889634f * z2));
}
__device__ __forceinline__ float fast_gelu_tanh2(float x) {
    constexpr float c1 = -1.4426950408889634f * 1.5957691216057308f, c2 = c1 * 0.044715f;
    return x * __builtin_amdgcn_rcpf(1.f + __builtin_amdgcn_exp2f(x * (c2 * (x * x) + c1)));
}
__device__ __forceinline__ float one_minus_exp(float x, float ehalf  ) {
    const float big = 1.f - ehalf * ehalf;
    const float small = -x * (1.f + x * (0.5f + x * (0.16666667f + x * (0.041666668f + x * 0.0083333338f))));
    return (x > -0.25f) ? small : big;
}

struct LruRows { u32x4 r[4][2]; u32x4 ag[2]; };

template <bool PASS2>
__device__ __forceinline__ void lru_fetch(u32x4 (&r)[4][2], u32x4 (&ag)[2], const LruCtx& C, bool prm, int b, int c, int row0, int n, int t, int cg) {
    const int col = n * HD + 16 * cg;
#pragma unroll
    for (int j = 0; j < 4; ++j) {
        const int tt = t + j - 3, tpos = (prm ? 64 * c : 0) + tt;
        if (tpos >= 0) { const bf16_t* hp = C.H + (size_t)(row0 + tt) * HP + C_AX + col; r[j][0] = *(const u32x4*)hp; r[j][1] = *(const u32x4*)(hp + 8); }
        else { r[j][0] = (u32x4){0u, 0u, 0u, 0u}; r[j][1] = (u32x4){0u, 0u, 0u, 0u}; }
    }
    if constexpr (PASS2) { const bf16_t* gp = C.H + (size_t)(row0 + t) * HP + C_AG + col; ag[0] = *(const u32x4*)gp; ag[1] = *(const u32x4*)(gp + 8); }
}

template <bool PASS2>
__device__ __forceinline__ void lru_item(LAS unsigned char* lds, const LruCtx& C, int chunk) {
    int tid_ = threadIdx.x; asm volatile("" : "+v"(tid_));
    const int tid = tid_, lane = tid & 63, wave = __builtin_amdgcn_readfirstlane(tid >> 6);
    const bool prm = chunk < 256; const int b = prm ? (chunk >> 6) : (chunk - 256), c = prm ? (chunk & 63) : 0;
    const int row0 = prm ? b * SEQ + 64 * c : TP + b * TS;
    LAS float* XCF = (LAS float*)(lds + LR_XCF); LAS unsigned char* XCB = lds + LR_XCB; LAS float* AA = (LAS float*)(lds + LR_A); LAS float* UU = XCF;
    LAS float* QS = (LAS float*)(lds + LR_QS); LAS float* SS = (LAS float*)(lds + LR_SS); LAS float* H0 = (LAS float*)(lds + LR_H0); LAS bf16_t* AG = (LAS bf16_t*)(lds + LR_AG); LAS float* CW = (LAS float*)(lds + LR_CW); LAS float* GC = (LAS float*)(lds + LR_GC);
    const int st_ = tid >> 3, scg_ = tid & 7;
    u32x4 rr[4][2], rag[2];
    lru_fetch<PASS2>(rr, rag, C, prm, b, c, row0, 0, st_, scg_);
#pragma unroll
    for (int i = 0; i < 2; ++i) {
        const int ch = tid + 512 * i;
        CW[ch] = C.bconv[ch];
#pragma unroll
        for (int j = 0; j < 4; ++j) CW[(1 + j) * DA + ch] = C.wconv[(size_t)j * DA + ch];
        GC[ch] = C.bra[ch]; GC[DA + ch] = C.brx[ch]; GC[2 * DA + ch] = log1pf(expf(-C.lam[ch]));
        if constexpr (PASS2) ((LAS float*)(lds + LR_GM))[ch] = C.gm[ch];
    }
    if constexpr (PASS2) {
#pragma unroll
        for (int i = 0; i < 2; ++i) {
            const int ch = tid + 512 * i; float h;
            if (prm && !(C.pf & 1)) { h = 0.f; const float* sa = C.SA + (size_t)b * 64 * DA + ch; const float* sh = C.SH + (size_t)b * 64 * DA + ch;
                for (int j0 = 0; j0 < c; j0 += 16) {
                    float av[16], hv[16];
#pragma unroll
                    for (int k = 0; k < 16; ++k) { av[k] = sa[(size_t)(j0 + k) * DA]; hv[k] = sh[(size_t)(j0 + k) * DA]; }
#pragma unroll
                    for (int k = 0; k < 16; ++k) if (j0 + k < c) h = av[k] * h + hv[k];
                } }
            else h = prm ? 0.f : C.slru[(size_t)b * DA + ch];
            H0[ch] = h;
        }
        if (tid < 64) SS[tid] = 0.f;
    }
    __syncthreads();
    for (int n = 0; n < C.nb; ++n) {
        u32x4 wq0[8], wq1[8];
        { int ln = lane; asm volatile("" : "+v"(ln));
          const int ch = 32 * (wave >> 1) + (ln & 31);
          const bf16_t* b0p = C.WgT + ((size_t)(0 * 8 + n) * HD + ch) * HD + 8 * (ln >> 5); const bf16_t* b1p = C.WgT + ((size_t)(1 * 8 + n) * HD + ch) * HD + 8 * (ln >> 5);
#pragma unroll
          for (int s = 0; s < 8; ++s) { wq0[s] = *(const u32x4*)(b0p + 16 * s); wq1[s] = *(const u32x4*)(b1p + 16 * s); } }
        {
            int st = st_, scg = scg_; asm volatile("" : "+v"(st), "+v"(scg));
            const int col = n * HD + 16 * scg;
            f32x4 acc[4];
#pragma unroll
            for (int k = 0; k < 4; ++k) acc[k] = *(const LAS f32x4*)(CW + col + 4 * k);
#pragma unroll
            for (int j = 0; j < 4; ++j) {
                const int tpos = (prm ? 64 * c : 0) + st + j - 3;
                f32x4 x[4];
                if (tpos >= 0 || prm) {
                    const u32x4 r0 = rr[j][0], r1 = rr[j][1];
                    x[0] = (f32x4){bflo(r0.x), bfhi(r0.x), bflo(r0.y), bfhi(r0.y)}; x[1] = (f32x4){bflo(r0.z), bfhi(r0.z), bflo(r0.w), bfhi(r0.w)};
                    x[2] = (f32x4){bflo(r1.x), bfhi(r1.x), bflo(r1.y), bfhi(r1.y)}; x[3] = (f32x4){bflo(r1.z), bfhi(r1.z), bflo(r1.w), bfhi(r1.w)};
                } else {
                    const float* sp = C.sconv + ((size_t)b * 3 + (tpos + 3)) * DA + col;
#pragma unroll
                    for (int k = 0; k < 4; ++k) x[k] = *(const f32x4*)(sp + 4 * k);
                }
#pragma unroll
                for (int k = 0; k < 4; ++k) { const f32x4 w = *(const LAS f32x4*)(CW + (1 + j) * DA + col + 4 * k); acc[k] += w * x[k]; }
            }
#pragma unroll
            for (int k = 0; k < 4; ++k) *(LAS f32x4*)(XCF + st * HD + 16 * scg + 4 * k) = acc[k];
            u32x4 w0, w1;
            w0.x = pkbf(acc[0].x, acc[0].y); w0.y = pkbf(acc[0].z, acc[0].w); w0.z = pkbf(acc[1].x, acc[1].y); w0.w = pkbf(acc[1].z, acc[1].w);
            w1.x = pkbf(acc[2].x, acc[2].y); w1.y = pkbf(acc[2].z, acc[2].w); w1.z = pkbf(acc[3].x, acc[3].y); w1.w = pkbf(acc[3].z, acc[3].w);
            *(LAS u32x4*)(XCB + off_b(st, 2 * scg)) = w0; *(LAS u32x4*)(XCB + off_b(st, 2 * scg + 1)) = w1;
            if constexpr (PASS2) { *(LAS u32x4*)(AG + st * HD + 16 * scg) = rag[0]; *(LAS u32x4*)(AG + st * HD + 16 * scg + 8) = rag[1]; }
            if (n + 1 < 8) { int st2 = st, cg2 = scg; asm volatile("" : "+v"(st2), "+v"(cg2)); lru_fetch<PASS2>(rr, rag, C, prm, b, c, row0, n + 1, st2, cg2); }
        }
        {
            int ln = lane; asm volatile("" : "+v"(ln));
            const int lq = ln & 31, lh = ln >> 5;
            const int rt = wave & 1, ct = wave >> 1, ch = 32 * ct + lq, gch = n * HD + ch;
            const float bra = GC[gch], brx = GC[DA + gch], sp = GC[2 * DA + gch];
            __syncthreads();
            f32x16 g0, g1;
#pragma unroll
            for (int r = 0; r < 16; ++r) { g0[r] = 0.f; g1[r] = 0.f; }
#pragma unroll
            for (int s = 0; s < 8; ++s) {
                const bf16x8 a = *(const LAS bf16x8*)(XCB + off_b(32 * rt + lq, 2 * s + lh));
                g0 = MFMA32(a, __builtin_bit_cast(bf16x8, wq0[s]), g0); g1 = MFMA32(a, __builtin_bit_cast(bf16x8, wq1[s]), g1);
            }
#pragma unroll
            for (int r = 0; r < 16; ++r) {
                const int t = 32 * rt + 8 * (r >> 2) + 4 * lh + (r & 3);
                const float rg = fast_sigmoid(g0[r] + bra), ig = fast_sigmoid(g1[r] + brx);
                const float log_a = -8.0f * rg * sp, a = __builtin_amdgcn_exp2f(1.4426950408889634f * log_a);
                float mult = __builtin_amdgcn_sqrtf(one_minus_exp(2.0f * log_a, a));
                if (prm && c == 0 && t == 0) mult = 1.0f;
                const float uv = mult * (ig * XCF[t * HD + ch]);
                AA[t * HD + ch] = a; UU[t * HD + ch] = uv;
                if constexpr (!PASS2 && LRU_STREAM) { C.AG_[(size_t)(row0 + t) * DA + gch] = a; C.UG_[(size_t)(row0 + t) * DA + gch] = f2bf(uv); }
            }
        }
        __syncthreads();
        {
            int tn = tid; asm volatile("" : "+v"(tn));
            const int ch = tn & 127, q = tn >> 7, gch = n * HD + ch;
            const LAS float* ap = AA + (16 * q) * HD + ch; const LAS float* up = UU + (16 * q) * HD + ch;
            float ra = 1.f, rh = 0.f;
#pragma unroll 4
            for (int i = 0; i < 16; ++i) { const float a = ap[i * HD], u = up[i * HD]; rh = a * rh + u; ra *= a; }
            QS[(q * HD + ch) * 2] = ra; QS[(q * HD + ch) * 2 + 1] = rh;
            __syncthreads();
            float cin = PASS2 ? H0[gch] : 0.f;
            for (int qq = 0; qq < q; ++qq) cin = QS[(qq * HD + ch) * 2] * cin + QS[(qq * HD + ch) * 2 + 1];
            if constexpr (!PASS2) {
                if (q == 3) {
                    const float atot = QS[(0 * HD + ch) * 2] * QS[(1 * HD + ch) * 2] * QS[(2 * HD + ch) * 2] * ra;
                    C.SA[((size_t)b * 64 + c) * DA + gch] = atot; C.SH[((size_t)b * 64 + c) * DA + gch] = ra * cin + rh;
                }
            } else {
                float h = cin;
                LAS bf16_t* agp = AG + (16 * q) * HD + ch;
#pragma unroll 4
                for (int i = 0; i < 16; ++i) {
                    h = ap[i * HD] * h + up[i * HD];
                    agp[i * HD] = f2bf(h * fast_gelu_tanh(bf2f(agp[i * HD])));
                }
                if (q == 3 && (!prm || c == 63)) { if (prm) C.out[O_PLRU + (size_t)(C.l * NB_P + b) * DA + gch] = h; else C.out[O_SLRU + (size_t)(C.l * NB_S + b) * DA + gch] = h; }
            }
        }
        __syncthreads();
        if constexpr (PASS2) {
            int st = st_, scg = scg_; asm volatile("" : "+v"(st), "+v"(scg));
            const u32x4 y0 = *(const LAS u32x4*)(AG + st * HD + 16 * scg), y1 = *(const LAS u32x4*)(AG + st * HD + 16 * scg + 8);
            bf16_t* yp = C.Y + (size_t)(row0 + st) * DM + n * HD + 16 * scg;
            *(u32x4*)yp = y0; *(u32x4*)(yp + 8) = y1;
            float q = 0.f;
            { const unsigned w[8] = {y0.x, y0.y, y0.z, y0.w, y1.x, y1.y, y1.z, y1.w};
#pragma unroll
              for (int k = 0; k < 8; ++k) { const float a = bflo(w[k]), bq = bfhi(w[k]); q += a * a + bq * bq; } }
            q += __builtin_bit_cast(float, __builtin_amdgcn_update_dpp(0, __builtin_bit_cast(int, q), 0xB1, 0xF, 0xF, true));
            q += __builtin_bit_cast(float, __builtin_amdgcn_update_dpp(0, __builtin_bit_cast(int, q), 0x4E, 0xF, 0xF, true));
            q += __builtin_bit_cast(float, __builtin_amdgcn_update_dpp(0, __builtin_bit_cast(int, q), 0x141, 0xF, 0xF, true));
            if (scg == 0) SS[st] += q;
            __syncthreads();
        }
    }
    if (PASS2 && !(C.pf & 2)) {
        VM_WAIT();
        __syncthreads();
#pragma unroll
        for (int hf = 0; hf < 2; ++hf) {
            u32x4 raw[8];
#pragma unroll
            for (int i = 0; i < 8; ++i) { const int k = tid + 512 * (8 * hf + i), t = k >> 7, cc = k & 127; raw[i] = *(const u32x4*)(C.Y + (size_t)(row0 + t) * DM + 8 * cc); }
#pragma unroll
            for (int i = 0; i < 8; ++i) {
                const int k = tid + 512 * (8 * hf + i), t = k >> 7, cc = k & 127;
                const float rstd = rsqrtf(SS[t] * (1.f / DA) + LN_EPS);
                const LAS float* gp = (const LAS float*)(lds + LR_GM) + 8 * cc;
                const f32x4 ga = *(const LAS f32x4*)gp, gb = *(const LAS f32x4*)(gp + 4);
                u32x4 o; o.x = pkbf(bflo(raw[i].x) * rstd * ga.x, bfhi(raw[i].x) * rstd * ga.y); o.y = pkbf(bflo(raw[i].y) * rstd * ga.z, bfhi(raw[i].y) * rstd * ga.w);
                o.z = pkbf(bflo(raw[i].z) * rstd * gb.x, bfhi(raw[i].z) * rstd * gb.y); o.w = pkbf(bflo(raw[i].w) * rstd * gb.z, bfhi(raw[i].w) * rstd * gb.w);
                *(u32x4*)(C.Y + (size_t)(row0 + t) * DM + 8 * cc) = o;
            }
        }
        __syncthreads();
    }
    if constexpr (PASS2) {
        if (C.OB) {
#pragma unroll
            for (int which = 0; which < 2; ++which) {
                int st = st_, scg = scg_; asm volatile("" : "+v"(st), "+v"(scg));
                const bf16_t* src = (which ? C.OC : C.OB) + (size_t)(row0 + st) * DB + 64 * scg;
                f32x4 v[16]; float q = 0.f;
#pragma unroll
                for (int k = 0; k < 8; ++k) { const u32x4 w = *(const u32x4*)(src + 8 * k);
                    v[2 * k] = (f32x4){bflo(w.x), bfhi(w.x), bflo(w.y), bfhi(w.y)}; v[2 * k + 1] = (f32x4){bflo(w.z), bfhi(w.z), bflo(w.w), bfhi(w.w)}; }
#pragma unroll
                for (int k = 0; k < 16; ++k) q += (v[k].x * v[k].x + v[k].y * v[k].y) + (v[k].z * v[k].z + v[k].w * v[k].w);
                q += __builtin_bit_cast(float, __builtin_amdgcn_update_dpp(0, __builtin_bit_cast(int, q), 0xB1, 0xF, 0xF, true));
                q += __builtin_bit_cast(float, __builtin_amdgcn_update_dpp(0, __builtin_bit_cast(int, q), 0x4E, 0xF, 0xF, true));
                q += __builtin_bit_cast(float, __builtin_amdgcn_update_dpp(0, __builtin_bit_cast(int, q), 0x141, 0xF, 0xF, true));
                const float rstd = rsqrtf(q * (1.f / DB) + LN_EPS);
                const float* gp = C.gm + DA + which * DB + 64 * scg;
                bf16_t* yp = C.Y + (size_t)(row0 + st) * DM + DA + which * DB + 64 * scg;
#pragma unroll
                for (int k = 0; k < 8; ++k) {
                    const f32x4 ga = *(const f32x4*)(gp + 8 * k), gb = *(const f32x4*)(gp + 8 * k + 4);
                    const f32x4 a = v[2 * k] * rstd * ga, bq = v[2 * k + 1] * rstd * gb;
                    u32x4 o; o.x = pkbf(a.x, a.y); o.y = pkbf(a.z, a.w); o.z = pkbf(bq.x, bq.y); o.w = pkbf(bq.z, bq.w);
                    *(u32x4*)(yp + 8 * k) = o;
                }
            }
        }
    }
}

constexpr int L2_YT = 0, L2_QS = 131072, L2_H0 = 139264, L2_SS = 143360, L2_END = 143616;
static_assert(L2_END <= RING_BYTES, "lru pass-2 LDS map");
__device__ __forceinline__ void lru_pass2_stream(LAS unsigned char* lds, const LruCtx& C, int chunk) {
    int tid_ = threadIdx.x; asm volatile("" : "+v"(tid_));
    const int tid = tid_;
    const int b = chunk >> 6, c = chunk & 63, row0 = b * SEQ + 64 * c;
    LAS bf16_t* YT = (LAS bf16_t*)(lds + L2_YT); LAS float* QS = (LAS float*)(lds + L2_QS); LAS float* H0 = (LAS float*)(lds + L2_H0);
    const int ch = tid & 127, q = tid >> 7;
    float av[16], uv[16], gv[16];
#define L2_LOAD(n_) do { const size_t e0 = (size_t)(row0 + 16 * q) * DA + (n_) * HD + ch; const bf16_t* gp = C.H + (size_t)(row0 + 16 * q) * HP + C_AG + (n_) * HD + ch; \
        _Pragma("unroll") for (int i = 0; i < 16; ++i) { av[i] = C.AG_[e0 + (size_t)i * DA]; uv[i] = bf2f(C.UG_[e0 + (size_t)i * DA]); gv[i] = bf2f(gp[(size_t)i * HP]); } } while (0)
    L2_LOAD(0);
#pragma unroll
    for (int i = 0; i < 2; ++i) {
        const int cc = tid + 512 * i; float h = 0.f; const float* sa = C.SA + (size_t)b * 64 * DA + cc; const float* sh = C.SH + (size_t)b * 64 * DA + cc;
        for (int j0 = 0; j0 < c; j0 += 16) {
            float fa[16], fh[16];
#pragma unroll
            for (int k = 0; k < 16; ++k) { fa[k] = sa[(size_t)(j0 + k) * DA]; fh[k] = sh[(size_t)(j0 + k) * DA]; }
#pragma unroll
            for (int k = 0; k < 16; ++k) if (j0 + k < c) h = fa[k] * h + fh[k];
        }
        H0[cc] = h;
    }
    for (int n = 0; n < 8; ++n) {
        float ra = 1.f, rh = 0.f;
#pragma unroll
        for (int i = 0; i < 16; ++i) { rh = av[i] * rh + uv[i]; ra *= av[i]; }
        LAS float* qs = QS + (n & 1) * 1024;
        qs[(q * HD + ch) * 2] = ra; qs[(q * HD + ch) * 2 + 1] = rh;
        __syncthreads();
        float h = H0[n * HD + ch];
        for (int qq = 0; qq < q; ++qq) h = qs[(qq * HD + ch) * 2] * h + qs[(qq * HD + ch) * 2 + 1];
        LAS bf16_t* yp = YT + (16 * q) * DA + n * HD + ch;
#pragma unroll
        for (int i = 0; i < 16; ++i) { h = av[i] * h + uv[i]; yp[i * DA] = f2bf(h * fast_gelu_tanh(gv[i])); }
        if (q == 3 && c == 63) C.out[O_PLRU + (size_t)(C.l * NB_P + b) * DA + n * HD + ch] = h;
        if (n + 1 < 8) L2_LOAD(n + 1);
    }
#undef L2_LOAD
    __syncthreads();
    {
        const int st = tid >> 3, scg = tid & 7;
        const LAS bf16_t* rp = YT + st * DA + 128 * scg;
        u32x4 w[16]; float s2 = 0.f;
#pragma unroll
        for (int k = 0; k < 16; ++k) { w[k] = *(const LAS u32x4*)(rp + 8 * ((k + scg + 2 * st) & 15));
            const unsigned ww[4] = {w[k].x, w[k].y, w[k].z, w[k].w};
#pragma unroll
            for (int e = 0; e < 4; ++e) { const float a = bflo(ww[e]), bq = bfhi(ww[e]); s2 += a * a + bq * bq; } }
        s2 += __builtin_bit_cast(float, __builtin_amdgcn_update_dpp(0, __builtin_bit_cast(int, s2), 0xB1, 0xF, 0xF, true));
        s2 += __builtin_bit_cast(float, __builtin_amdgcn_update_dpp(0, __builtin_bit_cast(int, s2), 0x4E, 0xF, 0xF, true));
        s2 += __builtin_bit_cast(float, __builtin_amdgcn_update_dpp(0, __builtin_bit_cast(int, s2), 0x141, 0xF, 0xF, true));
        const float rstd = rsqrtf(s2 * (1.f / DA) + LN_EPS);
        const float* gp = C.gm + 128 * scg;
        bf16_t* yo = C.Y + (size_t)(row0 + st) * DM + 128 * scg;
#pragma unroll
        for (int k = 0; k < 16; ++k) {
            const int kk = (k + scg + 2 * st) & 15;
            const f32x4 ga = *(const f32x4*)(gp + 8 * kk), gb = *(const f32x4*)(gp + 8 * kk + 4);
            u32x4 o; o.x = pkbf(bflo(w[k].x) * rstd * ga.x, bfhi(w[k].x) * rstd * ga.y); o.y = pkbf(bflo(w[k].y) * rstd * ga.z, bfhi(w[k].y) * rstd * ga.w);
            o.z = pkbf(bflo(w[k].z) * rstd * gb.x, bfhi(w[k].z) * rstd * gb.y); o.w = pkbf(bflo(w[k].w) * rstd * gb.z, bfhi(w[k].w) * rstd * gb.w);
            *(u32x4*)(yo + 8 * kk) = o;
        }
    }
    __syncthreads();
}

constexpr int W2_XCB = 0  , W2_AG = 32768  , W2_SS = 65536, W2_H0 = 65792,
              W2_CW = 69888  , W2_GC = 90368  , W2_GM = 102656  , W2_AP = 106752  , W2_END = 139520;
static_assert(W2_END <= RING_BYTES, "lru strip LDS map");

template <bool PASS2, bool AB = false>
__device__ __forceinline__ void lru_item2(LAS unsigned char* lds, const LruCtx& C, int chunk) {
    int tid_ = threadIdx.x; asm volatile("" : "+v"(tid_));
    const int tid = tid_, lane = tid & 63, wave = __builtin_amdgcn_readfirstlane(tid >> 6);
    const bool prm = chunk < 256; const int b = prm ? (chunk >> 6) : (chunk - 256), c = prm ? (chunk & 63) : 0;
    const int row0 = prm ? b * SEQ + 64 * c : TP + b * TS;
    LAS float* SS = (LAS float*)(lds + W2_SS); LAS float* H0 = (LAS float*)(lds + W2_H0); LAS float* CW = (LAS float*)(lds + W2_CW); LAS float* GC = (LAS float*)(lds + W2_GC);
    const int st_ = tid >> 3, scg_ = tid & 7;
#pragma unroll
    for (int i = 0; i < 2; ++i) {
        const int ch = tid + 512 * i;
        CW[ch] = C.bconv[ch];
#pragma unroll
        for (int j = 0; j < 4; ++j) CW[(1 + j) * DA + ch] = C.wconv[(size_t)j * DA + ch];
        GC[ch] = C.bra[ch]; GC[DA + ch] = C.brx[ch]; GC[2 * DA + ch] = log1pf(expf(-C.lam[ch]));
        if constexpr (PASS2) ((LAS float*)(lds + W2_GM))[ch] = C.gm[ch];
    }
    if constexpr (PASS2) {
#pragma unroll
        for (int i = 0; i < 2; ++i) {
            const int ch = tid + 512 * i; float h;
            if (prm) { h = 0.f; const float* sa = C.SA + (size_t)b * 64 * DA + ch; const float* sh = C.SH + (size_t)b * 64 * DA + ch;
                for (int j0 = 0; j0 < c; j0 += 16) {
                    float av[16], hv[16];
#pragma unroll
                    for (int k = 0; k < 16; ++k) { av[k] = sa[(size_t)(j0 + k) * DA]; hv[k] = sh[(size_t)(j0 + k) * DA]; }
#pragma unroll
                    for (int k = 0; k < 16; ++k) if (j0 + k < c) h = av[k] * h + hv[k];
                } }
            else h = C.slru[(size_t)b * DA + ch];
            H0[ch] = h;
        }
        if (tid < 64) SS[tid] = 0.f;
    }
    __syncthreads();
    for (int rd = 0; rd < 4; ++rd) {
#pragma unroll
        for (int nb = 0; nb < 2; ++nb) {
            int st = st_, scg = scg_; asm volatile("" : "+v"(st), "+v"(scg));
            const int n = 2 * rd + nb, col = n * HD + 16 * scg;
            f32x4 acc[4];
#pragma unroll
            for (int k = 0; k < 4; ++k) acc[k] = *(const LAS f32x4*)(CW + col + 4 * k);
#pragma unroll
            for (int j = 0; j < 4; ++j) {
                const int tt = st + j - 3, tpos = (prm ? 64 * c : 0) + tt;
                f32x4 x[4];
                if (tpos >= 0) {
                    const bf16_t* hp = C.H + (size_t)(row0 + tt) * HP + C_AX + col;
                    const u32x4 r0 = *(const u32x4*)hp, r1 = *(const u32x4*)(hp + 8);
                    x[0] = (f32x4){bflo(r0.x), bfhi(r0.x), bflo(r0.y), bfhi(r0.y)}; x[1] = (f32x4){bflo(r0.z), bfhi(r0.z), bflo(r0.w), bfhi(r0.w)};
                    x[2] = (f32x4){bflo(r1.x), bfhi(r1.x), bflo(r1.y), bfhi(r1.y)}; x[3] = (f32x4){bflo(r1.z), bfhi(r1.z), bflo(r1.w), bfhi(r1.w)};
                } else if (!prm) {
                    const float* sp = C.sconv + ((size_t)b * 3 + (tpos + 3)) * DA + col;
#pragma unroll
                    for (int k = 0; k < 4; ++k) x[k] = *(const f32x4*)(sp + 4 * k);
                } else {
#pragma unroll
                    for (int k = 0; k < 4; ++k) x[k] = (f32x4){0.f, 0.f, 0.f, 0.f};
                }
#pragma unroll
                for (int k = 0; k < 4; ++k) { const f32x4 w = *(const LAS f32x4*)(CW + (1 + j) * DA + col + 4 * k); acc[k] += w * x[k]; }
            }
            u32x4 w0, w1;
            w0.x = pkbf(acc[0].x, acc[0].y); w0.y = pkbf(acc[0].z, acc[0].w); w0.z = pkbf(acc[1].x, acc[1].y); w0.w = pkbf(acc[1].z, acc[1].w);
            w1.x = pkbf(acc[2].x, acc[2].y); w1.y = pkbf(acc[2].z, acc[2].w); w1.z = pkbf(acc[3].x, acc[3].y); w1.w = pkbf(acc[3].z, acc[3].w);
            LAS unsigned char* XCB = lds + W2_XCB + nb * 16384;
            *(LAS u32x4*)(XCB + off_b(st, 2 * scg)) = w0; *(LAS u32x4*)(XCB + off_b(st, 2 * scg + 1)) = w1;
            { LAS unsigned char* XP = lds + W2_AP + nb * 16384 + st * 256 + 32 * scg; *(LAS u32x4*)XP = w0; *(LAS u32x4*)(XP + 16) = w1; }
            if constexpr (PASS2 || AB) {
                const bf16_t* gp = C.H + (size_t)(row0 + st) * HP + C_AG + col;
                LAS bf16_t* AG = (LAS bf16_t*)(lds + W2_AG + nb * 16384);
                *(LAS u32x4*)(AG + st * HD + 16 * scg) = *(const u32x4*)gp; *(LAS u32x4*)(AG + st * HD + 16 * scg + 8) = *(const u32x4*)(gp + 8);
            }
        }
        {
            int ln = lane; asm volatile("" : "+v"(ln));
            const int lq = ln & 31, lh = ln >> 5;
            const int nb = wave >> 2, ct = wave & 3, n = 2 * rd + nb, ch = 32 * ct + lq, gch = n * HD + ch;
            u32x4 wq0[8], wq1[8];
            { const bf16_t* b0p = C.WgT + ((size_t)(0 * 8 + n) * HD + ch) * HD + 8 * lh; const bf16_t* b1p = C.WgT + ((size_t)(1 * 8 + n) * HD + ch) * HD + 8 * lh;
#pragma unroll
              for (int s = 0; s < 8; ++s) { wq0[s] = *(const u32x4*)(b0p + 16 * s); wq1[s] = *(const u32x4*)(b1p + 16 * s); } }
            __syncthreads();
            const LAS unsigned char* XCB = lds + W2_XCB + nb * 16384;
            f32x16 g[2][2];
#pragma unroll
            for (int r = 0; r < 16; ++r) { g[0][0][r] = 0.f; g[0][1][r] = 0.f; g[1][0][r] = 0.f; g[1][1][r] = 0.f; }
#pragma unroll
            for (int s = 0; s < 8; ++s) {
                const bf16x8 w0 = __builtin_bit_cast(bf16x8, wq0[s]), w1 = __builtin_bit_cast(bf16x8, wq1[s]);
                const bf16x8 a0 = *(const LAS bf16x8*)(XCB + off_b(lq, 2 * s + lh)), a1 = *(const LAS bf16x8*)(XCB + off_b(32 + lq, 2 * s + lh));
                g[0][0] = MFMA32(a0, w0, g[0][0]); g[1][0] = MFMA32(a0, w1, g[1][0]); g[0][1] = MFMA32(a1, w0, g[0][1]); g[1][1] = MFMA32(a1, w1, g[1][1]);
            }
            const float bra = GC[gch], brx = GC[DA + gch], sp = GC[2 * DA + gch];
            {
                constexpr float L2E = 1.4426950408889634f;
                const LAS unsigned char* XPL = lds + W2_AP + nb * 16384;
                const float nb0 = -L2E * bra, nb1 = -L2E * brx, ka = -8.0f * L2E * sp, kx = -16.0f * sp;
#pragma unroll
                for (int rt = 0; rt < 2; ++rt)
#pragma unroll
                    for (int rp = 0; rp < 8; ++rp) {
                        const int r = 2 * rp, t = 32 * rt + 8 * (r >> 2) + 4 * lh + (r & 3);
                        const f32x2 e0 = (f32x2){g[0][rt][r], g[0][rt][r + 1]} * -L2E + nb0, e1 = (f32x2){g[1][rt][r], g[1][rt][r + 1]} * -L2E + nb1;
                        const f32x2 d0 = (f32x2){__builtin_amdgcn_exp2f(e0.x), __builtin_amdgcn_exp2f(e0.y)} + 1.f, d1 = (f32x2){__builtin_amdgcn_exp2f(e1.x), __builtin_amdgcn_exp2f(e1.y)} + 1.f;
                        const f32x2 rg = {__builtin_amdgcn_rcpf(d0.x), __builtin_amdgcn_rcpf(d0.y)}, ig = {__builtin_amdgcn_rcpf(d1.x), __builtin_amdgcn_rcpf(d1.y)};
                        const f32x2 la = rg * ka;
                        const f32x2 a = {__builtin_amdgcn_exp2f(la.x), __builtin_amdgcn_exp2f(la.y)};
                        const f32x2 x = rg * kx;
                        const f32x2 big = 1.f - a * a;
                        const f32x2 sm = -x * (1.f + x * (0.5f + x * (0.16666667f + x * (0.041666668f + x * 0.0083333338f))));
                        const f32x2 om = {(x.x > -0.25f) ? sm.x : big.x, (x.y > -0.25f) ? sm.y : big.y};
                        f32x2 mult = {__builtin_amdgcn_sqrtf(om.x), __builtin_amdgcn_sqrtf(om.y)};
                        if (prm && c == 0 && t == 0) mult.x = 1.0f;
                        const f32x2 xc = {bf2f(*(const LAS bf16_t*)(XPL + t * 256 + 2 * ch)), bf2f(*(const LAS bf16_t*)(XPL + (t + 1) * 256 + 2 * ch))};
                        const f32x2 u = mult * (ig * xc);
                        g[0][rt][r] = a.x; g[0][rt][r + 1] = a.y; g[1][rt][r] = u.x; g[1][rt][r + 1] = u.y;
                    }
            }
            float sa[8], sh[8];
#pragma unroll
            for (int k = 0; k < 8; ++k) {
                float A = 1.f, Hh = 0.f;
#pragma unroll
                for (int i = 0; i < 4; ++i) { const float a = g[0][k >> 2][4 * (k & 3) + i], u = g[1][k >> 2][4 * (k & 3) + i]; Hh = a * Hh + u; A *= a; }
                sa[k] = A; sh[k] = Hh;
            }
            float cin = PASS2 ? H0[gch] : 0.f;
            float ck[8];
            float cA = 1.f, pk[8];
#pragma unroll
            for (int k = 0; k < 8; ++k) {
                const float pa = xshfl32(sa[k], ln), ph = xshfl32(sh[k], ln);
                const float a_even = lh ? pa : sa[k], h_even = lh ? ph : sh[k], a_odd = lh ? sa[k] : pa, h_odd = lh ? sh[k] : ph;
                const float c_even = cin, c_odd = a_even * cin + h_even;
                ck[k] = lh ? c_odd : c_even;
                cin = a_odd * c_odd + h_odd;
                if constexpr (AB) { const float q_odd = a_even * cA; pk[k] = lh ? q_odd : cA; cA = a_odd * q_odd; }
            }
            if constexpr (!PASS2) {
                float atot = 1.f;
                if constexpr (AB) atot = cA;
                else {
#pragma unroll
                    for (int k = 0; k < 8; ++k) atot *= sa[k];
                    atot *= xshfl32(atot, ln);
                }
                if (lh == 0) { C.SA[((size_t)b * 64 + c) * DA + gch] = atot; C.SH[((size_t)b * 64 + c) * DA + gch] = cin; }
                if constexpr (AB) {
                    LAS bf16_t* AG = (LAS bf16_t*)(lds + W2_AG + nb * 16384); LAS bf16_t* AP = (LAS bf16_t*)(lds + W2_AP + nb * 16384);
#pragma unroll
                    for (int k = 0; k < 8; ++k) {
                        float h = ck[k], p = pk[k];
#pragma unroll
                        for (int i = 0; i < 4; ++i) {
                            const int r = 4 * (k & 3) + i, rt = k >> 2, t = 32 * rt + 8 * (k & 3) + 4 * lh + i;
                            h = g[0][rt][r] * h + g[1][rt][r]; p *= g[0][rt][r];
                            LAS bf16_t* yp = AG + t * HD + ch;
                            const float gl = fast_gelu_tanh2(bf2f(*yp));
                            const unsigned w2 = pkbf(h * gl, p * gl);
                            *yp = (bf16_t)w2; AP[t * HD + ch] = (bf16_t)(w2 >> 16);
                        }
                    }
                }
            } else {
                LAS bf16_t* AG = (LAS bf16_t*)(lds + W2_AG + nb * 16384);
#pragma unroll
                for (int k = 0; k < 8; ++k) {
                    float h = ck[k];
#pragma unroll
                    for (int i = 0; i < 4; ++i) {
                        const int r = 4 * (k & 3) + i, rt = k >> 2, t = 32 * rt + 8 * (k & 3) + 4 * lh + i;
                        h = g[0][rt][r] * h + g[1][rt][r];
                        LAS bf16_t* yp = AG + t * HD + ch;
                        *yp = (bf16_t)pkbf(h * fast_gelu_tanh2(bf2f(*yp)), 0.f);
                    }
                }
                if (lh == 1 && (!prm || c == 63)) { if (prm) C.out[O_PLRU + (size_t)(C.l * NB_P + b) * DA + gch] = cin; else C.out[O_SLRU + (size_t)(C.l * NB_S + b) * DA + gch] = cin; }
            }
        }
        __syncthreads();
        if constexpr (AB) {
            int st = st_, scg = scg_; asm volatile("" : "+v"(st), "+v"(scg));
#pragma unroll
            for (int nb = 0; nb < 2; ++nb) {
                const LAS bf16_t* AG = (const LAS bf16_t*)(lds + W2_AG + nb * 16384); const LAS bf16_t* AP = (const LAS bf16_t*)(lds + W2_AP + nb * 16384);
                const u32x4 y0 = *(const LAS u32x4*)(AG + st * HD + 16 * scg), y1 = *(const LAS u32x4*)(AG + st * HD + 16 * scg + 8);
                const u32x4 p0 = *(const LAS u32x4*)(AP + st * HD + 16 * scg), p1 = *(const LAS u32x4*)(AP + st * HD + 16 * scg + 8);
                const size_t o = (size_t)(row0 + st) * DA + (2 * rd + nb) * HD + 16 * scg;
                bf16_t* bp = C.UG_ + o; bf16_t* ap = bp - (WS_UU - WS_AA) / 2;
                *(u32x4*)bp = y0; *(u32x4*)(bp + 8) = y1; *(u32x4*)ap = p0; *(u32x4*)(ap + 8) = p1;
            }
            __syncthreads();
        }
        if constexpr (PASS2) {
            int st = st_, scg = scg_; asm volatile("" : "+v"(st), "+v"(scg));
            float q = 0.f;
#pragma unroll
            for (int nb = 0; nb < 2; ++nb) {
                const LAS bf16_t* AG = (const LAS bf16_t*)(lds + W2_AG + nb * 16384);
                const u32x4 y0 = *(const LAS u32x4*)(AG + st * HD + 16 * scg), y1 = *(const LAS u32x4*)(AG + st * HD + 16 * scg + 8);
                bf16_t* yp = C.Y + (size_t)(row0 + st) * DM + (2 * rd + nb) * HD + 16 * scg;
                *(u32x4*)yp = y0; *(u32x4*)(yp + 8) = y1;
                const unsigned w[8] = {y0.x, y0.y, y0.z, y0.w, y1.x, y1.y, y1.z, y1.w};
#pragma unroll
                for (int k = 0; k < 8; ++k) { const float a = bflo(w[k]), bq = bfhi(w[k]); q += a * a + bq * bq; }
            }
            q += __builtin_bit_cast(float, __builtin_amdgcn_update_dpp(0, __builtin_bit_cast(int, q), 0xB1, 0xF, 0xF, true));
            q += __builtin_bit_cast(float, __builtin_amdgcn_update_dpp(0, __builtin_bit_cast(int, q), 0x4E, 0xF, 0xF, true));
            q += __builtin_bit_cast(float, __builtin_amdgcn_update_dpp(0, __builtin_bit_cast(int, q), 0x141, 0xF, 0xF, true));
            if (scg == 0) SS[st] += q;
            __syncthreads();
        }
    }
    if constexpr (PASS2) {
        VM_WAIT();
        __syncthreads();
#pragma unroll
        for (int hf = 0; hf < 2; ++hf) {
            u32x4 raw[8];
#pragma unroll
            for (int i = 0; i < 8; ++i) { const int k = tid + 512 * (8 * hf + i), t = k >> 7, cc = k & 127; raw[i] = *(const u32x4*)(C.Y + (size_t)(row0 + t) * DM + 8 * cc); }
#pragma unroll
            for (int i = 0; i < 8; ++i) {
                const int k = tid + 512 * (8 * hf + i), t = k >> 7, cc = k & 127;
                const float rstd = rsqrtf(SS[t] * (1.f / DA) + LN_EPS);
                const LAS float* gp = (const LAS float*)(lds + W2_GM) + 8 * cc;
                const f32x4 ga = *(const LAS f32x4*)gp, gb = *(const LAS f32x4*)(gp + 4);
                u32x4 o; o.x = pkbf(bflo(raw[i].x) * rstd * ga.x, bfhi(raw[i].x) * rstd * ga.y); o.y = pkbf(bflo(raw[i].y) * rstd * ga.z, bfhi(raw[i].y) * rstd * ga.w);
                o.z = pkbf(bflo(raw[i].z) * rstd * gb.x, bfhi(raw[i].z) * rstd * gb.y); o.w = pkbf(bflo(raw[i].w) * rstd * gb.z, bfhi(raw[i].w) * rstd * gb.w);
                *(u32x4*)(C.Y + (size_t)(row0 + t) * DM + 8 * cc) = o;
            }
        }
        if (C.OB) {
#pragma unroll
            for (int which = 0; which < 2; ++which) {
                int st = st_, scg = scg_; asm volatile("" : "+v"(st), "+v"(scg));
                const bf16_t* src = (which ? C.OC : C.OB) + (size_t)(row0 + st) * DB + 64 * scg;
                f32x4 v[16]; float q = 0.f;
#pragma unroll
                for (int k = 0; k < 8; ++k) { const u32x4 w = *(const u32x4*)(src + 8 * k);
                    v[2 * k] = (f32x4){bflo(w.x), bfhi(w.x), bflo(w.y), bfhi(w.y)}; v[2 * k + 1] = (f32x4){bflo(w.z), bfhi(w.z), bflo(w.w), bfhi(w.w)}; }
#pragma unroll
                for (int k = 0; k < 16; ++k) q += (v[k].x * v[k].x + v[k].y * v[k].y) + (v[k].z * v[k].z + v[k].w * v[k].w);
                q += __builtin_bit_cast(float, __builtin_amdgcn_update_dpp(0, __builtin_bit_cast(int, q), 0xB1, 0xF, 0xF, true));
                q += __builtin_bit_cast(float, __builtin_amdgcn_update_dpp(0, __builtin_bit_cast(int, q), 0x4E, 0xF, 0xF, true));
                q += __builtin_bit_cast(float, __builtin_amdgcn_update_dpp(0, __builtin_bit_cast(int, q), 0x141, 0xF, 0xF, true));
                const float rstd = rsqrtf(q * (1.f / DB) + LN_EPS);
                const float* gp = C.gm + DA + which * DB + 64 * scg;
                bf16_t* yp = C.Y + (size_t)(row0 + st) * DM + DA + which * DB + 64 * scg;
#pragma unroll
                for (int k = 0; k < 8; ++k) {
                    const f32x4 ga = *(const f32x4*)(gp + 8 * k), gb = *(const f32x4*)(gp + 8 * k + 4);
                    const f32x4 a = v[2 * k] * rstd * ga, bq = v[2 * k + 1] * rstd * gb;
                    u32x4 o; o.x = pkbf(a.x, a.y); o.y = pkbf(a.z, a.w); o.z = pkbf(bq.x, bq.y); o.w = pkbf(bq.z, bq.w);
                    *(u32x4*)(yp + 8 * k) = o;
                }
            }
        }
    }
    __syncthreads();
}

__device__ __forceinline__ void lru_fin(LAS unsigned char* lds, const LruCtx& C, int chunk) {
    int tid_ = threadIdx.x; asm volatile("" : "+v"(tid_));
    const int tid = tid_;
    const int b = chunk >> 6, c = chunk & 63, row0 = b * SEQ + 64 * c;
    LAS float* H0 = (LAS float*)(lds + W2_H0); LAS float* GM = (LAS float*)(lds + W2_GM);
    int st = tid >> 3, scg = tid & 7; asm volatile("" : "+v"(st), "+v"(scg));
    const bf16_t* bp = C.UG_ + (size_t)(row0 + st) * DA + 8 * scg;
    const bf16_t* ap = bp - (WS_UU - WS_AA) / 2;
    u32x4 av[8], bv[8];
#pragma unroll
    for (int i = 0; i < 8; ++i) { av[i] = *(const u32x4*)(ap + 64 * i); bv[i] = *(const u32x4*)(bp + 64 * i); }
    {
        float h0 = 0.f, h1 = 0.f;
        const float* sa = C.SA + (size_t)b * 64 * DA + tid; const float* sh = C.SH + (size_t)b * 64 * DA + tid;
        for (int j0 = 0; j0 < c; j0 += 16) {
            float a0[16], s0[16], a1[16], s1[16];
#pragma unroll
            for (int k = 0; k < 16; ++k) { a0[k] = sa[(size_t)(j0 + k) * DA]; s0[k] = sh[(size_t)(j0 + k) * DA]; a1[k] = sa[(size_t)(j0 + k) * DA + 512]; s1[k] = sh[(size_t)(j0 + k) * DA + 512]; }
#pragma unroll
            for (int k = 0; k < 16; ++k) if (j0 + k < c) { h0 = a0[k] * h0 + s0[k]; h1 = a1[k] * h1 + s1[k]; }
        }
        H0[tid] = h0; H0[tid + 512] = h1; GM[tid] = C.gm[tid]; GM[tid + 512] = C.gm[tid + 512];
        if (c == 63) { float* op = C.out + O_PLRU + (size_t)(C.l * NB_P + b) * DA + tid;
                       op[0] = sa[(size_t)63 * DA] * h0 + sh[(size_t)63 * DA]; op[512] = sa[(size_t)63 * DA + 512] * h1 + sh[(size_t)63 * DA + 512]; }
    }
    __syncthreads();
    {
        u32x4 y[16]; float q = 0.f;
#pragma unroll
        for (int kb = 0; kb < 2; ++kb) {
            if (kb == 1) {
#pragma unroll
                for (int i = 0; i < 8; ++i) { av[i] = *(const u32x4*)(ap + 64 * (8 + i)); bv[i] = *(const u32x4*)(bp + 64 * (8 + i)); }
            }
#pragma unroll
            for (int i = 0; i < 8; ++i) {
                const LAS float* hp = H0 + 8 * scg + 64 * (8 * kb + i);
                const f32x4 h0 = *(const LAS f32x4*)hp, h1 = *(const LAS f32x4*)(hp + 4);
                const float r0 = bflo(bv[i].x) + bflo(av[i].x) * h0.x, r1 = bfhi(bv[i].x) + bfhi(av[i].x) * h0.y, r2 = bflo(bv[i].y) + bflo(av[i].y) * h0.z, r3 = bfhi(bv[i].y) + bfhi(av[i].y) * h0.w;
                const float r4 = bflo(bv[i].z) + bflo(av[i].z) * h1.x, r5 = bfhi(bv[i].z) + bfhi(av[i].z) * h1.y, r6 = bflo(bv[i].w) + bflo(av[i].w) * h1.z, r7 = bfhi(bv[i].w) + bfhi(av[i].w) * h1.w;
                q += (r0 * r0 + r1 * r1) + (r2 * r2 + r3 * r3) + (r4 * r4 + r5 * r5) + (r6 * r6 + r7 * r7);
                u32x4 o; o.x = pkbf(r0, r1); o.y = pkbf(r2, r3); o.z = pkbf(r4, r5); o.w = pkbf(r6, r7);
                y[8 * kb + i] = o;
            }
            __builtin_amdgcn_sched_barrier(0);
        }
        q += __builtin_bit_cast(float, __builtin_amdgcn_update_dpp(0, __builtin_bit_cast(int, q), 0xB1, 0xF, 0xF, true));
        q += __builtin_bit_cast(float, __builtin_amdgcn_update_dpp(0, __builtin_bit_cast(int, q), 0x4E, 0xF, 0xF, true));
        q += __builtin_bit_cast(float, __builtin_amdgcn_update_dpp(0, __builtin_bit_cast(int, q), 0x141, 0xF, 0xF, true));
        const float rstd = rsqrtf(q * (1.f / DA) + LN_EPS);
        bf16_t* yo = C.Y + (size_t)(row0 + st) * DM + 8 * scg;
#pragma unroll
        for (int k = 0; k < 16; ++k) {
            const LAS float* gp = GM + 8 * scg + 64 * k;
            const f32x4 ga = *(const LAS f32x4*)gp, gb = *(const LAS f32x4*)(gp + 4);
            u32x4 o; o.x = pkbf(bflo(y[k].x) * rstd * ga.x, bfhi(y[k].x) * rstd * ga.y); o.y = pkbf(bflo(y[k].y) * rstd * ga.z, bfhi(y[k].y) * rstd * ga.w);
            o.z = pkbf(bflo(y[k].z) * rstd * gb.x, bfhi(y[k].z) * rstd * gb.y); o.w = pkbf(bflo(y[k].w) * rstd * gb.z, bfhi(y[k].w) * rstd * gb.w);
            *(u32x4*)(yo + 64 * k) = o;
            if ((k & 3) == 3) __builtin_amdgcn_sched_barrier(0);
        }
    }
    __builtin_amdgcn_sched_barrier(0);
    if (C.OB) {
#pragma unroll
        for (int which = 0; which < 2; ++which) {
            int st = tid >> 3, scg = tid & 7; asm volatile("" : "+v"(st), "+v"(scg));
            const bf16_t* src = (which ? C.OC : C.OB) + (size_t)(row0 + st) * DB + 64 * scg;
            f32x4 v[16]; float q = 0.f;
#pragma unroll
            for (int k = 0; k < 8; ++k) { const u32x4 w = *(const u32x4*)(src + 8 * k);
                v[2 * k] = (f32x4){bflo(w.x), bfhi(w.x), bflo(w.y), bfhi(w.y)}; v[2 * k + 1] = (f32x4){bflo(w.z), bfhi(w.z), bflo(w.w), bfhi(w.w)}; }
#pragma unroll
            for (int k = 0; k < 16; ++k) q += (v[k].x * v[k].x + v[k].y * v[k].y) + (v[k].z * v[k].z + v[k].w * v[k].w);
            q += __builtin_bit_cast(float, __builtin_amdgcn_update_dpp(0, __builtin_bit_cast(int, q), 0xB1, 0xF, 0xF, true));
            q += __builtin_bit_cast(float, __builtin_amdgcn_update_dpp(0, __builtin_bit_cast(int, q), 0x4E, 0xF, 0xF, true));
            q += __builtin_bit_cast(float, __builtin_amdgcn_update_dpp(0, __builtin_bit_cast(int, q), 0x141, 0xF, 0xF, true));
            const float rstd = rsqrtf(q * (1.f / DB) + LN_EPS);
            const float* gp = C.gm + DA + which * DB + 64 * scg;
            bf16_t* yp = C.Y + (size_t)(row0 + st) * DM + DA + which * DB + 64 * scg;
#pragma unroll
            for (int k = 0; k < 8; ++k) {
                const f32x4 ga = *(const f32x4*)(gp + 8 * k), gb = *(const f32x4*)(gp + 8 * k + 4);
                const f32x4 a = v[2 * k] * rstd * ga, bq = v[2 * k + 1] * rstd * gb;
                u32x4 o; o.x = pkbf(a.x, a.y); o.y = pkbf(a.z, a.w); o.z = pkbf(bq.x, bq.y); o.w = pkbf(bq.z, bq.w);
                *(u32x4*)(yp + 8 * k) = o;
            }
        }
    }
    __syncthreads();
}
constexpr int CW_BAR = 4096;
constexpr int N_MV = 8192;
constexpr int CV_I_IN = (DM / 64) * (DINP / 32), CV_I_OUT = (DM / 64) * (DM / 32), CV_I_UP = (DM / 64) * (DFF / 32), CV_I_DN = (DFF / 64) * (DM / 32), CV_I_G = 16 * 8, CV_I_L = CV_I_IN + CV_I_OUT + CV_I_UP + CV_I_DN + CV_I_G;
constexpr int CV2_A0 = CV_I_IN + N_MV, CV2_AN = CV_I_OUT + CV_I_UP - N_MV + CV_I_DN, CV2_B0 = CV_I_L, CV2_BN = 4096, N_MV2 = CV2_AN + CV2_BN;
static_assert(CV2_A0 + CV2_AN == CV_I_IN + CV_I_OUT + CV_I_UP + CV_I_DN && CV2_BN <= CV_I_IN && CV2_AN % 2048 == 0 && CV2_BN % 2048 == 0, "filler ranges");
constexpr int CW_QUEUE = 65536;
constexpr int CW_LRUCNT = 98304;
constexpr int CW_SPLITK = 131072;
constexpr size_t CTL_ZERO_BYTES = 1 * MiB;
constexpr int NPH = 2 + 8 * DEPTH;

__device__ __forceinline__ unsigned pk2(float lo, float hi) { return pg8::cvt_pk_bf16(lo, hi); }

struct Args { const float* in[27]; float* out; unsigned char* ws; int ph_lo, ph_hi, li, flags; };

__device__ __forceinline__ void tr_item(const float* W, int K, int ld, int ncols, bf16_t* WT, LAS float* scr, int item, int lane) {
    const int nblk = ncols / 32, kb = item / nblk, nb = item % nblk, k0 = 64 * kb, n0 = 32 * nb;
    float wv[32];
#pragma unroll
    for (int i = 0; i < 32; ++i) wv[i] = W[(size_t)(k0 + 2 * i + (lane >> 5)) * ld + n0 + (lane & 31)];
#pragma unroll
    for (int i = 0; i < 32; ++i) scr[(2 * i + (lane >> 5)) * 33 + (lane & 31)] = wv[i];
    LDS_WAIT(); asm volatile("" ::: "memory");
    const int c = lane & 7;
#pragma unroll
    for (int j = 0; j < 4; ++j) { const int n = (lane >> 3) + 8 * j; const LAS float* s = scr + (8 * c) * 33 + n;
        u32x4 o; o.x = pk2(s[0 * 33], s[1 * 33]); o.y = pk2(s[2 * 33], s[3 * 33]); o.z = pk2(s[4 * 33], s[5 * 33]); o.w = pk2(s[6 * 33], s[7 * 33]);
        *(u32x4*)(WT + (size_t)(n0 + n) * K + k0 + 8 * c) = o; }
    LDS_WAIT(); asm volatile("" ::: "memory");
}
__device__ __forceinline__ void conv_item(int it, const float* w_in, const float* w_out, const float* w_up, const float* w_dn, const float* w_ra, const float* w_rx,
                                          bf16_t* WinT, bf16_t* WoutT, bf16_t* WupT, bf16_t* WdnT, bf16_t* WgT, LAS float* scr, int lane) {
    const int l = it / CV_I_L; int r = it % CV_I_L;
    if (r < CV_I_IN) { tr_item(w_in + (size_t)l * DM * DIN, DM, DIN, DINP, WinT + (size_t)l * DINP * DM, scr, r, lane); return; } r -= CV_I_IN;
    if (r < CV_I_OUT) { tr_item(w_out + (size_t)l * DM * DM, DM, DM, DM, WoutT + (size_t)l * DM * DM, scr, r, lane); return; } r -= CV_I_OUT;
    if (r < CV_I_UP) { tr_item(w_up + (size_t)l * DM * DFF, DM, DFF, DFF, WupT + (size_t)l * DFF * DM, scr, r, lane); return; } r -= CV_I_UP;
    if (r < CV_I_DN) { tr_item(w_dn + (size_t)l * DFF * DM, DFF, DM, DM, WdnT + (size_t)l * DM * DFF, scr, r, lane); return; } r -= CV_I_DN;
    { const int mat = r >> 3, sub = r & 7, gate = mat >> 3, n = mat & 7;
      const float* src = (gate ? w_rx : w_ra) + ((size_t)l * 8 + n) * HD * HD;
      tr_item(src, HD, HD, HD, WgT + (((size_t)l * 2 + gate) * 8 + n) * HD * HD, scr, sub, lane); }
}
__device__ __forceinline__ void logf_store(float d0, float d1, float d2, float d3, const float* bfg, float* out, int l, int row, int lane) {
    d0 = wave_sum(d0); d1 = wave_sum(d1); d2 = wave_sum(d2); d3 = wave_sum(d3);
    if (lane < 4) {
        const float d = lane == 0 ? d0 : lane == 1 ? d1 : lane == 2 ? d2 : d3;
        const float lf = log_sigmoid_f(d + bfg[lane]);
        bool prm; int b, t; row_bt(row, prm, b, t);
        if (prm) out[O_PFL + ((size_t)(l * NB_P + b) * SEQ + t) * NH + lane] = lf;
        else out[O_SFL + ((size_t)(l * NB_S + b) * TS + t) * NH + lane] = lf;
    }
}
template <int NR>
__device__ __forceinline__ void xcvt_rows(const float* x_p, const float* x_s, const float* wf, const float* bfg, bf16_t* xb, float* out, int l, int row0, int rstep, int nvalid, int lane) {
    f32x4 v[NR][8];
#pragma unroll
    for (int r = 0; r < NR; ++r) {
        const float* xr = xrow0(x_p, x_s, (r < nvalid) ? row0 + r * rstep : row0);
#pragma unroll
        for (int j = 0; j < 8; ++j) v[r][j] = ((const f32x4*)xr)[lane + 64 * j];
    }
    float d[NR][4];
#pragma unroll
    for (int r = 0; r < NR; ++r) { d[r][0] = 0.f; d[r][1] = 0.f; d[r][2] = 0.f; d[r][3] = 0.f; }
#pragma unroll
    for (int j = 0; j < 8; ++j) {
        const int c = lane + 64 * j;
        const f32x4 w0 = ((const f32x4*)wf)[c], w1 = ((const f32x4*)(wf + DM))[c], w2 = ((const f32x4*)(wf + 2 * DM))[c], w3 = ((const f32x4*)(wf + 3 * DM))[c];
#pragma unroll
        for (int r = 0; r < NR; ++r) {
            if (r < nvalid) {
                const f32x4 o = v[r][j];
                u32x2 p; p.x = pk2(o.x, o.y); p.y = pk2(o.z, o.w);
                ((u32x2*)(xb + (size_t)(row0 + r * rstep) * DM))[c] = p;
                d[r][0] += o.x * w0.x + o.y * w0.y + o.z * w0.z + o.w * w0.w; d[r][1] += o.x * w1.x + o.y * w1.y + o.z * w1.z + o.w * w1.w;
                d[r][2] += o.x * w2.x + o.y * w2.y + o.z * w2.z + o.w * w2.w; d[r][3] += o.x * w3.x + o.y * w3.y + o.z * w3.z + o.w * w3.w;
            }
        }
    }
#pragma unroll
    for (int r = 0; r < NR; ++r) if (r < nvalid) logf_store(d[r][0], d[r][1], d[r][2], d[r][3], bfg, out, l, row0 + r * rstep, lane);
}
template <int NR>
__device__ __forceinline__ void ln_rows(const bf16_t* z, const float* g, const float* bta, float* xf, bf16_t* xb, const float* wf_next, const float* bfg_next, float* out, int lnext, int row0, int rstep, int nvalid, int lane) {
    u32x4 w[NR][4]; float s[NR];
#pragma unroll
    for (int r = 0; r < NR; ++r) {
        const int row = (r < nvalid) ? row0 + r * rstep : row0;
#pragma unroll
        for (int jj = 0; jj < 4; ++jj) w[r][jj] = ((const u32x4*)(z + (size_t)row * DM))[lane + 64 * jj];
    }
#define LN_V(r, j) ((j & 1) ? (f32x4){bflo(w[r][(j) >> 1].z), bfhi(w[r][(j) >> 1].z), bflo(w[r][(j) >> 1].w), bfhi(w[r][(j) >> 1].w)} : (f32x4){bflo(w[r][(j) >> 1].x), bfhi(w[r][(j) >> 1].x), bflo(w[r][(j) >> 1].y), bfhi(w[r][(j) >> 1].y)})
    float mu[NR], rstd[NR];
#pragma unroll
    for (int r = 0; r < NR; ++r) {
        s[r] = 0.f;
#pragma unroll
        for (int j = 0; j < 8; ++j) { const f32x4 v = LN_V(r, j); s[r] += (v.x + v.y) + (v.z + v.w); }
        mu[r] = wave_sum(s[r]) * (1.f / DM); float q = 0.f;
#pragma unroll
        for (int j = 0; j < 8; ++j) { const f32x4 v = LN_V(r, j) - mu[r]; q += (v.x * v.x + v.y * v.y) + (v.z * v.z + v.w * v.w); }
        rstd[r] = rsqrtf(wave_sum(q) * (1.f / DM) + LN_EPS);
    }
    float d[NR][4];
#pragma unroll
    for (int r = 0; r < NR; ++r) { d[r][0] = 0.f; d[r][1] = 0.f; d[r][2] = 0.f; d[r][3] = 0.f; }
#pragma unroll
    for (int j = 0; j < 8; ++j) {
        const int c = 2 * (lane + 64 * (j >> 1)) + (j & 1);
        const f32x4 gg = ((const f32x4*)g)[c], bb = ((const f32x4*)bta)[c];
        f32x4 w0, w1, w2, w3;
        if (wf_next) { w0 = ((const f32x4*)wf_next)[c]; w1 = ((const f32x4*)(wf_next + DM))[c]; w2 = ((const f32x4*)(wf_next + 2 * DM))[c]; w3 = ((const f32x4*)(wf_next + 3 * DM))[c]; }
#pragma unroll
        for (int r = 0; r < NR; ++r) {
            if (r < nvalid) {
                const int row = row0 + r * rstep;
                const f32x4 o = (LN_V(r, j) - mu[r]) * rstd[r] * gg + bb;
                if (xf) ((f32x4*)(xf + (size_t)row * DM))[c] = o;
                u32x2 p; p.x = pk2(o.x, o.y); p.y = pk2(o.z, o.w);
                if (xb) ((u32x2*)(xb + (size_t)row * DM))[c] = p;
                if (wf_next) { d[r][0] += o.x * w0.x + o.y * w0.y + o.z * w0.z + o.w * w0.w; d[r][1] += o.x * w1.x + o.y * w1.y + o.z * w1.z + o.w * w1.w;
                               d[r][2] += o.x * w2.x + o.y * w2.y + o.z * w2.z + o.w * w2.w; d[r][3] += o.x * w3.x + o.y * w3.y + o.z * w3.z + o.w * w3.w; }
            }
        }
    }
#undef LN_V
    if (wf_next) {
#pragma unroll
        for (int r = 0; r < NR; ++r) if (r < nvalid) logf_store(d[r][0], d[r][1], d[r][2], d[r][3], bfg_next, out, lnext, row0 + r * rstep, lane);
    }
}
__device__ __forceinline__ void mixnorm_row(const float* OA, const bf16_t* OB, const bf16_t* OC, const float* PO, const float* PM, const float* PL, const float* gm, bf16_t* Y, bool with_a, int row, int lane) {
    if (with_a) {
        f32x4 a[4]; float sa = 0.f;
#pragma unroll
        for (int j = 0; j < 4; ++j) { a[j] = ((const f32x4*)(OA + (size_t)row * DA))[lane + 64 * j]; sa += (a[j].x * a[j].x + a[j].y * a[j].y) + (a[j].z * a[j].z + a[j].w * a[j].w); }
        const float ra = rsqrtf(wave_sum(sa) * (1.f / DA) + LN_EPS);
#pragma unroll
        for (int j = 0; j < 4; ++j) { const int c = lane + 64 * j; const f32x4 gg = ((const f32x4*)gm)[c]; const f32x4 o = a[j] * ra * gg;
            u32x2 p; p.x = pk2(o.x, o.y); p.y = pk2(o.z, o.w); ((u32x2*)(Y + (size_t)row * DM))[c] = p; }
    }
    {
        f32x4 b[2]; float sb = 0.f;
        { const u32x4 w = ((const u32x4*)(OB + (size_t)row * DB))[lane]; b[0] = (f32x4){bflo(w.x), bfhi(w.x), bflo(w.y), bfhi(w.y)}; b[1] = (f32x4){bflo(w.z), bfhi(w.z), bflo(w.w), bfhi(w.w)}; }
#pragma unroll
        for (int j = 0; j < 2; ++j) sb += (b[j].x * b[j].x + b[j].y * b[j].y) + (b[j].z * b[j].z + b[j].w * b[j].w);
        const float rb = rsqrtf(wave_sum(sb) * (1.f / DB) + LN_EPS);
#pragma unroll
        for (int j = 0; j < 2; ++j) { const int c = 2 * lane + j; const f32x4 gb = ((const f32x4*)(gm + DA))[c]; const f32x4 ob = b[j] * rb * gb;
            u32x2 p; p.x = pk2(ob.x, ob.y); p.y = pk2(ob.z, ob.w); ((u32x2*)(Y + (size_t)row * DM + DA))[c] = p; }
    }
    if (row < TP) {
        f32x4 cc[2]; float sc = 0.f;
        { const u32x4 w = ((const u32x4*)(OC + (size_t)row * DB))[lane]; cc[0] = (f32x4){bflo(w.x), bfhi(w.x), bflo(w.y), bfhi(w.y)}; cc[1] = (f32x4){bflo(w.z), bfhi(w.z), bflo(w.w), bfhi(w.w)}; }
#pragma unroll
        for (int j = 0; j < 2; ++j) sc += (cc[j].x * cc[j].x + cc[j].y * cc[j].y) + (cc[j].z * cc[j].z + cc[j].w * cc[j].w);
        const float rc = rsqrtf(wave_sum(sc) * (1.f / DB) + LN_EPS);
#pragma unroll
        for (int j = 0; j < 2; ++j) { const int c = 2 * lane + j; const f32x4 gc = ((const f32x4*)(gm + DA + DB))[c]; const f32x4 oc = cc[j] * rc * gc;
            u32x2 q; q.x = pk2(oc.x, oc.y); q.y = pk2(oc.z, oc.w); ((u32x2*)(Y + (size_t)row * DM + DA + DB))[c] = q; }
    } else {
        const int r = row - TP, b = r >> 6, qi = r & 63;
        float cv[NH][2]; float sc = 0.f;
#pragma unroll
        for (int hh = 0; hh < NH; ++hh) {
            const int bh = b * NH + hh;
            float m = -1e30f;
#pragma unroll
            for (int sp = 0; sp < NSPLIT; ++sp) m = fmaxf(m, PM[((size_t)bh * NSPLIT + sp) * TS + qi]);
            float l = 0.f, o0 = 0.f, o1 = 0.f;
#pragma unroll
            for (int sp = 0; sp < NSPLIT; ++sp) {
                const size_t pr = ((size_t)bh * NSPLIT + sp) * TS + qi;
                const float w = __builtin_amdgcn_exp2f(PM[pr] - m);
                l += PL[pr] * w; o0 += PO[pr * HD + lane] * w; o1 += PO[pr * HD + lane + 64] * w;
            }
            const float inv = 1.f / l;
            cv[hh][0] = o0 * inv; cv[hh][1] = o1 * inv; sc += cv[hh][0] * cv[hh][0] + cv[hh][1] * cv[hh][1];
        }
        const float rc = rsqrtf(wave_sum(sc) * (1.f / DB) + LN_EPS);
#pragma unroll
        for (int hh = 0; hh < NH; ++hh) {
            const int c0 = DA + DB + hh * HD + lane;
            Y[(size_t)row * DM + c0] = f2bf(cv[hh][0] * rc * gm[c0]); Y[(size_t)row * DM + c0 + 64] = f2bf(cv[hh][1] * rc * gm[c0 + 64]);
        }
    }
}
__device__ __forceinline__ void cumsum_seq(LAS float* scr, const float* out, const float* cfl_l, float* Fp, float* Fs, int l, int seq, int tid) {
    const int lane = tid & 63, wave = tid >> 6;
    const bool prm = seq < 16; const int bh = prm ? seq : seq - 16, b = bh >> 2, h = bh & 3;
    const int n = prm ? SEQ : PAST + TS, seg = prm ? 8 : 9;
    const int i0 = tid * seg, i1 = min(n, i0 + seg);
    float s = 0.f;
    for (int i = i0; i < i1; ++i) s += logf_get(out, cfl_l, l, prm, b, h, i);
    float v = s;
#pragma unroll
    for (int o = 1; o < 64; o <<= 1) { const float t = __builtin_bit_cast(float, __builtin_amdgcn_ds_bpermute((lane - o) << 2, __builtin_bit_cast(int, v))); if (lane >= o) v += t; }
    __syncthreads();
    if (lane == 63) scr[wave] = v;
    __syncthreads();
    float pre = 0.f;
    for (int w = 0; w < wave; ++w) pre += scr[w];
    float run = pre + v - s;
    float* dst = prm ? Fp + (size_t)bh * SEQ : Fs + (size_t)bh * (PAST + TS);
    for (int i = i0; i < i1; ++i) { run += logf_get(out, cfl_l, l, prm, b, h, i); dst[i] = run; }
}

__global__ void __launch_bounds__(NTHREADS, 2) mk_fwd(Args args) {
    extern __shared__ __attribute__((aligned(16))) unsigned char lds_raw[];
    LAS unsigned char* lds = (LAS unsigned char*)lds_raw;
    volatile LAS unsigned* MISC = (volatile LAS unsigned*)(lds + MISC_OFF);
    const int wave = __builtin_amdgcn_readfirstlane((int)threadIdx.x >> 6);
#define TIDF() ([]() __attribute__((always_inline)) { int t_ = threadIdx.x; asm volatile("" : "+v"(t_)); return t_; }())
#define tid TIDF()
#define lane (TIDF() & 63)
    typedef const __attribute__((address_space(4))) Args* KArgs;
#define KA() ([]() __attribute__((always_inline)) { KArgs a_ = (KArgs)__builtin_amdgcn_kernarg_segment_ptr(); asm volatile("" : "+s"(a_)); return a_; }())
    { unsigned* ctl0 = (unsigned*)(args.ws + WS_CTL);
      for (int u = tid; u < (LDS_BYTES - RING_BYTES) / 4; u += NTHREADS) ((LAS unsigned*)(lds + RING_BYTES))[u] = 0u;
      __syncthreads();
      (void)xcd_barrier_post(ctl0 + CW_BAR + args.li * XCD_BAR_WORDS, MISC + 8); }
#ifdef PROBE_PHASE
#define NB_LRU ((KA()->flags >> 16) & 15 ? ((KA()->flags >> 16) & 15) - 1 : 8)
#define PF_LRU ((KA()->flags >> 21) & 3)
#define ATT_SKIP ((KA()->flags >> 24) & 7)
#else
#define NB_LRU 8
#define PF_LRU 0
#define ATT_SKIP 0
#endif
#define IN(k) (KA()->ph_lo <= (k) && (k) < KA()->ph_hi)
#define SEAM(k) do { if (IN(k) && IN((k) + 1)) { XcdBarrier b_; b_.bar = (unsigned*)(KA()->ws + WS_CTL) + CW_BAR + KA()->li * XCD_BAR_WORDS; b_.x = xb_xcc_id(); b_.st = MISC + 8; xcd_barrier(b_); } } while (0)
#define PHASE_PTRS \
    KArgs A_ = KA(); \
    const int G = gridDim.x, gw = blockIdx.x * NWAVES + wave, NGW = G * NWAVES; unsigned* ctl = (unsigned*)(A_->ws + WS_CTL); (void)G; (void)gw; (void)NGW; (void)ctl; \
    unsigned char* ws = A_->ws; float* out = A_->out; \
    const float *x_p = A_->in[0], *x_s = A_->in[1], *st_conv = A_->in[2], *st_lru = A_->in[3], *c_bk = A_->in[4], *c_bv = A_->in[5], *c_fk = A_->in[6], *c_fv = A_->in[7], *c_fl = A_->in[8], *w_in = A_->in[9]; \
    const float *w_conv = A_->in[10], *b_conv = A_->in[11], *w_ra = A_->in[12], *b_ra = A_->in[13], *w_rx = A_->in[14], *b_rx = A_->in[15], *lam = A_->in[16], *relb = A_->in[17], *bfg = A_->in[18], *gmix = A_->in[19], *w_out = A_->in[20]; \
    const float *ln1g = A_->in[21], *ln1b = A_->in[22], *w_up = A_->in[23], *w_dn = A_->in[24], *ln2g = A_->in[25], *ln2b = A_->in[26]; \
    bf16_t* WinT = (bf16_t*)(ws + WS_WIN); bf16_t* WoutT = (bf16_t*)(ws + WS_WOUT); bf16_t* WupT = (bf16_t*)(ws + WS_WUP); bf16_t* WdnT = (bf16_t*)(ws + WS_WDN); bf16_t* WgT = (bf16_t*)(ws + WS_WG); \
    float* WF = (float*)(ws + WS_WF); bf16_t* Xb = (bf16_t*)(ws + WS_XB); float* X1f = (float*)(ws + WS_X1F); bf16_t* X1b = (bf16_t*)(ws + WS_X1B); float* X2f = (float*)(ws + WS_X2F); \
    bf16_t* Z = (bf16_t*)(ws + WS_Z); bf16_t* H = (bf16_t*)(ws + WS_H); bf16_t* Y = (bf16_t*)(ws + WS_Y); bf16_t* HDN = (bf16_t*)(ws + WS_HDN); \
    bf16_t* OB = (bf16_t*)(ws + WS_OB); bf16_t* OC = (bf16_t*)(ws + WS_OC); float* Fp = (float*)(ws + WS_FP); float* Fs = (float*)(ws + WS_FS); float* OA = (float*)(ws + WS_OA); \
    float* PO = (float*)(ws + WS_PO); float* PM = (float*)(ws + WS_PM); float* PL = (float*)(ws + WS_PL); float* SA = (float*)(ws + WS_SA); float* SH = (float*)(ws + WS_SH); \
    (void)x_p; (void)x_s; (void)st_conv; (void)st_lru; (void)c_bk; (void)c_bv; (void)c_fk; (void)c_fv; (void)c_fl; (void)w_in; (void)w_conv; (void)b_conv; (void)w_ra; (void)b_ra; (void)w_rx; (void)b_rx; (void)lam; (void)relb; (void)bfg; (void)gmix; (void)w_out; \
    (void)ln1g; (void)ln1b; (void)w_up; (void)w_dn; (void)ln2g; (void)ln2b; (void)WinT; (void)WoutT; (void)WupT; (void)WdnT; (void)WgT; (void)WF; (void)Xb; (void)X1f; (void)X1b; (void)X2f; (void)Z; (void)H; (void)Y; (void)HDN; (void)OB; (void)OC; (void)Fp; (void)Fs; (void)OA; \
    (void)PO; (void)PM; (void)PL; (void)SA; (void)SH; (void)out;

    if (IN(0)) {
        PHASE_PTRS
        LAS float* scr = (LAS float*)(lds + wave * 16384);
        const bool mv = (G > 0) && (1440 % G) != 0;
        const bool mv2 = (G > 0) && (576 % G) != 0;
        for (int it = gw; it < DEPTH * CV_I_L; it += NGW) {
            const int r = it % CV_I_L;
            if (mv && r >= CV_I_IN && r < CV_I_IN + N_MV) continue;
            if (mv2 && ((it >= CV2_A0 && it < CV2_A0 + CV2_AN) || (it >= CV2_B0 && it < CV2_B0 + CV2_BN))) continue;
            conv_item(it, w_in, w_out, w_up, w_dn, w_ra, w_rx, WinT, WoutT, WupT, WdnT, WgT, scr, lane);
        }
        for (int i = blockIdx.x * NTHREADS + tid; i < DEPTH * 4 * DM; i += G * NTHREADS) { const int l = i / (4 * DM), r = i % (4 * DM), j = r / DM, k = r % DM; WF[i] = w_in[(size_t)l * DM * DIN + (size_t)k * DIN + DINP + j]; }
        VM_WAIT(); __syncthreads();
    }
    SEAM(0);
    if (IN(1)) {
        PHASE_PTRS
        int ln = lane; asm volatile("" : "+v"(ln));
        for (int row = gw; row < TT; row += 2 * NGW) { const int nv = (TT - row + NGW - 1) / NGW; xcvt_rows<2>(x_p, x_s, WF, bfg, Xb, out, 0, row, NGW, nv < 3 ? nv : 3, ln); }
    }
    SEAM(1);

    for (int l = 0; l < DEPTH; ++l) {
        const int pb = 2 + 8 * l;
        if (IN(pb + 0)) {
            PHASE_PTRS
            int td = tid; asm volatile("" : "+v"(td));
            { const int spare0 = (G > 0) ? (1440 % G) : 0, nspare = (spare0 > 0) ? G - spare0 : G;
              if ((int)blockIdx.x >= ((spare0 > 0) ? spare0 : 0)) for (int seq = (int)blockIdx.x - ((spare0 > 0) ? spare0 : 0); seq < 144; seq += nspare) cumsum_seq((LAS float*)lds, out, c_fl + (size_t)l * NB_S * PAST * NH, Fp, Fs, l, seq, td); }
            __syncthreads();
            pg8::Gemm g{Xb, WinT + (size_t)l * DINP * DM, TT, DINP, DM}; pg8::StaticOrder S; S.init(TT, DINP, DM, G, (int)blockIdx.x, false);
            pg8::EpiInP E{H, out, l};
            pg8::gemm_phase<pg8::EpiInP, pg8::StaticOrder, true, true>(lds, g, S, E);
            { const int spare0 = (G > 0) ? (1440 % G) : 0;
              if (spare0 > 0 && (int)blockIdx.x >= spare0) {
                  VM_WAIT(); __syncthreads();
                  LAS float* scr = (LAS float*)(lds + wave * 16384);
                  const int nsw = (G - spare0) * NWAVES;
                  for (int r = nsw - 1 - (((int)blockIdx.x - spare0) * NWAVES + wave); r < N_MV; r += nsw)
                      conv_item(l * CV_I_L + CV_I_IN + r, w_in, w_out, w_up, w_dn, w_ra, w_rx, WinT, WoutT, WupT, WdnT, WgT, scr, lane);
                  VM_WAIT(); __syncthreads();
              } }
        }
        SEAM(pb + 0);
        if (IN(pb + 1)) {
            constexpr int N_AT = 256 + 512 + 256 + 32 + 256 + 128;
            for (;;) {
                if (tid == 0) MISC[16] = atomicAdd((unsigned*)(KA()->ws + WS_CTL) + CW_QUEUE + 64 * (l + 2 * ((KA()->flags >> 1) & 7)), 1u);
                __syncthreads();
                const int item = __builtin_amdgcn_readfirstlane((int)MISC[16]);
                __syncthreads();
                if (item >= N_AT) break;
                int kind, j;
                if (item < 128) { kind = 0; j = item; }
                else if (item < 1056) { const int m = item - 128, per = m / 29, p = m - 29 * per, cs0 = (p * 16) / 29, cs1 = ((p + 1) * 16) / 29;
                    if (cs1 > cs0) { kind = 1; j = 16 * per + cs0; }
                    else { const int o = 13 * per + (p - cs0); if (o < 288) { kind = 2; j = o; } else { kind = 0; j = (o < 352) ? 128 + (o - 288) : 192 + (o - 352); } } }
                else if (item < 1312) { kind = 3; j = item - 1056; } else { kind = 4; j = item - 1312; }
#ifdef PROBE_PHASE
                { const int mask = (KA()->flags >> 8) & 255; if (mask && !((mask >> kind) & 1)) continue; }
#endif
                if (kind == 0) { PHASE_PTRS const AttnCtx Cfp{H, nullptr, nullptr, Fp, nullptr, OC, nullptr, nullptr, nullptr}; attn_item<0>(lds, Cfp, j & 15, 15 - (j >> 4), 0); }
                else if (kind == 1) { PHASE_PTRS const AttnCtx Cfs{H, c_fk + (size_t)l * NB_S * PAST * DB, c_fv + (size_t)l * NB_S * PAST * DB, Fs, nullptr, nullptr, PO, PM, PL};
                                      fox_sample_item(lds, Cfs, j >> 2, j & 3); }
                else if (kind == 2) { PHASE_PTRS const LruCtx CL{H, st_conv + (size_t)l * NB_S * 3 * DA, st_lru + (size_t)l * NB_S * DA, w_conv + (size_t)l * 4 * DA, b_conv + (size_t)l * DA, WgT + (size_t)l * 2 * 8 * HD * HD,
                                          b_ra + (size_t)l * DA, b_rx + (size_t)l * DA, lam + (size_t)l * DA, gmix + (size_t)l * DM, SA, SH, Y, out, l, NB_LRU, PF_LRU, nullptr, nullptr, (float*)(ws + WS_AA), (bf16_t*)(ws + WS_UU)};
                                      if (j < 256) lru_item2<false, true>(lds, CL, j); else lru_item2<true>(lds, CL, j); }
                else if (kind == 3) { PHASE_PTRS const AttnCtx Cbp{H, nullptr, nullptr, nullptr, relb + (size_t)l * NH * NREL, OB, nullptr, nullptr, nullptr};
                                      const int bh = j & 15; attn_item<1>(lds, Cbp, bh >> 2, 15 - (j >> 4), bh & 3); }
                else { PHASE_PTRS const AttnCtx Cbs{H, c_bk + (size_t)l * NB_S * BAND * DB, c_bv + (size_t)l * NB_S * BAND * DB, nullptr, relb + (size_t)l * NH * NREL, OB, nullptr, nullptr, nullptr};
                       attn_item<2>(lds, Cbs, j >> 2, j & 3, 0); }
            }
        }
        SEAM(pb + 1);
        if (IN(pb + 2)) {
            { PHASE_PTRS
              const LruCtx CL{H, st_conv + (size_t)l * NB_S * 3 * DA, st_lru + (size_t)l * NB_S * DA, w_conv + (size_t)l * 4 * DA, b_conv + (size_t)l * DA, WgT + (size_t)l * 2 * 8 * HD * HD,
                              b_ra + (size_t)l * DA, b_rx + (size_t)l * DA, lam + (size_t)l * DA, gmix + (size_t)l * DM, SA, SH, Y, out, l, NB_LRU, PF_LRU, LRU_STREAM ? nullptr : OB, LRU_STREAM ? nullptr : OC, (float*)(ws + WS_AA), (bf16_t*)(ws + WS_UU)};
              if constexpr (LRU_STREAM) { for (int chunk = blockIdx.x; chunk < 256; chunk += G) lru_pass2_stream(lds, CL, chunk); }
              else { for (int chunk = blockIdx.x; chunk < 256; chunk += G) lru_fin(lds, CL, chunk); } }
            { PHASE_PTRS
              int ln = lane; asm volatile("" : "+v"(ln));
              for (int row = (LRU_STREAM ? 0 : TP) + gw; row < TT; row += NGW) mixnorm_row(OA, OB, OC, PO, PM, PL, gmix + (size_t)l * DM, Y, false, row, ln); }
        }
        SEAM(pb + 2);
        for (int half = 0; half < 2; ++half) {
            if (IN(pb + 3 + 3 * half)) {
                PHASE_PTRS
                const int Kg = half ? DFF : DM;
                pg8::Gemm g{half ? HDN : Y, half ? WdnT + (size_t)l * DM * DFF : WoutT + (size_t)l * DM * DM, TT, DM, Kg}; pg8::StaticOrder S; const int rem2 = (G > 0) ? (576 % G) : 0; const bool fill2 = (half == 0) && (l == 0) && rem2 > 0;
                S.init(TT, DM, Kg, G, (int)blockIdx.x, !fill2);
                pg8::EpiResP<true> E{Z, nullptr, nullptr, half ? X1b : Xb};
                pg8::gemm_phase<pg8::EpiResP<true>, pg8::StaticOrder, true, true>(lds, g, S, E, (float*)(ws + WS_SK), ctl + CW_SPLITK + (2 * l + half) * 64 * 16);
                if (fill2 && (int)blockIdx.x >= rem2) {
                    VM_WAIT(); __syncthreads();
                    LAS float* scr = (LAS float*)(lds + wave * 16384);
                    const int nsw = (G - rem2) * NWAVES;
                    for (int q = ((int)blockIdx.x - rem2) * NWAVES + wave; q < N_MV2; q += nsw)
                        conv_item(q < CV2_AN ? CV2_A0 + q : CV2_B0 + (q - CV2_AN), w_in, w_out, w_up, w_dn, w_ra, w_rx, WinT, WoutT, WupT, WdnT, WgT, scr, lane);
                    VM_WAIT(); __syncthreads();
                }
            }
            SEAM(pb + 3 + 3 * half);
            if (IN(pb + 4 + 3 * half)) {
                PHASE_PTRS
                const bool nxt = half && (l + 1 < DEPTH), last = half && (l == DEPTH - 1);
                const float* gg = (half ? ln2g : ln1g) + (size_t)l * DM; const float* bb = (half ? ln2b : ln1b) + (size_t)l * DM;
                float* xf = last ? out + O_YP : nullptr; bf16_t* xbo = half ? (last ? nullptr : Xb) : X1b;
                int ln = lane; asm volatile("" : "+v"(ln));
                for (int row = gw; row < TT; row += 3 * NGW) { const int nv = (TT - row + NGW - 1) / NGW; int l2 = ln; asm volatile("" : "+v"(l2));
                    ln_rows<3>(Z, gg, bb, xf, xbo, nxt ? WF + (size_t)(l + 1) * 4 * DM : nullptr, nxt ? bfg + (l + 1) * NH : nullptr, out, l + 1, row, NGW, nv < 3 ? nv : 3, l2); }
            }
            SEAM(pb + 4 + 3 * half);
            if (half == 0) {
                if (IN(pb + 5)) {
                    PHASE_PTRS
                    pg8::Gemm g{X1b, WupT + (size_t)l * DFF * DM, TT, DFF, DM}; pg8::StaticOrder S; S.init(TT, DFF, DM, G, (int)blockIdx.x, false);
                    pg8::EpiUpP E{HDN};
                    pg8::gemm_phase<pg8::EpiUpP, pg8::StaticOrder, true, true>(lds, g, S, E);
                }
                SEAM(pb + 5);
            }
        }
    }
#undef IN
#undef SEAM
#undef PHASE_PTRS
#undef tid
#undef lane
#undef TIDF
}
extern "C" void kernel_launch(void* const* d_in, const int* in_sizes, int n_in, void* d_out, int out_size, void* d_ws, size_t ws_size, hipStream_t stream) {
    static int grid = 0;
    if (grid == 0) {
        if (n_in != 27 || (size_t)out_size != O_END || ws_size < WS_END) { fprintf(stderr, "kernel_launch: unexpected sizes n_in %d out %d ws %zu (need %zu)\n", n_in, out_size, ws_size, (size_t)WS_END); grid = -1; return; }
        int dev = 0, cus = 0, per_cu = 0;
        if (hipGetDevice(&dev) != hipSuccess || hipDeviceGetAttribute(&cus, hipDeviceAttributeMultiprocessorCount, dev) != hipSuccess) { grid = -1; return; }
        if (hipFuncSetAttribute((const void*)mk_fwd, hipFuncAttributeMaxDynamicSharedMemorySize, LDS_BYTES) != hipSuccess) { fprintf(stderr, "kernel_launch: hipFuncSetAttribute failed\n"); grid = -1; return; }
        if (hipOccupancyMaxActiveBlocksPerMultiprocessor(&per_cu, (const void*)mk_fwd, NTHREADS, LDS_BYTES) != hipSuccess || per_cu < 1) fprintf(stderr, "kernel_launch: occupancy query says %d\n", per_cu);
        (void)hipGetLastError();
        grid = cus;
    }
    if (grid < 0) return;
    (void)hipMemsetAsync((unsigned char*)d_ws + WS_CTL, 0, CTL_ZERO_BYTES, stream);
    Args a{};
    for (int i = 0; i < 27; ++i) a.in[i] = (const float*)d_in[i];
    a.out = (float*)d_out; a.ws = (unsigned char*)d_ws; a.ph_lo = 0; a.ph_hi = NPH; a.li = 0; a.flags = 0;
    hipLaunchKernelGGL(mk_fwd, dim3(grid), dim3(NTHREADS), LDS_BYTES, stream, a);
#ifdef PROBE_PHASE
    { Args p = a; p.ph_lo = PROBE_PHASE; p.ph_hi = PROBE_PHASE + 1; p.li = 1; p.flags = 2;
      for (int r = 0; r < PROBE_REPS; ++r) { p.flags = 2 + 4 * r + (PROBE_MASK << 8) + (PROBE_NB << 16) + (PROBE_SKIP << 24); hipLaunchKernelGGL(mk_fwd, dim3(grid), dim3(NTHREADS), LDS_BYTES, stream, p); } }
#endif
    const hipError_t le = hipPeekAtLastError();
    if (le != hipSuccess) fprintf(stderr, "kernel_launch: mk_fwd launch failed: %s\n", hipGetErrorName(le));
}
```

```cpp
#include <hip/hip_runtime.h>
#include <cstdio>
#include <cstdint>

typedef unsigned short bf16_t;

constexpr int DM = 2048, NB_P = 4, SEQ = 4096, DEPTH = 2, NB_S = 32, TS = 64, PAST = 4096;
constexpr int TP = NB_P * SEQ;
constexpr int TT = TP + NB_S * TS;
constexpr int DA = 1024, HD = 128, NH = 4, DB = 512, DIN = 5124, DINP = 5120, DFF = 8192, NREL = 513, BAND = 512;
constexpr int HP = DINP;
constexpr float ALPHA = 1.41421356237309515f, SCALE = 0.08838834764831845f, LN_EPS = 1e-5f, NEGBIG = -1e30f;
constexpr int C_AX = 0, C_AG = 1024, C_BQ = 2048, C_BK = 2560, C_BV = 3072, C_CQ = 3584, C_CK = 4096, C_CV = 4608;

constexpr size_t O_YP = 0;
constexpr size_t O_YS = O_YP + (size_t)NB_P * SEQ * DM;
constexpr size_t O_PCONV = O_YS + (size_t)NB_S * TS * DM;
constexpr size_t O_PLRU = O_PCONV + (size_t)DEPTH * NB_P * 3 * DA;
constexpr size_t O_PBK = O_PLRU + (size_t)DEPTH * NB_P * DA;
constexpr size_t O_PBV = O_PBK + (size_t)DEPTH * NB_P * BAND * DB;
constexpr size_t O_PFK = O_PBV + (size_t)DEPTH * NB_P * BAND * DB;
constexpr size_t O_PFV = O_PFK + (size_t)DEPTH * NB_P * SEQ * DB;
constexpr size_t O_PFL = O_PFV + (size_t)DEPTH * NB_P * SEQ * DB;
constexpr size_t O_SCONV = O_PFL + (size_t)DEPTH * NB_P * SEQ * NH;
constexpr size_t O_SLRU = O_SCONV + (size_t)DEPTH * NB_S * 3 * DA;
constexpr size_t O_SBK = O_SLRU + (size_t)DEPTH * NB_S * DA;
constexpr size_t O_SBV = O_SBK + (size_t)DEPTH * NB_S * TS * DB;
constexpr size_t O_SFK = O_SBV + (size_t)DEPTH * NB_S * TS * DB;
constexpr size_t O_SFV = O_SFK + (size_t)DEPTH * NB_S * TS * DB;
constexpr size_t O_SFL = O_SFV + (size_t)DEPTH * NB_S * TS * DB;
constexpr size_t O_END = O_SFL + (size_t)DEPTH * NB_S * TS * NH;
static_assert(O_END == 84328448ull, "output size");

constexpr size_t MiB = 1ull << 20;
constexpr size_t WS_CTL = 0;
constexpr size_t WS_WIN = 1 * MiB;
constexpr size_t WS_WOUT = WS_WIN + 40 * MiB;
constexpr size_t WS_WUP = WS_WOUT + 16 * MiB;
constexpr size_t WS_WDN = WS_WUP + 64 * MiB;
constexpr size_t WS_WF = WS_WDN + 64 * MiB;
constexpr size_t WS_XB = WS_WF + 1 * MiB;
constexpr size_t WS_X1F = WS_XB + 72 * MiB;
constexpr size_t WS_X1B = WS_X1F + 144 * MiB;
constexpr size_t WS_X2F = WS_X1B + 72 * MiB;
constexpr size_t WS_Z = WS_X2F + 144 * MiB;
constexpr size_t WS_H = WS_Z + 144 * MiB;
constexpr size_t WS_Y = WS_H + 186 * MiB;
constexpr size_t WS_HDN = WS_Y + 72 * MiB;
constexpr size_t WS_OB = WS_HDN + 288 * MiB;
constexpr size_t WS_OC = WS_OB + 36 * MiB;
constexpr size_t WS_FP = WS_OC + 36 * MiB;
constexpr size_t WS_FS = WS_FP + 1 * MiB;
constexpr size_t WS_OA = WS_FS + 3 * MiB;
constexpr size_t WS_XC = WS_OA + 72 * MiB;
constexpr size_t WS_AA = WS_XC + 72 * MiB;
constexpr size_t WS_UU = WS_AA + 72 * MiB;
constexpr size_t WS_WG = WS_UU + 72 * MiB;
constexpr size_t WS_PO = WS_WG + 1 * MiB;
constexpr size_t WS_PM = WS_PO + 16 * MiB;
constexpr size_t WS_PL = WS_PM + 1 * MiB;
constexpr size_t WS_SA = WS_PL + 1 * MiB;
constexpr size_t WS_SH = WS_SA + 1 * MiB;
constexpr size_t WS_SK = WS_SH + 1 * MiB;
constexpr size_t WS_END = WS_SK + 64 * MiB;
static_assert(WS_END <= 2048 * MiB, "workspace");

__device__ __forceinline__ float bf2f(bf16_t b) { return __uint_as_float(((unsigned)b) << 16); }
__device__ __forceinline__ float bflo(unsigned w) { return __uint_as_float(w << 16); }
__device__ __forceinline__ float bfhi(unsigned w) { return __uint_as_float(w & 0xffff0000u); }
__device__ __forceinline__ bf16_t f2bf(float f) { unsigned u = __float_as_uint(f); u += 0x7fffu + ((u >> 16) & 1u); return (bf16_t)(u >> 16); }
__device__ __forceinline__ float xshfl32(float v, int lane) { return __builtin_bit_cast(float, __builtin_amdgcn_ds_bpermute((lane ^ 32) << 2, __builtin_bit_cast(int, v))); }
__device__ __forceinline__ float wave_sum(float v) {
#define WS_DPP(x, ctrl, rmask) __builtin_bit_cast(float, __builtin_amdgcn_update_dpp(0, __builtin_bit_cast(int, (x)), (ctrl), (rmask), 0xF, false))
    v += WS_DPP(v, 0xB1, 0xF);
    v += WS_DPP(v, 0x4E, 0xF);
    v += WS_DPP(v, 0x141, 0xF);
    v += WS_DPP(v, 0x140, 0xF);
    v += WS_DPP(v, 0x142, 0xA);
    v += WS_DPP(v, 0x143, 0xC);
#undef WS_DPP
    return __builtin_bit_cast(float, __builtin_amdgcn_readlane(__builtin_bit_cast(int, v), 63));
}
__device__ __forceinline__ float wave_max(float v) {
#pragma unroll
    for (int o = 1; o < 64; o <<= 1) v = fmaxf(v, __shfl_xor(v, o));
    return v;
}
__device__ __forceinline__ float log_sigmoid_f(float z) { return fminf(z, 0.f) - log1pf(expf(-fabsf(z))); }
__device__ __forceinline__ float sigmoid_f(float z) { return 1.f / (1.f + expf(-z)); }
__device__ __forceinline__ float gelu_tanh_f(float x) { return 0.5f * x * (1.f + tanhf(0.7978845608028654f * (x + 0.044715f * x * x * x))); }
__device__ __forceinline__ const float* xrow0(const float* xp, const float* xs, int row) { return row < TP ? xp + (size_t)row * DM : xs + (size_t)(row - TP) * DM; }
__device__ __forceinline__ void row_bt(int row, bool& prm, int& b, int& t) { prm = row < TP; if (prm) { b = row >> 12; t = row & 4095; } else { const int r = row - TP; b = r >> 6; t = r & 63; } }

__device__ __forceinline__ float logf_get(const float* out, const float* cfl_l, int l, bool prm, int b, int h, int i) {
    if (prm) return out[O_PFL + ((size_t)(l * NB_P + b) * SEQ + i) * NH + h];
    if (i < PAST) return cfl_l[((size_t)b * PAST + i) * NH + h];
    return out[O_SFL + ((size_t)(l * NB_S + b) * TS + (i - PAST)) * NH + h];
}
namespace pg8 {
#define PG8_LAS __attribute__((address_space(3)))
typedef unsigned short bf16_t;
typedef short bf16x8 __attribute__((ext_vector_type(8)));
typedef float f32x4 __attribute__((ext_vector_type(4)));
typedef unsigned u32x4 __attribute__((ext_vector_type(4)));
constexpr int BM = 256, BK = 64, HALF = 128, HTB = HALF * BK * 2  , STAGE_BYTES = 8 * HTB, NXCD = 8, WGM = 8;

__host__ __device__ __forceinline__ int lds_byte(int r, int c) { const int st = (r >> 4) * 2 + (c >> 5), rr = r & 15, cc = c & 31, ob = rr * 64 + cc * 2; return st * 1024 + (ob ^ (((ob >> 9) & 1) << 5)); }
__host__ __device__ __forceinline__ void stage_rc(int b, int& R, int& C) { const int st = b / 1024, sb = b % 1024, swz = sb ^ (((sb >> 9) & 1) << 5); R = (st >> 1) * 16 + swz / 64; C = (st & 1) * 32 + (swz % 64) / 2; }
__host__ __device__ __forceinline__ int perm32(int rho) { const int n = rho >> 4, i = rho & 15; return 8 * (i >> 2) + 4 * n + (i & 3); }

struct Unit { int pm, pn, k0, nt, part, slot; };
struct Gemm { const bf16_t* A; const bf16_t* Bt; int M, N, K; };

struct StaticOrder {
    int nM, nN, nwg, G, c, ntk, R, SF;
    __host__ __device__ __forceinline__ void init(int M, int N, int K, int G_, int c_, bool split) {
        nM = M / BM; nN = N / BM; nwg = nM * nN; G = G_; c = c_; ntk = K / BK; R = nwg / G;
        const int rem = nwg - R * G; SF = rem ? 1 : 0;
        if (split && rem && (G % rem) == 0) { const int sf = G / rem; if (sf == 4 && (ntk % (2 * sf)) == 0 && ntk / sf >= 4) SF = sf; }
    }
    __host__ __device__ __forceinline__ Unit tile_of(int L, int k0, int nt, int part, int slot) const {
        int wgid = L; { const int q = nwg / NXCD, r = nwg % NXCD, xcd = wgid % NXCD, off = wgid / NXCD; wgid = (xcd < r ? xcd * (q + 1) : r * (q + 1) + (xcd - r) * q) + off; }
        const int nig = WGM * nN, gid = wgid / nig, fm = gid * WGM, gsz = (nM - fm) < WGM ? (nM - fm) : WGM;
        return Unit{fm + ((wgid % nig) % gsz), (wgid % nig) / gsz, k0, nt, part, slot};
    }
    __host__ __device__ __forceinline__ Unit next(int i) const {
        if (SF >= 2) {
            if (i == 0) { const int j = c / SF, part = c % SF, ntp = ntk / SF; return tile_of(R * G + j, part * ntp, ntp, part, j); }
            if (i <= R) return tile_of((i - 1) * G + c, 0, ntk, -1, 0);
            return Unit{0, 0, 0, 0, -1, 0};
        }
        if (i < R) return tile_of(i * G + c, 0, ntk, -1, 0);
        if (i > R || SF == 0) return Unit{0, 0, 0, 0, -1, 0};
        { const int L = R * G + c; if (L >= nwg) return Unit{0, 0, 0, 0, -1, 0}; return tile_of(L, 0, ntk, -1, 0); }
    }
    __device__ __forceinline__ void a_ready(const Unit&) const {}
    __device__ __forceinline__ void done(const Unit&) const {}
};
typedef unsigned u32x2 __attribute__((ext_vector_type(2)));
__device__ __forceinline__ unsigned cvt_pk_bf16(float lo, float hi) { unsigned r; asm volatile("v_cvt_pk_bf16_f32 %0, %1, %2" : "=v"(r) : "v"(lo), "v"(hi)); return r; }

struct EpiInP {
    static constexpr bool PERM = true, AFTER_DRAIN = false, HAS_FRAG = false;
    bf16_t* H; float* out; int l;
    __device__ __forceinline__ void operator()(const f32x4 (&acc)[2][2][4][2], const Unit& u, int wr, int wc, int fr, int fq) const {
        const int pn = u.pn, pm = u.pm;
        const bool prm = pm < 64;
        const int ccol = (pn & 1) * 256 + wc * 32 + 8 * fq;
        const int col0 = pn * 256 + wc * 32 + 8 * fq;
        const int kind = (pn < 4) ? 3 : ((pn >= 10 && pn < 14) ? 1 : ((pn >= 16) ? 2 : 0));
        const bool isv = (kind == 1) ? (pn >= 12) : (pn >= 18);
#pragma unroll
        for (int ai = 0; ai < 2; ++ai)
#pragma unroll
            for (int m = 0; m < 4; ++m) {
                const int rloc = ai * 128 + wr * 64 + m * 16 + fr;
                const int row = pm * 256 + rloc;
                int b, t; if (prm) { b = pm >> 4; t = (pm & 15) * 256 + rloc; } else { const int r = row - TP; b = r >> 6; t = r & 63; }
                float* fp = nullptr;
                if (kind == 1) { if (prm) { if (t >= SEQ - BAND) fp = out + (isv ? O_PBV : O_PBK) + ((size_t)(l * NB_P + b) * BAND + (t - (SEQ - BAND))) * DB + ccol; }
                                 else fp = out + (isv ? O_SBV : O_SBK) + ((size_t)(l * NB_S + b) * TS + t) * DB + ccol; }
                else if (kind == 2) { if (prm) fp = out + (isv ? O_PFV : O_PFK) + ((size_t)(l * NB_P + b) * SEQ + t) * DB + ccol;
                                      else fp = out + (isv ? O_SFV : O_SFK) + ((size_t)(l * NB_S + b) * TS + t) * DB + ccol; }
                else if (kind == 3) { if (prm) { if (t >= SEQ - 3) fp = out + O_PCONV + ((size_t)(l * NB_P + b) * 3 + (t - (SEQ - 3))) * DA + col0; }
                                      else { if (t >= TS - 3) fp = out + O_SCONV + ((size_t)(l * NB_S + b) * 3 + (t - (TS - 3))) * DA + col0; } }
                bf16_t* hp = H + (size_t)row * HP + col0;
#pragma unroll
                for (int bj = 0; bj < 2; ++bj) {
                    const f32x4 v0 = acc[ai][bj][m][0], v1 = acc[ai][bj][m][1];
                    u32x4 w; w.x = cvt_pk_bf16(v0[0], v0[1]); w.y = cvt_pk_bf16(v0[2], v0[3]); w.z = cvt_pk_bf16(v1[0], v1[1]); w.w = cvt_pk_bf16(v1[2], v1[3]);
                    *(u32x4*)(hp + bj * HALF) = w;
                    if (fp) { *(f32x4*)(fp + bj * HALF) = v0; *(f32x4*)(fp + bj * HALF + 4) = v1; }
                }
            }
    }
};
template <bool XB16> struct EpiResP {
    static constexpr bool PERM = true, AFTER_DRAIN = false, HAS_FRAG = true;
    bf16_t* Z; const float* xa; const float* xb; const bf16_t* xh;
    __device__ __forceinline__ f32x4 xload(const Unit& u, size_t o) const {
        if constexpr (XB16) { const unsigned long long w = *(const unsigned long long*)(xh + (size_t)u.pm * BM * DM + o); const unsigned lo = (unsigned)w, hi = (unsigned)(w >> 32);
                              return (f32x4){__uint_as_float(lo << 16), __uint_as_float(lo & 0xffff0000u), __uint_as_float(hi << 16), __uint_as_float(hi & 0xffff0000u)}; }
        else { const float* xbase = (u.pm < TP / BM) ? xa + (size_t)u.pm * BM * DM : xb + (size_t)(u.pm - TP / BM) * BM * DM; return *(const f32x4*)(xbase + o); }
    }
    __device__ __forceinline__ void frag(const f32x4 v, const Unit& u, int ai, int bj, int m, int n, int wr, int wc, int fr, int fq) const {
        const size_t o = (size_t)(wr * 64 + fr + ai * HALF + m * 16) * DM + u.pn * BM + wc * 32 + 8 * fq + bj * HALF + 4 * n;
        const f32x4 r = xload(u, o) * ALPHA + v;
        u32x2 w; w.x = cvt_pk_bf16(r[0], r[1]); w.y = cvt_pk_bf16(r[2], r[3]);
        *(u32x2*)(Z + (size_t)u.pm * BM * DM + o) = w;
    }
    __device__ __forceinline__ void operator()(const f32x4 (&acc)[2][2][4][2], const Unit& u, int wr, int wc, int fr, int fq) const {
        const int rloc0 = wr * 64 + fr, col0 = u.pn * BM + wc * 32 + 8 * fq;
        bf16_t* zbase = Z + (size_t)u.pm * BM * DM;
#pragma unroll
        for (int ai = 0; ai < 2; ++ai)
#pragma unroll
            for (int m = 0; m < 4; ++m) {
                const size_t ro = (size_t)(rloc0 + ai * HALF + m * 16) * DM + col0;
#pragma unroll
                for (int bj = 0; bj < 2; ++bj) {
                    const f32x4 r0 = xload(u, ro + bj * HALF) * ALPHA + acc[ai][bj][m][0], r1 = xload(u, ro + bj * HALF + 4) * ALPHA + acc[ai][bj][m][1];
                    u32x4 w; w.x = cvt_pk_bf16(r0[0], r0[1]); w.y = cvt_pk_bf16(r0[2], r0[3]); w.z = cvt_pk_bf16(r1[0], r1[1]); w.w = cvt_pk_bf16(r1[2], r1[3]);
                    *(u32x4*)(zbase + ro + bj * HALF) = w;
                }
            }
    }
};
struct EpiUpP {
    static constexpr bool PERM = true, AFTER_DRAIN = false, HAS_FRAG = false;
    bf16_t* HDN;
    __device__ __forceinline__ void operator()(const f32x4 (&acc)[2][2][4][2], const Unit& u, int wr, int wc, int fr, int fq) const {
        const int row0 = u.pm * BM + wr * 64 + fr, col0 = u.pn * BM + wc * 32 + 8 * fq;
#pragma unroll
        for (int ai = 0; ai < 2; ++ai)
#pragma unroll
            for (int m = 0; m < 4; ++m) {
                bf16_t* rowp = HDN + (size_t)(row0 + ai * HALF + m * 16) * DFF + col0;
#pragma unroll
                for (int bj = 0; bj < 2; ++bj) {
                    f32x4 v0 = acc[ai][bj][m][0], v1 = acc[ai][bj][m][1];
#pragma unroll
                    for (int j = 0; j < 4; ++j) { const float a = fmaxf(v0[j], 0.f), b = fmaxf(v1[j], 0.f); v0[j] = a * a; v1[j] = b * b; }
                    u32x4 w; w.x = cvt_pk_bf16(v0[0], v0[1]); w.y = cvt_pk_bf16(v0[2], v0[3]); w.z = cvt_pk_bf16(v1[0], v1[1]); w.w = cvt_pk_bf16(v1[2], v1[3]);
                    *(u32x4*)(rowp + bj * HALF) = w;
                }
            }
    }
};
#ifdef PROBE_PLAIN_SLAB
#define SK_AUX 0
#else
#define SK_AUX 16
#endif
template <class Epi, class Sched, bool ALIGN_EPI = false, bool SP2 = false>
__device__ __forceinline__ void gemm_phase(PG8_LAS unsigned char* lds, const Gemm g, const Sched& S, const Epi& E, float* sk_slab = nullptr, unsigned* sk_cnt = nullptr) {
    int tid_ = threadIdx.x; asm volatile("" : "+v"(tid_));
    const int tid = tid_, wid = __builtin_amdgcn_readfirstlane(tid >> 6), lane = tid & 63, wr = wid >> 2, wc = wid & 3, fr = lane & 15, fq = lane >> 4;
    const int K = g.K;
    unsigned voffA[2], voffB[2];
#pragma unroll
    for (int i = 0; i < 2; ++i) { int R, C; stage_rc(tid * 16 + i * 8192, R, C); const int Rb = Epi::PERM ? ((R & ~31) + perm32(R & 31)) : R;
        voffA[i] = (unsigned)(R * K + C) * 2u; voffB[i] = (unsigned)(Rb * K + C) * 2u; }
    const size_t kstep = (size_t)(BK * 2);
    const size_t hstep = (size_t)HALF * K * 2;
    const size_t tstep = 2 * hstep;
    const unsigned ldsw = (unsigned)wid * 1024u;
    const int aoff = lds_byte(wr * 64 + fr, fq * 8), boff = lds_byte(wc * 32 + fr, fq * 8);
#define PG8_SA(b, h) (((b) * 2 + (h)) * HTB)
#define PG8_SB(b, h) ((4 + (b) * 2 + (h)) * HTB)
#define PG8_STAGE(bufoff, gbase, voff) do { _Pragma("unroll") for (int _i = 0; _i < 2; ++_i) \
        __builtin_amdgcn_global_load_lds((const unsigned*)((const char*)(gbase) + (voff)[_i]), (PG8_LAS unsigned*)(lds + (bufoff) + ldsw + _i * 8192), 16, 0, 0); } while (0)
#define PG8_LDA(dst, b, h) do { _Pragma("unroll") for (int m = 0; m < 4; ++m) _Pragma("unroll") for (int k = 0; k < 2; ++k) dst[m][k] = *(const PG8_LAS bf16x8*)(lds + PG8_SA(b, h) + aoff + m * 2048 + k * 1024); } while (0)
#define PG8_LDB(dst, b, h) do { _Pragma("unroll") for (int n = 0; n < 2; ++n) _Pragma("unroll") for (int k = 0; k < 2; ++k) dst[n][k] = *(const PG8_LAS bf16x8*)(lds + PG8_SB(b, h) + boff + n * 2048 + k * 1024); } while (0)
#define PG8_MMA(ai, bj, At, Bt) do { __builtin_amdgcn_s_setprio(1); _Pragma("unroll") for (int m = 0; m < 4; ++m) _Pragma("unroll") for (int n = 0; n < 2; ++n) _Pragma("unroll") for (int k = 0; k < 2; ++k) \
        acc[ai][bj][m][n] = __builtin_amdgcn_mfma_f32_16x16x32_bf16(Bt[n][k], At[m][k], acc[ai][bj][m][n], 0, 0, 0); __builtin_amdgcn_s_setprio(0); } while (0)
#define PG8_WAIT_V(n) asm volatile("s_waitcnt vmcnt(" #n ")" ::: "memory")
#define PG8_WAIT_L(n) asm volatile("s_waitcnt lgkmcnt(" #n ")" ::: "memory")
#define PG8_BAR __builtin_amdgcn_s_barrier()
#define PG8_SCHED __builtin_amdgcn_sched_barrier(0)
    int ui = 0;
    Unit cur = S.next(0), nxt = cur;
    if (cur.nt == 0) return;
    const Unit first = cur;
    f32x4 acc[2][2][4][2];
#pragma unroll
    for (int a = 0; a < 2; ++a)
#pragma unroll
        for (int b = 0; b < 2; ++b)
#pragma unroll
            for (int m = 0; m < 4; ++m)
#pragma unroll
                for (int n = 0; n < 2; ++n) acc[a][b][m][n] = (f32x4){0.f, 0.f, 0.f, 0.f};
    bf16x8 At[4][2], B0[2][2], B1[2][2];
    const char* cA = (const char*)g.A + (size_t)cur.pm * tstep + (size_t)cur.k0 * kstep; const char* cB = (const char*)g.Bt + (size_t)cur.pn * tstep + (size_t)cur.k0 * kstep;
    S.a_ready(cur);
    if constexpr (SP2) {
        PG8_STAGE(PG8_SB(0, 0), cB, voffB); PG8_STAGE(PG8_SB(0, 1), cB + hstep, voffB); PG8_STAGE(PG8_SA(0, 0), cA, voffA); PG8_STAGE(PG8_SA(0, 1), cA + hstep, voffA);
        if (wr == 1) PG8_BAR;
        PG8_WAIT_V(2); PG8_BAR;
        PG8_STAGE(PG8_SB(1, 0), cB + kstep, voffB); PG8_STAGE(PG8_SA(1, 0), cA + kstep, voffA); PG8_STAGE(PG8_SB(1, 1), cB + hstep + kstep, voffB);
        PG8_WAIT_V(6); PG8_BAR;
    } else {
        PG8_STAGE(PG8_SB(0, 0), cB, voffB); PG8_STAGE(PG8_SA(0, 0), cA, voffA); PG8_STAGE(PG8_SB(0, 1), cB + hstep, voffB); PG8_STAGE(PG8_SA(0, 1), cA + hstep, voffA);
        if (wr == 1) PG8_BAR;
        PG8_WAIT_V(4); PG8_BAR;
        PG8_STAGE(PG8_SB(1, 0), cB + kstep, voffB); PG8_STAGE(PG8_SA(1, 0), cA + kstep, voffA); PG8_STAGE(PG8_SB(1, 1), cB + hstep + kstep, voffB);
        PG8_WAIT_V(6); PG8_BAR;
    }
    for (;;) {
        nxt = S.next(ui + 1); const bool has_next = nxt.nt != 0;
        const char* nA = has_next ? (const char*)g.A + (size_t)nxt.pm * tstep + (size_t)nxt.k0 * kstep : cA; const char* nB = has_next ? (const char*)g.Bt + (size_t)nxt.pn * tstep + (size_t)nxt.k0 * kstep : cB;
        const int nt = cur.nt;
        for (int t = 0; t < nt; t += 2) {
            const bool last = (t == nt - 2);
            const char* a1 = cA + (size_t)(t + 1) * kstep;
            const char* a2 = last ? nA : cA + (size_t)(t + 2) * kstep; const char* b2 = last ? nB : cB + (size_t)(t + 2) * kstep;
            const char* a3 = a2 + kstep; const char* b3 = b2 + kstep;
            if (last && has_next) S.a_ready(nxt);
            if constexpr (SP2) {
            PG8_LDB(B0, 0, 0); PG8_LDB(B1, 0, 1); PG8_SCHED; PG8_LDA(At, 0, 0); PG8_STAGE(PG8_SA(1, 1), a1 + hstep, voffA);
            PG8_WAIT_V(8); PG8_WAIT_L(0); PG8_BAR; PG8_MMA(0, 0, At, B0); PG8_MMA(0, 1, At, B1); PG8_BAR; PG8_SCHED;
            PG8_LDA(At, 0, 1); PG8_STAGE(PG8_SB(0, 0), b2, voffB); PG8_STAGE(PG8_SB(0, 1), b2 + hstep, voffB); PG8_STAGE(PG8_SA(0, 0), a2, voffA);
            PG8_WAIT_V(8); PG8_WAIT_L(0); PG8_BAR; PG8_MMA(1, 0, At, B0); PG8_MMA(1, 1, At, B1); PG8_BAR; PG8_SCHED;
            PG8_LDB(B0, 1, 0); PG8_LDB(B1, 1, 1); PG8_SCHED; PG8_LDA(At, 1, 0); PG8_STAGE(PG8_SA(0, 1), a2 + hstep, voffA);
            PG8_WAIT_V(8); PG8_WAIT_L(0); PG8_BAR; PG8_MMA(0, 0, At, B0); PG8_MMA(0, 1, At, B1); PG8_BAR; PG8_SCHED;
            PG8_LDA(At, 1, 1); PG8_STAGE(PG8_SB(1, 0), b3, voffB); PG8_STAGE(PG8_SB(1, 1), b3 + hstep, voffB); PG8_STAGE(PG8_SA(1, 0), a3, voffA);
            PG8_WAIT_V(8); PG8_WAIT_L(0); PG8_BAR; PG8_MMA(1, 0, At, B0); PG8_MMA(1, 1, At, B1); PG8_BAR; PG8_SCHED;
            } else {
            PG8_LDB(B0, 0, 0); PG8_SCHED; PG8_LDA(At, 0, 0); PG8_STAGE(PG8_SA(1, 1), a1 + hstep, voffA);
            PG8_WAIT_L(8); PG8_BAR; PG8_WAIT_L(0); PG8_MMA(0, 0, At, B0); PG8_BAR; PG8_SCHED;
            PG8_LDB(B1, 0, 1); PG8_STAGE(PG8_SB(0, 0), b2, voffB);
            PG8_BAR; PG8_WAIT_L(0); PG8_MMA(0, 1, At, B1); PG8_BAR;
            PG8_LDA(At, 0, 1); PG8_STAGE(PG8_SA(0, 0), a2, voffA);
            PG8_BAR; PG8_WAIT_L(0); PG8_MMA(1, 0, At, B0); PG8_BAR; PG8_SCHED;
            PG8_STAGE(PG8_SB(0, 1), b2 + hstep, voffB);
            PG8_WAIT_V(6); PG8_BAR; PG8_MMA(1, 1, At, B1); PG8_BAR;
            PG8_LDB(B0, 1, 0); PG8_SCHED; PG8_LDA(At, 1, 0); PG8_STAGE(PG8_SA(0, 1), a2 + hstep, voffA);
            PG8_WAIT_L(8); PG8_BAR; PG8_WAIT_L(0); PG8_MMA(0, 0, At, B0); PG8_BAR; PG8_SCHED;
            PG8_LDB(B1, 1, 1); PG8_STAGE(PG8_SB(1, 0), b3, voffB);
            PG8_BAR; PG8_WAIT_L(0); PG8_MMA(0, 1, At, B1); PG8_BAR;
            PG8_LDA(At, 1, 1); PG8_STAGE(PG8_SA(1, 0), a3, voffA);
            PG8_BAR; PG8_WAIT_L(0); PG8_MMA(1, 0, At, B0); PG8_BAR; PG8_SCHED;
            PG8_STAGE(PG8_SB(1, 1), b3 + hstep, voffB);
            PG8_WAIT_V(6); PG8_BAR; PG8_MMA(1, 1, At, B1); PG8_BAR;
            }
        }
        if constexpr (ALIGN_EPI) { if (wr == 0) PG8_BAR; }
        if constexpr (!Epi::AFTER_DRAIN) {
            if (cur.part < 0) E(acc, cur, wr, wc, fr, fq);
            else {
                const __amdgpu_buffer_rsrc_t rs = __builtin_amdgcn_make_buffer_rsrc((void*)((char*)sk_slab + ((size_t)cur.slot * 4 + cur.part) * (BM * BM * 2)), (short)0, BM * BM * 2, 0x00020000);
#pragma unroll
                for (int a = 0; a < 2; ++a)
#pragma unroll
                    for (int b = 0; b < 2; ++b)
#pragma unroll
                        for (int m = 0; m < 4; ++m) {
                            const f32x4 v0 = acc[a][b][m][0], v1 = acc[a][b][m][1];
                            u32x4 w; w.x = cvt_pk_bf16(v0[0], v0[1]); w.y = cvt_pk_bf16(v0[2], v0[3]); w.z = cvt_pk_bf16(v1[0], v1[1]); w.w = cvt_pk_bf16(v1[2], v1[3]);
                            __builtin_amdgcn_raw_buffer_store_b128(w, rs, tid * 16, (((a * 2 + b) * 4 + m) * 512) * 16, SK_AUX);
                        }
                asm volatile("s_waitcnt vmcnt(0)" ::: "memory");
                if (lane == 0) __hip_atomic_fetch_add(sk_cnt + 16 * cur.slot, 1u, __ATOMIC_RELAXED, __HIP_MEMORY_SCOPE_AGENT);
            }
            S.done(cur); }
        if (!has_next) break;
#pragma unroll
        for (int a = 0; a < 2; ++a)
#pragma unroll
            for (int b = 0; b < 2; ++b)
#pragma unroll
                for (int m = 0; m < 4; ++m)
#pragma unroll
                    for (int n = 0; n < 2; ++n) acc[a][b][m][n] = (f32x4){0.f, 0.f, 0.f, 0.f};
        cur = nxt; cA = nA; cB = nB; ++ui;
        if constexpr (ALIGN_EPI) { if (wr == 1) PG8_BAR; }
    }
    PG8_WAIT_V(0);
    if constexpr (!ALIGN_EPI) { if (wr == 0) PG8_BAR; }
    PG8_BAR;
    if constexpr (Epi::AFTER_DRAIN) { E.fused(acc, cur, wr, wc, fr, fq, lds, wid, lane); S.done(cur); }
    if constexpr (Epi::HAS_FRAG) {
        if (first.part >= 0) {
            if (wid == 0) {
                unsigned spins = 0;
                while ((unsigned)__builtin_amdgcn_readfirstlane(__hip_atomic_load(sk_cnt + 16 * first.slot, __ATOMIC_RELAXED, __HIP_MEMORY_SCOPE_AGENT)) < 32u) { __builtin_amdgcn_s_sleep(2); if (++spins > (1u << 22)) break; }
                __builtin_amdgcn_fence(__ATOMIC_ACQUIRE, "agent");
                asm volatile("s_waitcnt vmcnt(0)" ::: "memory");
            }
            asm volatile("" ::: "memory"); PG8_BAR; asm volatile("" ::: "memory");
            const __amdgpu_buffer_rsrc_t rs4 = __builtin_amdgcn_make_buffer_rsrc((void*)((char*)sk_slab + (size_t)first.slot * 4 * (BM * BM * 2)), (short)0, 4 * BM * BM * 2, 0x00020000);
            const int a = first.part >> 1, b = first.part & 1;
            u32x4 pv[4][4];
#pragma unroll
            for (int m = 0; m < 4; ++m)
#pragma unroll
                for (int q = 0; q < 4; ++q) pv[m][q] = __builtin_amdgcn_raw_buffer_load_b128(rs4, tid * 16, (((a * 2 + b) * 4 + m) * 512) * 16 + q * (BM * BM * 2), 0);
            __builtin_amdgcn_sched_barrier(0);
#pragma unroll
            for (int m = 0; m < 4; ++m) {
                f32x4 v0 = (f32x4){0.f, 0.f, 0.f, 0.f}, v1 = v0;
#pragma unroll
                for (int q = 0; q < 4; ++q) { const u32x4 w = pv[m][q];
                    v0 += (f32x4){__uint_as_float(w.x << 16), __uint_as_float(w.x & 0xffff0000u), __uint_as_float(w.y << 16), __uint_as_float(w.y & 0xffff0000u)};
                    v1 += (f32x4){__uint_as_float(w.z << 16), __uint_as_float(w.z & 0xffff0000u), __uint_as_float(w.w << 16), __uint_as_float(w.w & 0xffff0000u)}; }
                E.frag(v0, first, a, b, m, 0, wr, wc, fr, fq); E.frag(v1, first, a, b, m, 1, wr, wc, fr, fq);
            }
        }
    }
#undef PG8_SA
#undef PG8_SB
#undef PG8_STAGE
#undef PG8_LDA
#undef PG8_LDB
#undef PG8_MMA
#undef PG8_WAIT_V
#undef PG8_WAIT_L
#undef PG8_BAR
#undef PG8_SCHED
}
}
#define GAS __attribute__((address_space(1)))
#define LAS __attribute__((address_space(3)))
typedef float f32x4 __attribute__((ext_vector_type(4)));
typedef unsigned u32x2 __attribute__((ext_vector_type(2)));
typedef unsigned u32x4 __attribute__((ext_vector_type(4)));
constexpr int NWAVES = 8, NTHREADS = 512;
#define LDS_WAIT() asm volatile("s_waitcnt lgkmcnt(0)" ::: "memory")
#define VM_WAIT() asm volatile("s_waitcnt vmcnt(0)" ::: "memory")
constexpr int RING_BYTES = 145408;
constexpr int MISC_OFF = RING_BYTES + 320;
constexpr int LDS_BYTES = 147456;
#define XB_TMO      128
#define XB_XCNT(j)  (256  + 64 * (j))
#define XB_XSUB(j)  (1280 + 64 * (j))
#define XB_XGEN(j)  (2304 + 64 * (j))
#define XB_TOP      3328
#define XB_TOPGEN   3392
#define XCD_BAR_WORDS 3456
#define XB_SPIN_CAP (1u << 18)

__device__ __forceinline__ unsigned xb_ld(unsigned* p)              { return __hip_atomic_load(p, __ATOMIC_RELAXED, __HIP_MEMORY_SCOPE_AGENT); }
__device__ __forceinline__ unsigned xb_add(unsigned* p, unsigned v) { return __hip_atomic_fetch_add(p, v, __ATOMIC_RELAXED, __HIP_MEMORY_SCOPE_AGENT); }
__device__ __forceinline__ unsigned xb_xcc_id() { return (unsigned)__builtin_amdgcn_s_getreg((3 << 11) | 20) & 0xFu; }
#define XB_SPIN(cond, bar) do { unsigned _sp = 0; while (cond) { __builtin_amdgcn_s_sleep(1); \
    if ((++_sp & 255u) == 0u) { if (xb_ld(&(bar)[XB_TMO])) break; if (_sp > XB_SPIN_CAP) { atomicAdd(&(bar)[XB_TMO], 1u); break; } } } } while (0)

struct XcdBarrier {
    unsigned* bar; unsigned x;
    volatile LAS unsigned* st;
};

__device__ __forceinline__ XcdBarrier xcd_barrier_post(unsigned* bar, volatile LAS unsigned* st) {
    XcdBarrier b; b.bar = bar; b.x = xb_xcc_id(); b.st = st;
    if (threadIdx.x == 0) (void)xb_add(&bar[XB_XCNT(b.x)], 1u);
    return b;
}
__device__ __forceinline__ void xcd_barrier_complete(unsigned* bar, unsigned x, unsigned& nloc, unsigned& nx) {
    const unsigned G = gridDim.x * gridDim.y * gridDim.z;
    unsigned sum, cnt, mine, sp = 0u;
    for (;;) {
        sum = 0u; cnt = 0u; mine = 0u;
#pragma unroll
        for (unsigned j = 0; j < 16; ++j) { const unsigned c = xb_ld(&bar[XB_XCNT(j)]); sum += c; cnt += (c > 0u) ? 1u : 0u; mine = (j == x) ? c : mine; }
        if (sum == G) break;
        __builtin_amdgcn_s_sleep(1);
        if ((++sp & 255u) == 0u) { if (xb_ld(&bar[XB_TMO])) break; if (sp > XB_SPIN_CAP) { atomicAdd(&bar[XB_TMO], 1u); break; } }
    }
    nloc = mine > 0u ? mine : 1u; nx = cnt > 0u ? cnt : 1u;
}

__device__ __forceinline__ void xcd_barrier(const XcdBarrier& b) {
    asm volatile("s_waitcnt vmcnt(0)" ::: "memory");
    __syncthreads();
    if (threadIdx.x == 0) {
        unsigned* bar = b.bar;
        __builtin_amdgcn_s_waitcnt(0);
        unsigned nloc = b.st[0], nx = b.st[1];
        if (nloc == 0u) { xcd_barrier_complete(bar, b.x, nloc, nx); b.st[0] = nloc; b.st[1] = nx; }
        const unsigned old = xb_add(&bar[XB_XSUB(b.x)], 1u);
        const unsigned gen = old / nloc;
        if (old + 1u == (gen + 1u) * nloc) {
            __builtin_amdgcn_fence(__ATOMIC_RELEASE, "agent");
            asm volatile("s_waitcnt vmcnt(0)" ::: "memory");
            const unsigned og = xb_add(&bar[XB_TOP], 1u);
            const unsigned tg = og / nx;
            if (og + 1u == (tg + 1u) * nx) xb_add(&bar[XB_TOPGEN], 1u);
            else XB_SPIN(xb_ld(&bar[XB_TOPGEN]) == tg, bar);
            __builtin_amdgcn_fence(__ATOMIC_ACQUIRE, "agent");
            xb_add(&bar[XB_XGEN(b.x)], 1u);
            asm volatile("s_waitcnt vmcnt(0)" ::: "memory");
        } else {
            XB_SPIN(xb_ld(&bar[XB_XGEN(b.x)]) == gen, bar);
            __builtin_amdgcn_fence(__ATOMIC_ACQUIRE, "agent");
            asm volatile("s_waitcnt vmcnt(0)" ::: "memory");
        }
    }
    __syncthreads();
}
typedef short bf16x8 __attribute__((ext_vector_type(8)));
typedef short s16x4 __attribute__((ext_vector_type(4)));
typedef float f32x16 __attribute__((ext_vector_type(16)));
typedef float f32x2 __attribute__((ext_vector_type(2)));
constexpr float DEFER_THR = 8.0f;
typedef float f32x8v __attribute__((ext_vector_type(8)));
typedef __bf16 bfv2 __attribute__((ext_vector_type(2)));
constexpr float LOG2E = 1.4426950408889634f;
constexpr float QSCALE = SCALE * LOG2E;
constexpr int KS = 272, VS = 320;
constexpr int KTILE = 64 * KS, VTILE = 64 * VS;
constexpr int AT_K = 0, AT_V = 2 * KTILE, AT_FK = AT_V + 2 * VTILE, AT_REL = AT_FK + 512, AT_Q = AT_REL + 2064 + 48, AT_END = AT_Q + 16384;
static_assert(AT_END <= 131072 && AT_Q % 16 == 0, "attention LDS map");
constexpr int NSPLIT = 4;

__device__ __forceinline__ unsigned pkbf(float a, float b) { const f32x2 v = {a, b}; return __builtin_bit_cast(unsigned, __builtin_convertvector(v, bfv2)); }
__device__ __forceinline__ int off_b(int row, int ch) { return 256 * row + 16 * (ch ^ (((row & 3) << 2) | ((row >> 2) & 3))); }
__device__ __forceinline__ s16x4 tr_read4(const LAS unsigned char* p) { return __builtin_amdgcn_ds_read_tr16_b64_v4i16((LAS s16x4*)p); }
#define MFMA32(a, b, c) __builtin_amdgcn_mfma_f32_32x32x16_bf16((a), (b), (c), 0, 0, 0)

struct AttnCtx {
    const bf16_t* H; const float* ck; const float* cv;
    const float* F;
    const float* relb;
    bf16_t* O;
    float* PO; float* PM; float* PL;
};

struct TileRegs { f32x4 k0a, k0b, k1a, k1b, v0a, v0b, v1a, v1b; float fkr; };
struct TileGeo { int b, h, bh, kbase_row, kcol, vcol, tlast_new, ncache; };
template <int KIND>
__device__ __forceinline__ void tile_load1(f32x4& ka, f32x4& kb2, f32x4& va, f32x4& vb2, const AttnCtx& C, const TileGeo& G, int t, int c) {
    constexpr bool F32SRC = (KIND == 2 || KIND == 3);
    const int row = c >> 4, ch = c & 15;
    bool f32t = false;
    if constexpr (F32SRC) f32t = (t != G.tlast_new);
    if (f32t) {
        const size_t e = (((size_t)G.b * G.ncache + 64 * t + row) * NH + G.h) * HD + ch * 8;
        ka = *(const f32x4*)(C.ck + e); kb2 = *(const f32x4*)(C.ck + e + 4);
        va = *(const f32x4*)(C.cv + e); vb2 = *(const f32x4*)(C.cv + e + 4);
    } else {
        int hrow;
        if constexpr (KIND == 0 || KIND == 1) hrow = G.kbase_row + 64 * t + row; else hrow = TP + G.b * TS + row;
        const bf16_t* hp = C.H + (size_t)hrow * HP + ch * 8;
        ka = *(const f32x4*)(hp + G.kcol); va = *(const f32x4*)(hp + G.vcol);
    }
}
template <int KIND>
__device__ __forceinline__ void tile_load(TileRegs& TR, const AttnCtx& C, const TileGeo& G, int t, int tid) {
    constexpr bool FOX = (KIND == 0 || KIND == 3);
    tile_load1<KIND>(TR.k0a, TR.k0b, TR.v0a, TR.v0b, C, G, t, tid);
    tile_load1<KIND>(TR.k1a, TR.k1b, TR.v1a, TR.v1b, C, G, t, tid + 512);
    if constexpr (FOX) { if (tid < 64) TR.fkr = C.F[(size_t)G.bh * (KIND == 0 ? SEQ : PAST + TS) + 64 * t + tid]; }
}
template <int KIND, int KOFF = AT_K, int VOFF = AT_V>
__device__ __forceinline__ void tile_store1(const f32x4& ka, const f32x4& kb2, const f32x4& va, const f32x4& vb2, LAS unsigned char* lds, const TileGeo& G, int t, int buf, int c) {
    constexpr bool F32SRC = (KIND == 2 || KIND == 3);
    const int row = c >> 4, ch = c & 15;
    bool f32t = false;
    if constexpr (F32SRC) f32t = (t != G.tlast_new);
    u32x4 kc, vc;
    if (f32t) {
        kc.x = pkbf(ka.x, ka.y); kc.y = pkbf(ka.z, ka.w); kc.z = pkbf(kb2.x, kb2.y); kc.w = pkbf(kb2.z, kb2.w);
        vc.x = pkbf(va.x, va.y); vc.y = pkbf(va.z, va.w); vc.z = pkbf(vb2.x, vb2.y); vc.w = pkbf(vb2.z, vb2.w);
    } else { kc = __builtin_bit_cast(u32x4, ka); vc = __builtin_bit_cast(u32x4, va); }
    *(LAS u32x4*)(lds + KOFF + buf * KTILE + KS * row + 16 * ch) = kc; *(LAS u32x4*)(lds + VOFF + buf * VTILE + VS * row + 16 * ch) = vc;
}
template <int KIND, int KOFF = AT_K, int VOFF = AT_V, int FKOFF = AT_FK>
__device__ __forceinline__ void tile_store(const TileRegs& TR, LAS unsigned char* lds, const TileGeo& G, int t, int buf, int tid) {
    constexpr bool FOX = (KIND == 0 || KIND == 3);
    tile_store1<KIND, KOFF, VOFF>(TR.k0a, TR.k0b, TR.v0a, TR.v0b, lds, G, t, buf, tid);
    tile_store1<KIND, KOFF, VOFF>(TR.k1a, TR.k1b, TR.v1a, TR.v1b, lds, G, t, buf, tid + 512);
    if constexpr (FOX) { if (tid < 64) ((LAS float*)(lds + FKOFF))[buf * 64 + tid] = -LOG2E * TR.fkr; }
}
template <int KIND>
__device__ __forceinline__ void attn_item(LAS unsigned char* lds, const AttnCtx& C, int p0, int p1, int p2) {
    int tid_ = threadIdx.x; asm volatile("" : "+v"(tid_));
    const int tid = tid_, lane = tid & 63, wave = __builtin_amdgcn_readfirstlane(tid >> 6), lq = lane & 31, lh = lane >> 5;
    constexpr bool FOX = (KIND == 0 || KIND == 3), F32SRC = (KIND == 2 || KIND == 3);
    int b, h, bh = 0, t0, t1, qrow0, kbase_row = 0;
    if constexpr (KIND == 0) { bh = p0; b = bh >> 2; h = bh & 3; t0 = 0; t1 = 4 * p1 + 4; qrow0 = b * SEQ + 256 * p1 + 32 * wave; kbase_row = b * SEQ; }
    else if constexpr (KIND == 1) { b = p0; h = p2; t0 = (8 - 4 * p1) > 0 ? (8 - 4 * p1) : 0; t1 = 12; qrow0 = b * SEQ + 256 * p1 + 32 * wave; kbase_row = b * SEQ + 64 * (4 * p1 - 8); }
    else if constexpr (KIND == 2) { b = p0; h = p1; t0 = 0; t1 = 9; qrow0 = TP + b * TS + 32 * (wave & 1); }
    else { bh = p0; b = bh >> 2; h = bh & 3; t0 = 16 * p1; t1 = 16 * p1 + 16 + (p1 == NSPLIT - 1 ? 1 : 0); qrow0 = TP + b * TS + 32 * (wave & 1); }
    const int qcol = (FOX ? C_CQ : C_BQ) + h * HD, kcol = (FOX ? C_CK : C_BK) + h * HD, vcol = (FOX ? C_CV : C_BV) + h * HD;
    const bool qwave = (KIND <= 1) ? true : (wave < 2);
    const int tlast_new = (KIND == 2) ? 8 : 64;
    const int ncache = (KIND == 2) ? BAND : PAST;
    constexpr bool QLDS = (KIND >= 2);
    bf16x8 qf[QLDS ? 1 : 8];
    if (qwave) {
        const bf16_t* qp = C.H + (size_t)(qrow0 + lq) * HP + qcol + 8 * lh;
#pragma unroll
        for (int s = 0; s < 8; ++s) {
            const u32x4 raw = *(const u32x4*)(qp + 16 * s);
            u32x4 o; o.x = pkbf(bflo(raw.x) * QSCALE, bfhi(raw.x) * QSCALE); o.y = pkbf(bflo(raw.y) * QSCALE, bfhi(raw.y) * QSCALE);
            o.z = pkbf(bflo(raw.z) * QSCALE, bfhi(raw.z) * QSCALE); o.w = pkbf(bflo(raw.w) * QSCALE, bfhi(raw.w) * QSCALE);
            if constexpr (QLDS) *(LAS u32x4*)(lds + AT_Q + (wave & 1) * 8192 + s * 1024 + lane * 16) = o;
            else qf[s] = __builtin_bit_cast(bf16x8, o);
        }
    } else if constexpr (!QLDS) {
#pragma unroll
        for (int s = 0; s < 8; ++s) qf[s] = (bf16x8){0, 0, 0, 0, 0, 0, 0, 0};
    }
    const LAS unsigned char* Qb = lds + AT_Q + (wave & 1) * 8192 + lane * 16;
    if constexpr (!FOX) { LAS float* rel = (LAS float*)(lds + AT_REL); for (int i = tid; i < NREL; i += NTHREADS) rel[i] = C.relb[h * NREL + i] * LOG2E; }
    TileRegs TR; TR.fkr = 0.f; TR.k0b = TR.k1b = TR.v0b = TR.v1b = (f32x4){0.f, 0.f, 0.f, 0.f};
    constexpr bool DEEP = false && (KIND <= 1);
    TileRegs TR2; TR2.fkr = 0.f; TR2.k0a = TR2.k1a = TR2.v0a = TR2.v1a = TR2.k0b = TR2.k1b = TR2.v0b = TR2.v1b = (f32x4){0.f, 0.f, 0.f, 0.f};
    const TileGeo TG{b, h, bh, kbase_row, kcol, vcol, tlast_new, ncache};
#define load_tile(t) tile_load<KIND>(TR, C, TG, (t), tid)
#define store_tile(t, buf) tile_store<KIND>(TR, lds, TG, (t), (buf), tid)
#define load_tile2(t) tile_load<KIND>(TR2, C, TG, (t), tid)
#define store_tile2(t, buf) tile_store<KIND>(TR2, lds, TG, (t), (buf), tid)
    f32x16 oacc[4];
#pragma unroll
    for (int c = 0; c < 4; ++c)
#pragma unroll
        for (int r = 0; r < 16; ++r) oacc[c][r] = 0.f;
    float m_run = -1e30f, l_run = 0.f;
    const int wh = (KIND <= 1) ? (wave >> 1) : 0;
    const int qi = 32 * (wave & 1) + lq;
    const int q4 = (lane & 15) >> 2, p4 = lane & 3, blk = (lane >> 4) & 1;

    const int kofs0 = AT_K + KS * lq + 16 * lh;
    const int vofs0 = AT_V + VS * (4 * lh + q4) + 32 * blk + 8 * p4;
    load_tile(t0); store_tile(t0, 0);
    if (DEEP && t0 + 1 < t1) load_tile2(t0 + 1);
    __syncthreads();
#pragma unroll 2
    for (int st_ = 0; st_ < t1 - t0; ++st_) {
        const int t = t0 + st_;
        const int buf = st_ & 1;
        if constexpr (DEEP) { if (t + 2 < t1) { if (buf) load_tile2(t + 2); else load_tile(t + 2); } }
        else { if (t + 1 < t1) load_tile(t + 1); }
        bool active;
        if constexpr (KIND == 0) active = (t <= 4 * p1 + wh);
        else if constexpr (KIND == 1) active = (wh <= t) && (t <= wh + 8);
        else active = (wave < 2);
        if (active) {
            const LAS unsigned char* Kb = lds + kofs0 + buf * KTILE; const LAS unsigned char* Vb = lds + vofs0 + buf * VTILE;
            f32x16 sacc[2];
#pragma unroll
            for (int r = 0; r < 16; ++r) { sacc[0][r] = 0.f; sacc[1][r] = 0.f; }
            if constexpr (!QLDS) {
                constexpr int KR = 4;
                bf16x8 kf[KR];
#pragma unroll
                for (int s = 0; s < KR; ++s) kf[s] = *(const LAS bf16x8*)(Kb + 32 * s);
#pragma unroll
                for (int s = 0; s < 16; ++s) {
                    const int kb = s >> 3, ss = s & 7;
                    sacc[kb] = MFMA32(kf[s % KR], qf[ss], sacc[kb]);
                    if (s + KR < 16) kf[s % KR] = *(const LAS bf16x8*)(Kb + 32 * ((s + KR) & 7) + 32 * KS * ((s + KR) >> 3));
                }
            } else {
#pragma unroll
                for (int s = 0; s < 8; ++s) {
                    const bf16x8 q = *(const LAS bf16x8*)(Qb + 1024 * s);
                    const bf16x8 k0 = *(const LAS bf16x8*)(Kb + 32 * s), k1 = *(const LAS bf16x8*)(Kb + 32 * s + 32 * KS);
                    sacc[0] = MFMA32(k0, q, sacc[0]); sacc[1] = MFMA32(k1, q, sacc[1]);
                }
            }
            s16x4 vlo[4], vhi[4];
#define AT_VREAD(kb_, s2_) do { _Pragma("unroll") for (int c = 0; c < 4; ++c) { \
                vlo[c] = tr_read4(Vb + VS * (32 * (kb_) + 16 * (s2_)) + 64 * c); vhi[c] = tr_read4(Vb + VS * (32 * (kb_) + 16 * (s2_) + 8) + 64 * c); } } while (0)
            AT_VREAD(0, 0);
            if constexpr (FOX) {
                const LAS float* fk = (const LAS float*)(lds + AT_FK) + buf * 64;
                bool need_mask;
                if constexpr (KIND == 0) need_mask = (t == 4 * p1 + wh); else need_mask = (t == tlast_new);
#pragma unroll
                for (int kb = 0; kb < 2; ++kb) {
                    { const f32x4 fa = *(const LAS f32x4*)(fk + 32 * kb + 4 * lh), fb = *(const LAS f32x4*)(fk + 32 * kb + 8 + 4 * lh), fc = *(const LAS f32x4*)(fk + 32 * kb + 16 + 4 * lh), fd = *(const LAS f32x4*)(fk + 32 * kb + 24 + 4 * lh);
                      sacc[kb] += __builtin_shufflevector(__builtin_shufflevector(fa, fb, 0, 1, 2, 3, 4, 5, 6, 7), __builtin_shufflevector(fc, fd, 0, 1, 2, 3, 4, 5, 6, 7), 0, 1, 2, 3, 4, 5, 6, 7, 8, 9, 10, 11, 12, 13, 14, 15); }
                    __builtin_amdgcn_sched_barrier(0);
                }
                if (need_mask) {
                    asm volatile("" ::: "memory");
#pragma unroll
                    for (int kb = 0; kb < 2; ++kb)
#pragma unroll
                        for (int r = 0; r < 16; ++r) { const int key = 32 * kb + 8 * (r >> 2) + 4 * lh + (r & 3); if (key > qi) sacc[kb][r] = -__builtin_inff(); }
                }
            } else {
                const LAS float* rel = (const LAS float*)(lds + AT_REL);
                const int dchunk = wh + 8 - t;
                if (dchunk >= 5) {
                    const float cb = rel[512];
#pragma unroll
                    for (int kb = 0; kb < 2; ++kb)
#pragma unroll
                        for (int r = 0; r < 16; ++r) sacc[kb][r] += cb;
                } else {
                    const int d0 = 64 * dchunk + qi - 4 * lh;
#pragma unroll
                    for (int kb = 0; kb < 2; ++kb)
#pragma unroll
                        for (int r = 0; r < 16; ++r) {
                            int idx = d0 - (32 * kb + 8 * (r >> 2) + (r & 3));
                            idx = idx < -256 ? -256 : (idx > 256 ? 256 : idx);
                            sacc[kb][r] += rel[idx + 256];
                        }
                }
            }
            float mx = sacc[0][0];
#pragma unroll
            for (int kb = 0; kb < 2; ++kb)
#pragma unroll
                for (int r = 0; r < 16; ++r) mx = fmaxf(mx, sacc[kb][r]);
            mx = fmaxf(mx, xshfl32(mx, lane));
            float m_new = m_run;
            if (__any(mx > m_run + DEFER_THR)) {
                m_new = fmaxf(m_run, mx);
                const float corr = __builtin_amdgcn_exp2f(m_run - m_new);
                l_run *= corr;
#pragma unroll
                for (int c = 0; c < 4; ++c)
#pragma unroll
                    for (int r = 0; r < 16; ++r) oacc[c][r] *= corr;
            }
            m_run = m_new;
            sacc[0] -= m_new; sacc[1] -= m_new;
#pragma unroll
            for (int kb = 0; kb < 2; ++kb)
#pragma unroll
                for (int r = 0; r < 16; ++r) sacc[kb][r] = __builtin_amdgcn_exp2f(sacc[kb][r]);
            float ps;
            { const f32x16 t16 = sacc[0] + sacc[1];
              const f32x8v t8 = __builtin_shufflevector(t16, t16, 0, 1, 2, 3, 4, 5, 6, 7) + __builtin_shufflevector(t16, t16, 8, 9, 10, 11, 12, 13, 14, 15);
              const f32x4 t4 = __builtin_shufflevector(t8, t8, 0, 1, 2, 3) + __builtin_shufflevector(t8, t8, 4, 5, 6, 7);
              ps = (t4.x + t4.y) + (t4.z + t4.w); }
            ps += xshfl32(ps, lane);
            l_run += ps;
#pragma unroll
            for (int kk = 0; kk < 4; ++kk) {
                const int kb = kk >> 1, s2 = kk & 1;
                u32x4 pw; pw.x = pkbf(sacc[kb][8 * s2 + 0], sacc[kb][8 * s2 + 1]); pw.y = pkbf(sacc[kb][8 * s2 + 2], sacc[kb][8 * s2 + 3]);
                pw.z = pkbf(sacc[kb][8 * s2 + 4], sacc[kb][8 * s2 + 5]); pw.w = pkbf(sacc[kb][8 * s2 + 6], sacc[kb][8 * s2 + 7]);
                const bf16x8 pf = __builtin_bit_cast(bf16x8, pw);
#pragma unroll
                for (int c = 0; c < 4; ++c) oacc[c] = MFMA32(__builtin_shufflevector(vlo[c], vhi[c], 0, 1, 2, 3, 4, 5, 6, 7), pf, oacc[c]);
                if (kk < 3) { AT_VREAD((kk + 1) >> 1, (kk + 1) & 1); }
            }
#undef AT_VREAD
        }
        if constexpr (DEEP) { if (t + 1 < t1) { if (buf) store_tile(t + 1, 0); else store_tile2(t + 1, 1); } }
        else { if (t + 1 < t1) store_tile(t + 1, buf ^ 1); }
        __syncthreads();
    }
    if (qwave) {
        if constexpr (KIND == 3) {
            const size_t pr = ((size_t)bh * NSPLIT + p1) * TS + qi;
#pragma unroll
            for (int c = 0; c < 4; ++c)
#pragma unroll
                for (int g = 0; g < 4; ++g) { const f32x4 v = {oacc[c][4 * g], oacc[c][4 * g + 1], oacc[c][4 * g + 2], oacc[c][4 * g + 3]}; *(f32x4*)(C.PO + pr * HD + 32 * c + 8 * g + 4 * lh) = v; }
            if (lh == 0) { C.PM[pr] = m_run; C.PL[pr] = l_run; }
        } else {
            const float inv = 1.f / l_run;
            bf16_t* op = C.O + (size_t)(qrow0 + lq) * DB + h * HD + 4 * lh;
#pragma unroll
            for (int c = 0; c < 4; ++c)
#pragma unroll
                for (int g = 0; g < 4; ++g) { u32x2 w; w.x = pkbf(oacc[c][4 * g] * inv, oacc[c][4 * g + 1] * inv); w.y = pkbf(oacc[c][4 * g + 2] * inv, oacc[c][4 * g + 3] * inv); *(u32x2*)(op + 32 * c + 8 * g) = w; }
        }
    }
}
#undef load_tile
#undef store_tile
#undef load_tile2
#undef store_tile2


__device__ __forceinline__ void fox_combine_row(const float* PO, const float* PM, const float* PL, float* OC, int idx, int lane) {
    const int bh = idx >> 6, qi = idx & 63, b = bh >> 2, h = bh & 3;
    float m = -1e30f;
#pragma unroll
    for (int s = 0; s < NSPLIT; ++s) m = fmaxf(m, PM[((size_t)bh * NSPLIT + s) * TS + qi]);
    float l = 0.f, o0 = 0.f, o1 = 0.f;
#pragma unroll
    for (int s = 0; s < NSPLIT; ++s) {
        const size_t pr = ((size_t)bh * NSPLIT + s) * TS + qi;
        const float w = __builtin_amdgcn_exp2f(PM[pr] - m);
        l += PL[pr] * w; o0 += PO[pr * HD + lane] * w; o1 += PO[pr * HD + lane + 64] * w;
    }
    const float inv = 1.f / l;
    float* op = OC + (size_t)(TP + b * TS + qi) * DB + h * HD;
    op[lane] = o0 * inv; op[lane + 64] = o1 * inv;
}

constexpr int FS_K = 0, FS_V = 3 * KTILE, FS_FK = FS_V + 3 * VTILE, FS_Q = FS_FK + 768, FS_END = FS_Q + 16384;
static_assert(FS_END <= RING_BYTES && FS_Q % 16 == 0, "fox-sample LDS map");
#define FS_BAR() do { asm volatile("s_waitcnt lgkmcnt(0)" ::: "memory"); __builtin_amdgcn_s_barrier(); asm volatile("" ::: "memory"); } while (0)

__device__ __forceinline__ void fox_sample_item(LAS unsigned char* lds, const AttnCtx& C, int bh, int sp) {
    int tid_ = threadIdx.x; asm volatile("" : "+v"(tid_));
    const int tid = tid_, lane = tid & 63, wave = __builtin_amdgcn_readfirstlane(tid >> 6);
    const int b = bh >> 2, h = bh & 3, t0 = 16 * sp;
    const bool has_new = (sp == NSPLIT - 1);
    const int nsteps = 16 + (has_new ? 1 : 0);
    if (wave >= 2) {
        const int ltid = tid - 128;
        const float* kbase = C.ck + (((size_t)b * PAST) * NH + h) * HD; const float* vbase = C.cv + (((size_t)b * PAST) * NH + h) * HD;
        const bool six = ltid < 128;
        constexpr int FD = 3;
        f32x4 R[FD][12]; float fk[FD];
#define FS_LOAD(SET, T) do { _Pragma("unroll") for (int i = 0; i < 6; ++i) { if (i < 5 || six) { const int it = ltid + 384 * i, isv = it >> 10, ii = it & 1023, row = ii >> 4, ch = ii & 15; \
            const float* src = (isv ? vbase : kbase) + ((size_t)(64 * (T) + row) * NH) * HD + 8 * ch; R[SET][2 * i] = *(const f32x4*)src; R[SET][2 * i + 1] = *(const f32x4*)(src + 4); } } \
            if (ltid < 64) fk[SET] = C.F[(size_t)bh * (PAST + TS) + 64 * (T) + ltid]; } while (0)
#define FS_STORE(SET, BUF) do { _Pragma("unroll") for (int i = 0; i < 6; ++i) { if (i < 5 || six) { const int it = ltid + 384 * i, isv = it >> 10, ii = it & 1023, row = ii >> 4, ch = ii & 15; \
            const f32x4 a = R[SET][2 * i], c4 = R[SET][2 * i + 1]; u32x4 w; w.x = pkbf(a.x, a.y); w.y = pkbf(a.z, a.w); w.z = pkbf(c4.x, c4.y); w.w = pkbf(c4.z, c4.w); \
            if (isv) *(LAS u32x4*)(lds + FS_V + (BUF) * VTILE + VS * row + 16 * ch) = w; else *(LAS u32x4*)(lds + FS_K + (BUF) * KTILE + KS * row + 16 * ch) = w; } } \
            if (ltid < 64) ((LAS float*)(lds + FS_FK))[(BUF) * 64 + ltid] = -LOG2E * fk[SET]; } while (0)
#pragma unroll
        for (int d = 0; d < FD; ++d) FS_LOAD(d, t0 + d);
#pragma unroll
        for (int s = 0; s < 16; ++s) {
            FS_STORE(s % FD, s % 3);
            if (s + FD < 16) FS_LOAD(s % FD, t0 + s + FD);
            FS_BAR();
        }
#undef FS_LOAD
#undef FS_STORE
        if (has_new) {
            for (int it = ltid; it < 2048; it += 384) {
                const int isv = it >> 10, ii = it & 1023, row = ii >> 4, ch = ii & 15;
                const u32x4 w = *(const u32x4*)(C.H + (size_t)(TP + b * TS + row) * HP + (isv ? C_CV : C_CK) + h * HD + 8 * ch);
                if (isv) *(LAS u32x4*)(lds + FS_V + 1 * VTILE + VS * row + 16 * ch) = w; else *(LAS u32x4*)(lds + FS_K + 1 * KTILE + KS * row + 16 * ch) = w;
            }
            if (ltid < 64) ((LAS float*)(lds + FS_FK))[1 * 64 + ltid] = -LOG2E * C.F[(size_t)bh * (PAST + TS) + PAST + ltid];
            FS_BAR();
        }
    } else {
        const int lq = lane & 31, lh = lane >> 5, qi = 32 * wave + lq;
        const int q4 = (lane & 15) >> 2, p4 = lane & 3, blk = (lane >> 4) & 1;
        {
            const bf16_t* qp = C.H + (size_t)(TP + b * TS + qi) * HP + C_CQ + h * HD + 8 * lh;
#pragma unroll
            for (int s = 0; s < 8; ++s) {
                const u32x4 raw = *(const u32x4*)(qp + 16 * s);
                u32x4 o; o.x = pkbf(bflo(raw.x) * QSCALE, bfhi(raw.x) * QSCALE); o.y = pkbf(bflo(raw.y) * QSCALE, bfhi(raw.y) * QSCALE);
                o.z = pkbf(bflo(raw.z) * QSCALE, bfhi(raw.z) * QSCALE); o.w = pkbf(bflo(raw.w) * QSCALE, bfhi(raw.w) * QSCALE);
                *(LAS u32x4*)(lds + FS_Q + wave * 8192 + s * 1024 + lane * 16) = o;
            }
        }
        const LAS unsigned char* Qb = lds + FS_Q + wave * 8192 + lane * 16;
        const int kofs0 = FS_K + KS * lq + 16 * lh, vofs0 = FS_V + VS * (4 * lh + q4) + 32 * blk + 8 * p4;
        f32x16 oacc[4];
#pragma unroll
        for (int c = 0; c < 4; ++c)
#pragma unroll
            for (int r = 0; r < 16; ++r) oacc[c][r] = 0.f;
        float m_run = -1e30f, l_run = 0.f;
        for (int s = 0; s < nsteps; ++s) {
            FS_BAR();
            const int buf = s % 3;
            const LAS unsigned char* Kb = lds + kofs0 + buf * KTILE; const LAS unsigned char* Vb = lds + vofs0 + buf * VTILE;
            f32x16 sacc[2];
#pragma unroll
            for (int r = 0; r < 16; ++r) { sacc[0][r] = 0.f; sacc[1][r] = 0.f; }
#pragma unroll
            for (int ss = 0; ss < 8; ++ss) {
                const bf16x8 q = *(const LAS bf16x8*)(Qb + 1024 * ss);
                const bf16x8 k0 = *(const LAS bf16x8*)(Kb + 32 * ss), k1 = *(const LAS bf16x8*)(Kb + 32 * ss + 32 * KS);
                sacc[0] = MFMA32(k0, q, sacc[0]); sacc[1] = MFMA32(k1, q, sacc[1]);
            }
            s16x4 vlo[4], vhi[4];
#define FS_VREAD(kb_, s2_) do { _Pragma("unroll") for (int c = 0; c < 4; ++c) { \
                vlo[c] = tr_read4(Vb + VS * (32 * (kb_) + 16 * (s2_)) + 64 * c); vhi[c] = tr_read4(Vb + VS * (32 * (kb_) + 16 * (s2_) + 8) + 64 * c); } } while (0)
            FS_VREAD(0, 0);
            {
                const LAS float* fkp = (const LAS float*)(lds + FS_FK) + buf * 64;
#pragma unroll
                for (int kb = 0; kb < 2; ++kb) {
                    { const f32x4 fa = *(const LAS f32x4*)(fkp + 32 * kb + 4 * lh), fb = *(const LAS f32x4*)(fkp + 32 * kb + 8 + 4 * lh), fc = *(const LAS f32x4*)(fkp + 32 * kb + 16 + 4 * lh), fd = *(const LAS f32x4*)(fkp + 32 * kb + 24 + 4 * lh);
                      sacc[kb] += __builtin_shufflevector(__builtin_shufflevector(fa, fb, 0, 1, 2, 3, 4, 5, 6, 7), __builtin_shufflevector(fc, fd, 0, 1, 2, 3, 4, 5, 6, 7), 0, 1, 2, 3, 4, 5, 6, 7, 8, 9, 10, 11, 12, 13, 14, 15); }
                    __builtin_amdgcn_sched_barrier(0);
                }
                if (s == 16) {
                    asm volatile("" ::: "memory");
#pragma unroll
                    for (int kb = 0; kb < 2; ++kb)
#pragma unroll
                        for (int r = 0; r < 16; ++r) { const int key = 32 * kb + 8 * (r >> 2) + 4 * lh + (r & 3); if (key > qi) sacc[kb][r] = -__builtin_inff(); }
                }
            }
            float mx = sacc[0][0];
#pragma unroll
            for (int kb = 0; kb < 2; ++kb)
#pragma unroll
                for (int r = 0; r < 16; ++r) mx = fmaxf(mx, sacc[kb][r]);
            mx = fmaxf(mx, xshfl32(mx, lane));
            float m_new = m_run;
            if (__any(mx > m_run + DEFER_THR)) {
                m_new = fmaxf(m_run, mx);
                const float corr = __builtin_amdgcn_exp2f(m_run - m_new);
                l_run *= corr;
#pragma unroll
                for (int c = 0; c < 4; ++c)
#pragma unroll
                    for (int r = 0; r < 16; ++r) oacc[c][r] *= corr;
            }
            m_run = m_new;
            sacc[0] -= m_new; sacc[1] -= m_new;
#pragma unroll
            for (int kb = 0; kb < 2; ++kb)
#pragma unroll
                for (int r = 0; r < 16; ++r) sacc[kb][r] = __builtin_amdgcn_exp2f(sacc[kb][r]);
            float ps;
            { const f32x16 t16 = sacc[0] + sacc[1];
              const f32x8v t8 = __builtin_shufflevector(t16, t16, 0, 1, 2, 3, 4, 5, 6, 7) + __builtin_shufflevector(t16, t16, 8, 9, 10, 11, 12, 13, 14, 15);
              const f32x4 t4 = __builtin_shufflevector(t8, t8, 0, 1, 2, 3) + __builtin_shufflevector(t8, t8, 4, 5, 6, 7);
              ps = (t4.x + t4.y) + (t4.z + t4.w); }
            ps += xshfl32(ps, lane);
            l_run += ps;
#pragma unroll
            for (int kk = 0; kk < 4; ++kk) {
                const int kb = kk >> 1, s2 = kk & 1;
                u32x4 pw; pw.x = pkbf(sacc[kb][8 * s2 + 0], sacc[kb][8 * s2 + 1]); pw.y = pkbf(sacc[kb][8 * s2 + 2], sacc[kb][8 * s2 + 3]);
                pw.z = pkbf(sacc[kb][8 * s2 + 4], sacc[kb][8 * s2 + 5]); pw.w = pkbf(sacc[kb][8 * s2 + 6], sacc[kb][8 * s2 + 7]);
                const bf16x8 pf = __builtin_bit_cast(bf16x8, pw);
#pragma unroll
                for (int c = 0; c < 4; ++c) oacc[c] = MFMA32(__builtin_shufflevector(vlo[c], vhi[c], 0, 1, 2, 3, 4, 5, 6, 7), pf, oacc[c]);
                if (kk < 3) { FS_VREAD((kk + 1) >> 1, (kk + 1) & 1); }
            }
#undef FS_VREAD
        }
        const size_t pr = ((size_t)bh * NSPLIT + sp) * TS + qi;
#pragma unroll
        for (int c = 0; c < 4; ++c)
#pragma unroll
            for (int g = 0; g < 4; ++g) { const f32x4 v = {oacc[c][4 * g], oacc[c][4 * g + 1], oacc[c][4 * g + 2], oacc[c][4 * g + 3]}; *(f32x4*)(C.PO + pr * HD + 32 * c + 8 * g + 4 * lh) = v; }
        if (lh == 0) { C.PM[pr] = m_run; C.PL[pr] = l_run; }
    }
}
constexpr int LR_XCF = 0  , LR_XCB = 32768, LR_A = 49152, LR_AG = 81920  ,
              LR_QS = 98304, LR_SS = 102400, LR_H0 = 102912, LR_CW = 107008  , LR_GC = 127488  , LR_GM = 139776  , LR_END = 143872;
static_assert(LR_END <= RING_BYTES, "lru LDS map");
constexpr bool LRU_STREAM = false;
struct LruCtx { const bf16_t* H; const float* sconv; const float* slru; const float* wconv; const float* bconv; const bf16_t* WgT; const float* bra; const float* brx; const float* lam;
                const float* gm; float* SA; float* SH; bf16_t* Y; float* out; int l; int nb; int pf; const bf16_t* OB; const bf16_t* OC; float* AG_; bf16_t* UG_; };

__device__ __forceinline__ float fast_sigmoid(float x) { return __builtin_amdgcn_rcpf(1.f + __builtin_amdgcn_exp2f(-1.4426950408889634f * x)); }
__device__ __forceinline__ float fast_gelu_tanh(float x) {
    const float z2 = 1.5957691216057308f * (x + 0.044715f * x * x * x);
    return x * __builtin_amdgcn_rcpf(1.f + __builtin_amdgcn_exp2f(-1.4426950408889634f * z2));
}
__device__ __forceinline__ float fast_gelu_tanh2(float x) {
    constexpr float c1 = -1.4426950408889634f * 1.5957691216057308f, c2 = c1 * 0.044715f;
    return x * __builtin_amdgcn_rcpf(1.f + __builtin_amdgcn_exp2f(x * (c2 * (x * x) + c1)));
}
__device__ __forceinline__ float one_minus_exp(float x, float ehalf  ) {
    const float big = 1.f - ehalf * ehalf;
    const float small = -x * (1.f + x * (0.5f + x * (0.16666667f + x * (0.041666668f + x * 0.0083333338f))));
    return (x > -0.25f) ? small : big;
}

struct LruRows { u32x4 r[4][2]; u32x4 ag[2]; };

template <bool PASS2>
__device__ __forceinline__ void lru_fetch(u32x4 (&r)[4][2], u32x4 (&ag)[2], const LruCtx& C, bool prm, int b, int c, int row0, int n, int t, int cg) {
    const int col = n * HD + 16 * cg;
#pragma unroll
    for (int j = 0; j < 4; ++j) {
        const int tt = t + j - 3, tpos = (prm ? 64 * c : 0) + tt;
        if (tpos >= 0) { const bf16_t* hp = C.H + (size_t)(row0 + tt) * HP + C_AX + col; r[j][0] = *(const u32x4*)hp; r[j][1] = *(const u32x4*)(hp + 8); }
        else { r[j][0] = (u32x4){0u, 0u, 0u, 0u}; r[j][1] = (u32x4){0u, 0u, 0u, 0u}; }
    }
    if constexpr (PASS2) { const bf16_t* gp = C.H + (size_t)(row0 + t) * HP + C_AG + col; ag[0] = *(const u32x4*)gp; ag[1] = *(const u32x4*)(gp + 8); }
}

template <bool PASS2>
__device__ __forceinline__ void lru_item(LAS unsigned char* lds, const LruCtx& C, int chunk) {
    int tid_ = threadIdx.x; asm volatile("" : "+v"(tid_));
    const int tid = tid_, lane = tid & 63, wave = __builtin_amdgcn_readfirstlane(tid >> 6);
    const bool prm = chunk < 256; const int b = prm ? (chunk >> 6) : (chunk - 256), c = prm ? (chunk & 63) : 0;
    const int row0 = prm ? b * SEQ + 64 * c : TP + b * TS;
    LAS float* XCF = (LAS float*)(lds + LR_XCF); LAS unsigned char* XCB = lds + LR_XCB; LAS float* AA = (LAS float*)(lds + LR_A); LAS float* UU = XCF;
    LAS float* QS = (LAS float*)(lds + LR_QS); LAS float* SS = (LAS float*)(lds + LR_SS); LAS float* H0 = (LAS float*)(lds + LR_H0); LAS bf16_t* AG = (LAS bf16_t*)(lds + LR_AG); LAS float* CW = (LAS float*)(lds + LR_CW); LAS float* GC = (LAS float*)(lds + LR_GC);
    const int st_ = tid >> 3, scg_ = tid & 7;
    u32x4 rr[4][2], rag[2];
    lru_fetch<PASS2>(rr, rag, C, prm, b, c, row0, 0, st_, scg_);
#pragma unroll
    for (int i = 0; i < 2; ++i) {
        const int ch = tid + 512 * i;
        CW[ch] = C.bconv[ch];
#pragma unroll
        for (int j = 0; j < 4; ++j) CW[(1 + j) * DA + ch] = C.wconv[(size_t)j * DA + ch];
        GC[ch] = C.bra[ch]; GC[DA + ch] = C.brx[ch]; GC[2 * DA + ch] = log1pf(expf(-C.lam[ch]));
        if constexpr (PASS2) ((LAS float*)(lds + LR_GM))[ch] = C.gm[ch];
    }
    if constexpr (PASS2) {
#pragma unroll
        for (int i = 0; i < 2; ++i) {
            const int ch = tid + 512 * i; float h;
            if (prm && !(C.pf & 1)) { h = 0.f; const float* sa = C.SA + (size_t)b * 64 * DA + ch; const float* sh = C.SH + (size_t)b * 64 * DA + ch;
                for (int j0 = 0; j0 < c; j0 += 16) {
                    float av[16], hv[16];
#pragma unroll
                    for (int k = 0; k < 16; ++k) { av[k] = sa[(size_t)(j0 + k) * DA]; hv[k] = sh[(size_t)(j0 + k) * DA]; }
#pragma unroll
                    for (int k = 0; k < 16; ++k) if (j0 + k < c) h = av[k] * h + hv[k];
                } }
            else h = prm ? 0.f : C.slru[(size_t)b * DA + ch];
            H0[ch] = h;
        }
        if (tid < 64) SS[tid] = 0.f;
    }
    __syncthreads();
    for (int n = 0; n < C.nb; ++n) {
        u32x4 wq0[8], wq1[8];
        { int ln = lane; asm volatile("" : "+v"(ln));
          const int ch = 32 * (wave >> 1) + (ln & 31);
          const bf16_t* b0p = C.WgT + ((size_t)(0 * 8 + n) * HD + ch) * HD + 8 * (ln >> 5); const bf16_t* b1p = C.WgT + ((size_t)(1 * 8 + n) * HD + ch) * HD + 8 * (ln >> 5);
#pragma unroll
          for (int s = 0; s < 8; ++s) { wq0[s] = *(const u32x4*)(b0p + 16 * s); wq1[s] = *(const u32x4*)(b1p + 16 * s); } }
        {
            int st = st_, scg = scg_; asm volatile("" : "+v"(st), "+v"(scg));
            const int col = n * HD + 16 * scg;
            f32x4 acc[4];
#pragma unroll
            for (int k = 0; k < 4; ++k) acc[k] = *(const LAS f32x4*)(CW + col + 4 * k);
#pragma unroll
            for (int j = 0; j < 4; ++j) {
                const int tpos = (prm ? 64 * c : 0) + st + j - 3;
                f32x4 x[4];
                if (tpos >= 0 || prm) {
                    const u32x4 r0 = rr[j][0], r1 = rr[j][1];
                    x[0] = (f32x4){bflo(r0.x), bfhi(r0.x), bflo(r0.y), bfhi(r0.y)}; x[1] = (f32x4){bflo(r0.z), bfhi(r0.z), bflo(r0.w), bfhi(r0.w)};
                    x[2] = (f32x4){bflo(r1.x), bfhi(r1.x), bflo(r1.y), bfhi(r1.y)}; x[3] = (f32x4){bflo(r1.z), bfhi(r1.z), bflo(r1.w), bfhi(r1.w)};
                } else {
                    const float* sp = C.sconv + ((size_t)b * 3 + (tpos + 3)) * DA + col;
#pragma unroll
                    for (int k = 0; k < 4; ++k) x[k] = *(const f32x4*)(sp + 4 * k);
                }
#pragma unroll
                for (int k = 0; k < 4; ++k) { const f32x4 w = *(const LAS f32x4*)(CW + (1 + j) * DA + col + 4 * k); acc[k] += w * x[k]; }
            }
#pragma unroll
            for (int k = 0; k < 4; ++k) *(LAS f32x4*)(XCF + st * HD + 16 * scg + 4 * k) = acc[k];
            u32x4 w0, w1;
            w0.x = pkbf(acc[0].x, acc[0].y); w0.y = pkbf(acc[0].z, acc[0].w); w0.z = pkbf(acc[1].x, acc[1].y); w0.w = pkbf(acc[1].z, acc[1].w);
            w1.x = pkbf(acc[2].x, acc[2].y); w1.y = pkbf(acc[2].z, acc[2].w); w1.z = pkbf(acc[3].x, acc[3].y); w1.w = pkbf(acc[3].z, acc[3].w);
            *(LAS u32x4*)(XCB + off_b(st, 2 * scg)) = w0; *(LAS u32x4*)(XCB + off_b(st, 2 * scg + 1)) = w1;
            if constexpr (PASS2) { *(LAS u32x4*)(AG + st * HD + 16 * scg) = rag[0]; *(LAS u32x4*)(AG + st * HD + 16 * scg + 8) = rag[1]; }
            if (n + 1 < 8) { int st2 = st, cg2 = scg; asm volatile("" : "+v"(st2), "+v"(cg2)); lru_fetch<PASS2>(rr, rag, C, prm, b, c, row0, n + 1, st2, cg2); }
        }
        {
            int ln = lane; asm volatile("" : "+v"(ln));
            const int lq = ln & 31, lh = ln >> 5;
            const int rt = wave & 1, ct = wave >> 1, ch = 32 * ct + lq, gch = n * HD + ch;
            const float bra = GC[gch], brx = GC[DA + gch], sp = GC[2 * DA + gch];
            __syncthreads();
            f32x16 g0, g1;
#pragma unroll
            for (int r = 0; r < 16; ++r) { g0[r] = 0.f; g1[r] = 0.f; }
#pragma unroll
            for (int s = 0; s < 8; ++s) {
                const bf16x8 a = *(const LAS bf16x8*)(XCB + off_b(32 * rt + lq, 2 * s + lh));
                g0 = MFMA32(a, __builtin_bit_cast(bf16x8, wq0[s]), g0); g1 = MFMA32(a, __builtin_bit_cast(bf16x8, wq1[s]), g1);
            }
#pragma unroll
            for (int r = 0; r < 16; ++r) {
                const int t = 32 * rt + 8 * (r >> 2) + 4 * lh + (r & 3);
                const float rg = fast_sigmoid(g0[r] + bra), ig = fast_sigmoid(g1[r] + brx);
                const float log_a = -8.0f * rg * sp, a = __builtin_amdgcn_exp2f(1.4426950408889634f * log_a);
                float mult = __builtin_amdgcn_sqrtf(one_minus_exp(2.0f * log_a, a));
                if (prm && c == 0 && t == 0) mult = 1.0f;
                const float uv = mult * (ig * XCF[t * HD + ch]);
                AA[t * HD + ch] = a; UU[t * HD + ch] = uv;
                if constexpr (!PASS2 && LRU_STREAM) { C.AG_[(size_t)(row0 + t) * DA + gch] = a; C.UG_[(size_t)(row0 + t) * DA + gch] = f2bf(uv); }
            }
        }
        __syncthreads();
        {
            int tn = tid; asm volatile("" : "+v"(tn));
            const int ch = tn & 127, q = tn >> 7, gch = n * HD + ch;
            const LAS float* ap = AA + (16 * q) * HD + ch; const LAS float* up = UU + (16 * q) * HD + ch;
            float ra = 1.f, rh = 0.f;
#pragma unroll 4
            for (int i = 0; i < 16; ++i) { const float a = ap[i * HD], u = up[i * HD]; rh = a * rh + u; ra *= a; }
            QS[(q * HD + ch) * 2] = ra; QS[(q * HD + ch) * 2 + 1] = rh;
            __syncthreads();
            float cin = PASS2 ? H0[gch] : 0.f;
            for (int qq = 0; qq < q; ++qq) cin = QS[(qq * HD + ch) * 2] * cin + QS[(qq * HD + ch) * 2 + 1];
            if constexpr (!PASS2) {
                if (q == 3) {
                    const float atot = QS[(0 * HD + ch) * 2] * QS[(1 * HD + ch) * 2] * QS[(2 * HD + ch) * 2] * ra;
                    C.SA[((size_t)b * 64 + c) * DA + gch] = atot; C.SH[((size_t)b * 64 + c) * DA + gch] = ra * cin + rh;
                }
            } else {
                float h = cin;
                LAS bf16_t* agp = AG + (16 * q) * HD + ch;
#pragma unroll 4
                for (int i = 0; i < 16; ++i) {
                    h = ap[i * HD] * h + up[i * HD];
                    agp[i * HD] = f2bf(h * fast_gelu_tanh(bf2f(agp[i * HD])));
                }
                if (q == 3 && (!prm || c == 63)) { if (prm) C.out[O_PLRU + (size_t)(C.l * NB_P + b) * DA + gch] = h; else C.out[O_SLRU + (size_t)(C.l * NB_S + b) * DA + gch] = h; }
            }
        }
        __syncthreads();
        if constexpr (PASS2) {
            int st = st_, scg = scg_; asm volatile("" : "+v"(st), "+v"(scg));
            const u32x4 y0 = *(const LAS u32x4*)(AG + st * HD + 16 * scg), y1 = *(const LAS u32x4*)(AG + st * HD + 16 * scg + 8);
            bf16_t* yp = C.Y + (size_t)(row0 + st) * DM + n * HD + 16 * scg;
            *(u32x4*)yp = y0; *(u32x4*)(yp + 8) = y1;
            float q = 0.f;
            { const unsigned w[8] = {y0.x, y0.y, y0.z, y0.w, y1.x, y1.y, y1.z, y1.w};
#pragma unroll
              for (int k = 0; k < 8; ++k) { const float a = bflo(w[k]), bq = bfhi(w[k]); q += a * a + bq * bq; } }
            q += __builtin_bit_cast(float, __builtin_amdgcn_update_dpp(0, __builtin_bit_cast(int, q), 0xB1, 0xF, 0xF, true));
            q += __builtin_bit_cast(float, __builtin_amdgcn_update_dpp(0, __builtin_bit_cast(int, q), 0x4E, 0xF, 0xF, true));
            q += __builtin_bit_cast(float, __builtin_amdgcn_update_dpp(0, __builtin_bit_cast(int, q), 0x141, 0xF, 0xF, true));
            if (scg == 0) SS[st] += q;
            __syncthreads();
        }
    }
    if (PASS2 && !(C.pf & 2)) {
        VM_WAIT();
        __syncthreads();
#pragma unroll
        for (int hf = 0; hf < 2; ++hf) {
            u32x4 raw[8];
#pragma unroll
            for (int i = 0; i < 8; ++i) { const int k = tid + 512 * (8 * hf + i), t = k >> 7, cc = k & 127; raw[i] = *(const u32x4*)(C.Y + (size_t)(row0 + t) * DM + 8 * cc); }
#pragma unroll
            for (int i = 0; i < 8; ++i) {
                const int k = tid + 512 * (8 * hf + i), t = k >> 7, cc = k & 127;
                const float rstd = rsqrtf(SS[t] * (1.f / DA) + LN_EPS);
                const LAS float* gp = (const LAS float*)(lds + LR_GM) + 8 * cc;
                const f32x4 ga = *(const LAS f32x4*)gp, gb = *(const LAS f32x4*)(gp + 4);
                u32x4 o; o.x = pkbf(bflo(raw[i].x) * rstd * ga.x, bfhi(raw[i].x) * rstd * ga.y); o.y = pkbf(bflo(raw[i].y) * rstd * ga.z, bfhi(raw[i].y) * rstd * ga.w);
                o.z = pkbf(bflo(raw[i].z) * rstd * gb.x, bfhi(raw[i].z) * rstd * gb.y); o.w = pkbf(bflo(raw[i].w) * rstd * gb.z, bfhi(raw[i].w) * rstd * gb.w);
                *(u32x4*)(C.Y + (size_t)(row0 + t) * DM + 8 * cc) = o;
            }
        }
        __syncthreads();
    }
    if constexpr (PASS2) {
        if (C.OB) {
#pragma unroll
            for (int which = 0; which < 2; ++which) {
                int st = st_, scg = scg_; asm volatile("" : "+v"(st), "+v"(scg));
                const bf16_t* src = (which ? C.OC : C.OB) + (size_t)(row0 + st) * DB + 64 * scg;
                f32x4 v[16]; float q = 0.f;
#pragma unroll
                for (int k = 0; k < 8; ++k) { const u32x4 w = *(const u32x4*)(src + 8 * k);
                    v[2 * k] = (f32x4){bflo(w.x), bfhi(w.x), bflo(w.y), bfhi(w.y)}; v[2 * k + 1] = (f32x4){bflo(w.z), bfhi(w.z), bflo(w.w), bfhi(w.w)}; }
#pragma unroll
                for (int k = 0; k < 16; ++k) q += (v[k].x * v[k].x + v[k].y * v[k].y) + (v[k].z * v[k].z + v[k].w * v[k].w);
                q += __builtin_bit_cast(float, __builtin_amdgcn_update_dpp(0, __builtin_bit_cast(int, q), 0xB1, 0xF, 0xF, true));
                q += __builtin_bit_cast(float, __builtin_amdgcn_update_dpp(0, __builtin_bit_cast(int, q), 0x4E, 0xF, 0xF, true));
                q += __builtin_bit_cast(float, __builtin_amdgcn_update_dpp(0, __builtin_bit_cast(int, q), 0x141, 0xF, 0xF, true));
                const float rstd = rsqrtf(q * (1.f / DB) + LN_EPS);
                const float* gp = C.gm + DA + which * DB + 64 * scg;
                bf16_t* yp = C.Y + (size_t)(row0 + st) * DM + DA + which * DB + 64 * scg;
#pragma unroll
                for (int k = 0; k < 8; ++k) {
                    const f32x4 ga = *(const f32x4*)(gp + 8 * k), gb = *(const f32x4*)(gp + 8 * k + 4);
                    const f32x4 a = v[2 * k] * rstd * ga, bq = v[2 * k + 1] * rstd * gb;
                    u32x4 o; o.x = pkbf(a.x, a.y); o.y = pkbf(a.z, a.w); o.z = pkbf(bq.x, bq.y); o.w = pkbf(bq.z, bq.w);
                    *(u32x4*)(yp + 8 * k) = o;
                }
            }
        }
    }
}

constexpr int L2_YT = 0, L2_QS = 131072, L2_H0 = 139264, L2_SS = 143360, L2_END = 143616;
static_assert(L2_END <= RING_BYTES, "lru pass-2 LDS map");
__device__ __forceinline__ void lru_pass2_stream(LAS unsigned char* lds, const LruCtx& C, int chunk) {
    int tid_ = threadIdx.x; asm volatile("" : "+v"(tid_));
    const int tid = tid_;
    const int b = chunk >> 6, c = chunk & 63, row0 = b * SEQ + 64 * c;
    LAS bf16_t* YT = (LAS bf16_t*)(lds + L2_YT); LAS float* QS = (LAS float*)(lds + L2_QS); LAS float* H0 = (LAS float*)(lds + L2_H0);
    const int ch = tid & 127, q = tid >> 7;
    float av[16], uv[16], gv[16];
#define L2_LOAD(n_) do { const size_t e0 = (size_t)(row0 + 16 * q) * DA + (n_) * HD + ch; const bf16_t* gp = C.H + (size_t)(row0 + 16 * q) * HP + C_AG + (n_) * HD + ch; \
        _Pragma("unroll") for (int i = 0; i < 16; ++i) { av[i] = C.AG_[e0 + (size_t)i * DA]; uv[i] = bf2f(C.UG_[e0 + (size_t)i * DA]); gv[i] = bf2f(gp[(size_t)i * HP]); } } while (0)
    L2_LOAD(0);
#pragma unroll
    for (int i = 0; i < 2; ++i) {
        const int cc = tid + 512 * i; float h = 0.f; const float* sa = C.SA + (size_t)b * 64 * DA + cc; const float* sh = C.SH + (size_t)b * 64 * DA + cc;
        for (int j0 = 0; j0 < c; j0 += 16) {
            float fa[16], fh[16];
#pragma unroll
            for (int k = 0; k < 16; ++k) { fa[k] = sa[(size_t)(j0 + k) * DA]; fh[k] = sh[(size_t)(j0 + k) * DA]; }
#pragma unroll
            for (int k = 0; k < 16; ++k) if (j0 + k < c) h = fa[k] * h + fh[k];
        }
        H0[cc] = h;
    }
    for (int n = 0; n < 8; ++n) {
        float ra = 1.f, rh = 0.f;
#pragma unroll
        for (int i = 0; i < 16; ++i) { rh = av[i] * rh + uv[i]; ra *= av[i]; }
        LAS float* qs = QS + (n & 1) * 1024;
        qs[(q * HD + ch) * 2] = ra; qs[(q * HD + ch) * 2 + 1] = rh;
        __syncthreads();
        float h = H0[n * HD + ch];
        for (int qq = 0; qq < q; ++qq) h = qs[(qq * HD + ch) * 2] * h + qs[(qq * HD + ch) * 2 + 1];
        LAS bf16_t* yp = YT + (16 * q) * DA + n * HD + ch;
#pragma unroll
        for (int i = 0; i < 16; ++i) { h = av[i] * h + uv[i]; yp[i * DA] = f2bf(h * fast_gelu_tanh(gv[i])); }
        if (q == 3 && c == 63) C.out[O_PLRU + (size_t)(C.l * NB_P + b) * DA + n * HD + ch] = h;
        if (n + 1 < 8) L2_LOAD(n + 1);
    }
#undef L2_LOAD
    __syncthreads();
    {
        const int st = tid >> 3, scg = tid & 7;
        const LAS bf16_t* rp = YT + st * DA + 128 * scg;
        u32x4 w[16]; float s2 = 0.f;
#pragma unroll
        for (int k = 0; k < 16; ++k) { w[k] = *(const LAS u32x4*)(rp + 8 * ((k + scg + 2 * st) & 15));
            const unsigned ww[4] = {w[k].x, w[k].y, w[k].z, w[k].w};
#pragma unroll
            for (int e = 0; e < 4; ++e) { const float a = bflo(ww[e]), bq = bfhi(ww[e]); s2 += a * a + bq * bq; } }
        s2 += __builtin_bit_cast(float, __builtin_amdgcn_update_dpp(0, __builtin_bit_cast(int, s2), 0xB1, 0xF, 0xF, true));
        s2 += __builtin_bit_cast(float, __builtin_amdgcn_update_dpp(0, __builtin_bit_cast(int, s2), 0x4E, 0xF, 0xF, true));
        s2 += __builtin_bit_cast(float, __builtin_amdgcn_update_dpp(0, __builtin_bit_cast(int, s2), 0x141, 0xF, 0xF, true));
        const float rstd = rsqrtf(s2 * (1.f / DA) + LN_EPS);
        const float* gp = C.gm + 128 * scg;
        bf16_t* yo = C.Y + (size_t)(row0 + st) * DM + 128 * scg;
#pragma unroll
        for (int k = 0; k < 16; ++k) {
            const int kk = (k + scg + 2 * st) & 15;
            const f32x4 ga = *(const f32x4*)(gp + 8 * kk), gb = *(const f32x4*)(gp + 8 * kk + 4);
            u32x4 o; o.x = pkbf(bflo(w[k].x) * rstd * ga.x, bfhi(w[k].x) * rstd * ga.y); o.y = pkbf(bflo(w[k].y) * rstd * ga.z, bfhi(w[k].y) * rstd * ga.w);
            o.z = pkbf(bflo(w[k].z) * rstd * gb.x, bfhi(w[k].z) * rstd * gb.y); o.w = pkbf(bflo(w[k].w) * rstd * gb.z, bfhi(w[k].w) * rstd * gb.w);
            *(u32x4*)(yo + 8 * kk) = o;
        }
    }
    __syncthreads();
}

constexpr int W2_XCB = 0  , W2_AG = 32768  , W2_SS = 65536, W2_H0 = 65792,
              W2_CW = 69888  , W2_GC = 90368  , W2_GM = 102656  , W2_AP = 106752  , W2_END = 139520;
static_assert(W2_END <= RING_BYTES, "lru strip LDS map");

template <bool PASS2, bool AB = false>
__device__ __forceinline__ void lru_item2(LAS unsigned char* lds, const LruCtx& C, int chunk) {
    int tid_ = threadIdx.x; asm volatile("" : "+v"(tid_));
    const int tid = tid_, lane = tid & 63, wave = __builtin_amdgcn_readfirstlane(tid >> 6);
    const bool prm = chunk < 256; const int b = prm ? (chunk >> 6) : (chunk - 256), c = prm ? (chunk & 63) : 0;
    const int row0 = prm ? b * SEQ + 64 * c : TP + b * TS;
    LAS float* SS = (LAS float*)(lds + W2_SS); LAS float* H0 = (LAS float*)(lds + W2_H0); LAS float* CW = (LAS float*)(lds + W2_CW); LAS float* GC = (LAS float*)(lds + W2_GC);
    const int st_ = tid >> 3, scg_ = tid & 7;
#pragma unroll
    for (int i = 0; i < 2; ++i) {
        const int ch = tid + 512 * i;
        CW[ch] = C.bconv[ch];
#pragma unroll
        for (int j = 0; j < 4; ++j) CW[(1 + j) * DA + ch] = C.wconv[(size_t)j * DA + ch];
        GC[ch] = C.bra[ch]; GC[DA + ch] = C.brx[ch]; GC[2 * DA + ch] = log1pf(expf(-C.lam[ch]));
        if constexpr (PASS2) ((LAS float*)(lds + W2_GM))[ch] = C.gm[ch];
    }
    if constexpr (PASS2) {
#pragma unroll
        for (int i = 0; i < 2; ++i) {
            const int ch = tid + 512 * i; float h;
            if (prm) { h = 0.f; const float* sa = C.SA + (size_t)b * 64 * DA + ch; const float* sh = C.SH + (size_t)b * 64 * DA + ch;
                for (int j0 = 0; j0 < c; j0 += 16) {
                    float av[16], hv[16];
#pragma unroll
                    for (int k = 0; k < 16; ++k) { av[k] = sa[(size_t)(j0 + k) * DA]; hv[k] = sh[(size_t)(j0 + k) * DA]; }
#pragma unroll
                    for (int k = 0; k < 16; ++k) if (j0 + k < c) h = av[k] * h + hv[k];
                } }
            else h = C.slru[(size_t)b * DA + ch];
            H0[ch] = h;
        }
        if (tid < 64) SS[tid] = 0.f;
    }
    __syncthreads();
    for (int rd = 0; rd < 4; ++rd) {
#pragma unroll
        for (int nb = 0; nb < 2; ++nb) {
            int st = st_, scg = scg_; asm volatile("" : "+v"(st), "+v"(scg));
            const int n = 2 * rd + nb, col = n * HD + 16 * scg;
            f32x4 acc[4];
#pragma unroll
            for (int k = 0; k < 4; ++k) acc[k] = *(const LAS f32x4*)(CW + col + 4 * k);
#pragma unroll
            for (int j = 0; j < 4; ++j) {
                const int tt = st + j - 3, tpos = (prm ? 64 * c : 0) + tt;
                f32x4 x[4];
                if (tpos >= 0) {
                    const bf16_t* hp = C.H + (size_t)(row0 + tt) * HP + C_AX + col;
                    const u32x4 r0 = *(const u32x4*)hp, r1 = *(const u32x4*)(hp + 8);
                    x[0] = (f32x4){bflo(r0.x), bfhi(r0.x), bflo(r0.y), bfhi(r0.y)}; x[1] = (f32x4){bflo(r0.z), bfhi(r0.z), bflo(r0.w), bfhi(r0.w)};
                    x[2] = (f32x4){bflo(r1.x), bfhi(r1.x), bflo(r1.y), bfhi(r1.y)}; x[3] = (f32x4){bflo(r1.z), bfhi(r1.z), bflo(r1.w), bfhi(r1.w)};
                } else if (!prm) {
                    const float* sp = C.sconv + ((size_t)b * 3 + (tpos + 3)) * DA + col;
#pragma unroll
                    for (int k = 0; k < 4; ++k) x[k] = *(const f32x4*)(sp + 4 * k);
                } else {
#pragma unroll
                    for (int k = 0; k < 4; ++k) x[k] = (f32x4){0.f, 0.f, 0.f, 0.f};
                }
#pragma unroll
                for (int k = 0; k < 4; ++k) { const f32x4 w = *(const LAS f32x4*)(CW + (1 + j) * DA + col + 4 * k); acc[k] += w * x[k]; }
            }
            u32x4 w0, w1;
            w0.x = pkbf(acc[0].x, acc[0].y); w0.y = pkbf(acc[0].z, acc[0].w); w0.z = pkbf(acc[1].x, acc[1].y); w0.w = pkbf(acc[1].z, acc[1].w);
            w1.x = pkbf(acc[2].x, acc[2].y); w1.y = pkbf(acc[2].z, acc[2].w); w1.z = pkbf(acc[3].x, acc[3].y); w1.w = pkbf(acc[3].z, acc[3].w);
            LAS unsigned char* XCB = lds + W2_XCB + nb * 16384;
            *(LAS u32x4*)(XCB + off_b(st, 2 * scg)) = w0; *(LAS u32x4*)(XCB + off_b(st, 2 * scg + 1)) = w1;
            { LAS unsigned char* XP = lds + W2_AP + nb * 16384 + st * 256 + 32 * scg; *(LAS u32x4*)XP = w0; *(LAS u32x4*)(XP + 16) = w1; }
            if constexpr (PASS2 || AB) {
                const bf16_t* gp = C.H + (size_t)(row0 + st) * HP + C_AG + col;
                LAS bf16_t* AG = (LAS bf16_t*)(lds + W2_AG + nb * 16384);
                *(LAS u32x4*)(AG + st * HD + 16 * scg) = *(const u32x4*)gp; *(LAS u32x4*)(AG + st * HD + 16 * scg + 8) = *(const u32x4*)(gp + 8);
            }
        }
        {
            int ln = lane; asm volatile("" : "+v"(ln));
            const int lq = ln & 31, lh = ln >> 5;
            const int nb = wave >> 2, ct = wave & 3, n = 2 * rd + nb, ch = 32 * ct + lq, gch = n * HD + ch;
            u32x4 wq0[8], wq1[8];
            { const bf16_t* b0p = C.WgT + ((size_t)(0 * 8 + n) * HD + ch) * HD + 8 * lh; const bf16_t* b1p = C.WgT + ((size_t)(1 * 8 + n) * HD + ch) * HD + 8 * lh;
#pragma unroll
              for (int s = 0; s < 8; ++s) { wq0[s] = *(const u32x4*)(b0p + 16 * s); wq1[s] = *(const u32x4*)(b1p + 16 * s); } }
            __syncthreads();
            const LAS unsigned char* XCB = lds + W2_XCB + nb * 16384;
            f32x16 g[2][2];
#pragma unroll
            for (int r = 0; r < 16; ++r) { g[0][0][r] = 0.f; g[0][1][r] = 0.f; g[1][0][r] = 0.f; g[1][1][r] = 0.f; }
#pragma unroll
            for (int s = 0; s < 8; ++s) {
                const bf16x8 w0 = __builtin_bit_cast(bf16x8, wq0[s]), w1 = __builtin_bit_cast(bf16x8, wq1[s]);
                const bf16x8 a0 = *(const LAS bf16x8*)(XCB + off_b(lq, 2 * s + lh)), a1 = *(const LAS bf16x8*)(XCB + off_b(32 + lq, 2 * s + lh));
                g[0][0] = MFMA32(a0, w0, g[0][0]); g[1][0] = MFMA32(a0, w1, g[1][0]); g[0][1] = MFMA32(a1, w0, g[0][1]); g[1][1] = MFMA32(a1, w1, g[1][1]);
            }
            const float bra = GC[gch], brx = GC[DA + gch], sp = GC[2 * DA + gch];
            {
                constexpr float L2E = 1.4426950408889634f;
                const LAS unsigned char* XPL = lds + W2_AP + nb * 16384;
                const float nb0 = -L2E * bra, nb1 = -L2E * brx, ka = -8.0f * L2E * sp, kx = -16.0f * sp;
#pragma unroll
                for (int rt = 0; rt < 2; ++rt)
#pragma unroll
                    for (int rp = 0; rp < 8; ++rp) {
                        const int r = 2 * rp, t = 32 * rt + 8 * (r >> 2) + 4 * lh + (r & 3);
                        const f32x2 e0 = (f32x2){g[0][rt][r], g[0][rt][r + 1]} * -L2E + nb0, e1 = (f32x2){g[1][rt][r], g[1][rt][r + 1]} * -L2E + nb1;
                        const f32x2 d0 = (f32x2){__builtin_amdgcn_exp2f(e0.x), __builtin_amdgcn_exp2f(e0.y)} + 1.f, d1 = (f32x2){__builtin_amdgcn_exp2f(e1.x), __builtin_amdgcn_exp2f(e1.y)} + 1.f;
                        const f32x2 rg = {__builtin_amdgcn_rcpf(d0.x), __builtin_amdgcn_rcpf(d0.y)}, ig = {__builtin_amdgcn_rcpf(d1.x), __builtin_amdgcn_rcpf(d1.y)};
                        const f32x2 la = rg * ka;
                        const f32x2 a = {__builtin_amdgcn_exp2f(la.x), __builtin_amdgcn_exp2f(la.y)};
                        const f32x2 x = rg * kx;
                        const f32x2 big = 1.f - a * a;
                        const f32x2 sm = -x * (1.f + x * (0.5f + x * (0.16666667f + x * (0.041666668f + x * 0.0083333338f))));
                        const f32x2 om = {(x.x > -0.25f) ? sm.x : big.x, (x.y > -0.25f) ? sm.y : big.y};
                        f32x2 mult = {__builtin_amdgcn_sqrtf(om.x), __builtin_amdgcn_sqrtf(om.y)};
                        if (prm && c == 0 && t == 0) mult.x = 1.0f;
                        const f32x2 xc = {bf2f(*(const LAS bf16_t*)(XPL + t * 256 + 2 * ch)), bf2f(*(const LAS bf16_t*)(XPL + (t + 1) * 256 + 2 * ch))};
                        const f32x2 u = mult * (ig * xc);
                        g[0][rt][r] = a.x; g[0][rt][r + 1] = a.y; g[1][rt][r] = u.x; g[1][rt][r + 1] = u.y;
                    }
            }
            float sa[8], sh[8];
#pragma unroll
            for (int k = 0; k < 8; ++k) {
                float A = 1.f, Hh = 0.f;
#pragma unroll
                for (int i = 0; i < 4; ++i) { const float a = g[0][k >> 2][4 * (k & 3) + i], u = g[1][k >> 2][4 * (k & 3) + i]; Hh = a * Hh + u; A *= a; }
                sa[k] = A; sh[k] = Hh;
            }
            float cin = PASS2 ? H0[gch] : 0.f;
            float ck[8];
            float cA = 1.f, pk[8];
#pragma unroll
            for (int k = 0; k < 8; ++k) {
                const float pa = xshfl32(sa[k], ln), ph = xshfl32(sh[k], ln);
                const float a_even = lh ? pa : sa[k], h_even = lh ? ph : sh[k], a_odd = lh ? sa[k] : pa, h_odd = lh ? sh[k] : ph;
                const float c_even = cin, c_odd = a_even * cin + h_even;
                ck[k] = lh ? c_odd : c_even;
                cin = a_odd * c_odd + h_odd;
                if constexpr (AB) { const float q_odd = a_even * cA; pk[k] = lh ? q_odd : cA; cA = a_odd * q_odd; }
            }
            if constexpr (!PASS2) {
                float atot = 1.f;
                if constexpr (AB) atot = cA;
                else {
#pragma unroll
                    for (int k = 0; k < 8; ++k) atot *= sa[k];
                    atot *= xshfl32(atot, ln);
                }
                if (lh == 0) { C.SA[((size_t)b * 64 + c) * DA + gch] = atot; C.SH[((size_t)b * 64 + c) * DA + gch] = cin; }
                if constexpr (AB) {
                    LAS bf16_t* AG = (LAS bf16_t*)(lds + W2_AG + nb * 16384); LAS bf16_t* AP = (LAS bf16_t*)(lds + W2_AP + nb * 16384);
#pragma unroll
                    for (int k = 0; k < 8; ++k) {
                        float h = ck[k], p = pk[k];
#pragma unroll
                        for (int i = 0; i < 4; ++i) {
                            const int r = 4 * (k & 3) + i, rt = k >> 2, t = 32 * rt + 8 * (k & 3) + 4 * lh + i;
                            h = g[0][rt][r] * h + g[1][rt][r]; p *= g[0][rt][r];
                            LAS bf16_t* yp = AG + t * HD + ch;
                            const float gl = fast_gelu_tanh2(bf2f(*yp));
                            const unsigned w2 = pkbf(h * gl, p * gl);
                            *yp = (bf16_t)w2; AP[t * HD + ch] = (bf16_t)(w2 >> 16);
                        }
                    }
                }
            } else {
                LAS bf16_t* AG = (LAS bf16_t*)(lds + W2_AG + nb * 16384);
#pragma unroll
                for (int k = 0; k < 8; ++k) {
                    float h = ck[k];
#pragma unroll
                    for (int i = 0; i < 4; ++i) {
                        const int r = 4 * (k & 3) + i, rt = k >> 2, t = 32 * rt + 8 * (k & 3) + 4 * lh + i;
                        h = g[0][rt][r] * h + g[1][rt][r];
                        LAS bf16_t* yp = AG + t * HD + ch;
                        *yp = (bf16_t)pkbf(h * fast_gelu_tanh2(bf2f(*yp)), 0.f);
                    }
                }
                if (lh == 1 && (!prm || c == 63)) { if (prm) C.out[O_PLRU + (size_t)(C.l * NB_P + b) * DA + gch] = cin; else C.out[O_SLRU + (size_t)(C.l * NB_S + b) * DA + gch] = cin; }
            }
        }
        __syncthreads();
        if constexpr (AB) {
            int st = st_, scg = scg_; asm volatile("" : "+v"(st), "+v"(scg));
#pragma unroll
            for (int nb = 0; nb < 2; ++nb) {
                const LAS bf16_t* AG = (const LAS bf16_t*)(lds + W2_AG + nb * 16384); const LAS bf16_t* AP = (const LAS bf16_t*)(lds + W2_AP + nb * 16384);
                const u32x4 y0 = *(const LAS u32x4*)(AG + st * HD + 16 * scg), y1 = *(const LAS u32x4*)(AG + st * HD + 16 * scg + 8);
                const u32x4 p0 = *(const LAS u32x4*)(AP + st * HD + 16 * scg), p1 = *(const LAS u32x4*)(AP + st * HD + 16 * scg + 8);
                const size_t o = (size_t)(row0 + st) * DA + (2 * rd + nb) * HD + 16 * scg;
                bf16_t* bp = C.UG_ + o; bf16_t* ap = bp - (WS_UU - WS_AA) / 2;
                *(u32x4*)bp = y0; *(u32x4*)(bp + 8) = y1; *(u32x4*)ap = p0; *(u32x4*)(ap + 8) = p1;
            }
            __syncthreads();
        }
        if constexpr (PASS2) {
            int st = st_, scg = scg_; asm volatile("" : "+v"(st), "+v"(scg));
            float q = 0.f;
#pragma unroll
            for (int nb = 0; nb < 2; ++nb) {
                const LAS bf16_t* AG = (const LAS bf16_t*)(lds + W2_AG + nb * 16384);
                const u32x4 y0 = *(const LAS u32x4*)(AG + st * HD + 16 * scg), y1 = *(const LAS u32x4*)(AG + st * HD + 16 * scg + 8);
                bf16_t* yp = C.Y + (size_t)(row0 + st) * DM + (2 * rd + nb) * HD + 16 * scg;
                *(u32x4*)yp = y0; *(u32x4*)(yp + 8) = y1;
                const unsigned w[8] = {y0.x, y0.y, y0.z, y0.w, y1.x, y1.y, y1.z, y1.w};
#pragma unroll
                for (int k = 0; k < 8; ++k) { const float a = bflo(w[k]), bq = bfhi(w[k]); q += a * a + bq * bq; }
            }
            q += __builtin_bit_cast(float, __builtin_amdgcn_update_dpp(0, __builtin_bit_cast(int, q), 0xB1, 0xF, 0xF, true));
            q += __builtin_bit_cast(float, __builtin_amdgcn_update_dpp(0, __builtin_bit_cast(int, q), 0x4E, 0xF, 0xF, true));
            q += __builtin_bit_cast(float, __builtin_amdgcn_update_dpp(0, __builtin_bit_cast(int, q), 0x141, 0xF, 0xF, true));
            if (scg == 0) SS[st] += q;
            __syncthreads();
        }
    }
    if constexpr (PASS2) {
        VM_WAIT();
        __syncthreads();
#pragma unroll
        for (int hf = 0; hf < 2; ++hf) {
            u32x4 raw[8];
#pragma unroll
            for (int i = 0; i < 8; ++i) { const int k = tid + 512 * (8 * hf + i), t = k >> 7, cc = k & 127; raw[i] = *(const u32x4*)(C.Y + (size_t)(row0 + t) * DM + 8 * cc); }
#pragma unroll
            for (int i = 0; i < 8; ++i) {
                const int k = tid + 512 * (8 * hf + i), t = k >> 7, cc = k & 127;
                const float rstd = rsqrtf(SS[t] * (1.f / DA) + LN_EPS);
                const LAS float* gp = (const LAS float*)(lds + W2_GM) + 8 * cc;
                const f32x4 ga = *(const LAS f32x4*)gp, gb = *(const LAS f32x4*)(gp + 4);
                u32x4 o; o.x = pkbf(bflo(raw[i].x) * rstd * ga.x, bfhi(raw[i].x) * rstd * ga.y); o.y = pkbf(bflo(raw[i].y) * rstd * ga.z, bfhi(raw[i].y) * rstd * ga.w);
                o.z = pkbf(bflo(raw[i].z) * rstd * gb.x, bfhi(raw[i].z) * rstd * gb.y); o.w = pkbf(bflo(raw[i].w) * rstd * gb.z, bfhi(raw[i].w) * rstd * gb.w);
                *(u32x4*)(C.Y + (size_t)(row0 + t) * DM + 8 * cc) = o;
            }
        }
        if (C.OB) {
#pragma unroll
            for (int which = 0; which < 2; ++which) {
                int st = st_, scg = scg_; asm volatile("" : "+v"(st), "+v"(scg));
                const bf16_t* src = (which ? C.OC : C.OB) + (size_t)(row0 + st) * DB + 64 * scg;
                f32x4 v[16]; float q = 0.f;
#pragma unroll
                for (int k = 0; k < 8; ++k) { const u32x4 w = *(const u32x4*)(src + 8 * k);
                    v[2 * k] = (f32x4){bflo(w.x), bfhi(w.x), bflo(w.y), bfhi(w.y)}; v[2 * k + 1] = (f32x4){bflo(w.z), bfhi(w.z), bflo(w.w), bfhi(w.w)}; }
#pragma unroll
                for (int k = 0; k < 16; ++k) q += (v[k].x * v[k].x + v[k].y * v[k].y) + (v[k].z * v[k].z + v[k].w * v[k].w);
                q += __builtin_bit_cast(float, __builtin_amdgcn_update_dpp(0, __builtin_bit_cast(int, q), 0xB1, 0xF, 0xF, true));
                q += __builtin_bit_cast(float, __builtin_amdgcn_update_dpp(0, __builtin_bit_cast(int, q), 0x4E, 0xF, 0xF, true));
                q += __builtin_bit_cast(float, __builtin_amdgcn_update_dpp(0, __builtin_bit_cast(int, q), 0x141, 0xF, 0xF, true));
                const float rstd = rsqrtf(q * (1.f / DB) + LN_EPS);
                const float* gp = C.gm + DA + which * DB + 64 * scg;
                bf16_t* yp = C.Y + (size_t)(row0 + st) * DM + DA + which * DB + 64 * scg;
#pragma unroll
                for (int k = 0; k < 8; ++k) {
                    const f32x4 ga = *(const f32x4*)(gp + 8 * k), gb = *(const f32x4*)(gp + 8 * k + 4);
                    const f32x4 a = v[2 * k] * rstd * ga, bq = v[2 * k + 1] * rstd * gb;
                    u32x4 o; o.x = pkbf(a.x, a.y); o.y = pkbf(a.z, a.w); o.z = pkbf(bq.x, bq.y); o.w = pkbf(bq.z, bq.w);
                    *(u32x4*)(yp + 8 * k) = o;
                }
            }
        }
    }
    __syncthreads();
}

__device__ __forceinline__ void lru_fin(LAS unsigned char* lds, const LruCtx& C, int chunk) {
    int tid_ = threadIdx.x; asm volatile("" : "+v"(tid_));
    const int tid = tid_;
    const int b = chunk >> 6, c = chunk & 63, row0 = b * SEQ + 64 * c;
    LAS float* H0 = (LAS float*)(lds + W2_H0); LAS float* GM = (LAS float*)(lds + W2_GM);
    int st = tid >> 3, scg = tid & 7; asm volatile("" : "+v"(st), "+v"(scg));
    const bf16_t* bp = C.UG_ + (size_t)(row0 + st) * DA + 8 * scg;
    const bf16_t* ap = bp - (WS_UU - WS_AA) / 2;
    u32x4 av[8], bv[8];
#pragma unroll
    for (int i = 0; i < 8; ++i) { av[i] = *(const u32x4*)(ap + 64 * i); bv[i] = *(const u32x4*)(bp + 64 * i); }
    {
        float h0 = 0.f, h1 = 0.f;
        const float* sa = C.SA + (size_t)b * 64 * DA + tid; const float* sh = C.SH + (size_t)b * 64 * DA + tid;
        for (int j0 = 0; j0 < c; j0 += 16) {
            float a0[16], s0[16], a1[16], s1[16];
#pragma unroll
            for (int k = 0; k < 16; ++k) { a0[k] = sa[(size_t)(j0 + k) * DA]; s0[k] = sh[(size_t)(j0 + k) * DA]; a1[k] = sa[(size_t)(j0 + k) * DA + 512]; s1[k] = sh[(size_t)(j0 + k) * DA + 512]; }
#pragma unroll
            for (int k = 0; k < 16; ++k) if (j0 + k < c) { h0 = a0[k] * h0 + s0[k]; h1 = a1[k] * h1 + s1[k]; }
        }
        H0[tid] = h0; H0[tid + 512] = h1; GM[tid] = C.gm[tid]; GM[tid + 512] = C.gm[tid + 512];
        if (c == 63) { float* op = C.out + O_PLRU + (size_t)(C.l * NB_P + b) * DA + tid;
                       op[0] = sa[(size_t)63 * DA] * h0 + sh[(size_t)63 * DA]; op[512] = sa[(size_t)63 * DA + 512] * h1 + sh[(size_t)63 * DA + 512]; }
    }
    __syncthreads();
    {
        u32x4 y[16]; float q = 0.f;
#pragma unroll
        for (int kb = 0; kb < 2; ++kb) {
            if (kb == 1) {
#pragma unroll
                for (int i = 0; i < 8; ++i) { av[i] = *(const u32x4*)(ap + 64 * (8 + i)); bv[i] = *(const u32x4*)(bp + 64 * (8 + i)); }
            }
#pragma unroll
            for (int i = 0; i < 8; ++i) {
                const LAS float* hp = H0 + 8 * scg + 64 * (8 * kb + i);
                const f32x4 h0 = *(const LAS f32x4*)hp, h1 = *(const LAS f32x4*)(hp + 4);
                const float r0 = bflo(bv[i].x) + bflo(av[i].x) * h0.x, r1 = bfhi(bv[i].x) + bfhi(av[i].x) * h0.y, r2 = bflo(bv[i].y) + bflo(av[i].y) * h0.z, r3 = bfhi(bv[i].y) + bfhi(av[i].y) * h0.w;
                const float r4 = bflo(bv[i].z) + bflo(av[i].z) * h1.x, r5 = bfhi(bv[i].z) + bfhi(av[i].z) * h1.y, r6 = bflo(bv[i].w) + bflo(av[i].w) * h1.z, r7 = bfhi(bv[i].w) + bfhi(av[i].w) * h1.w;
                q += (r0 * r0 + r1 * r1) + (r2 * r2 + r3 * r3) + (r4 * r4 + r5 * r5) + (r6 * r6 + r7 * r7);
                u32x4 o; o.x = pkbf(r0, r1); o.y = pkbf(r2, r3); o.z = pkbf(r4, r5); o.w = pkbf(r6, r7);
                y[8 * kb + i] = o;
            }
            __builtin_amdgcn_sched_barrier(0);
        }
        q += __builtin_bit_cast(float, __builtin_amdgcn_update_dpp(0, __builtin_bit_cast(int, q), 0xB1, 0xF, 0xF, true));
        q += __builtin_bit_cast(float, __builtin_amdgcn_update_dpp(0, __builtin_bit_cast(int, q), 0x4E, 0xF, 0xF, true));
        q += __builtin_bit_cast(float, __builtin_amdgcn_update_dpp(0, __builtin_bit_cast(int, q), 0x141, 0xF, 0xF, true));
        const float rstd = rsqrtf(q * (1.f / DA) + LN_EPS);
        bf16_t* yo = C.Y + (size_t)(row0 + st) * DM + 8 * scg;
#pragma unroll
        for (int k = 0; k < 16; ++k) {
            const LAS float* gp = GM + 8 * scg + 64 * k;
            const f32x4 ga = *(const LAS f32x4*)gp, gb = *(const LAS f32x4*)(gp + 4);
            u32x4 o; o.x = pkbf(bflo(y[k].x) * rstd * ga.x, bfhi(y[k].x) * rstd * ga.y); o.y = pkbf(bflo(y[k].y) * rstd * ga.z, bfhi(y[k].y) * rstd * ga.w);
            o.z = pkbf(bflo(y[k].z) * rstd * gb.x, bfhi(y[k].z) * rstd * gb.y); o.w = pkbf(bflo(y[k].w) * rstd * gb.z, bfhi(y[k].w) * rstd * gb.w);
            *(u32x4*)(yo + 64 * k) = o;
            if ((k & 3) == 3) __builtin_amdgcn_sched_barrier(0);
        }
    }
    __builtin_amdgcn_sched_barrier(0);
    if (C.OB) {
#pragma unroll
        for (int which = 0; which < 2; ++which) {
            int st = tid >> 3, scg = tid & 7; asm volatile("" : "+v"(st), "+v"(scg));
            const bf16_t* src = (which ? C.OC : C.OB) + (size_t)(row0 + st) * DB + 64 * scg;
            f32x4 v[16]; float q = 0.f;
#pragma unroll
            for (int k = 0; k < 8; ++k) { const u32x4 w = *(const u32x4*)(src + 8 * k);
                v[2 * k] = (f32x4){bflo(w.x), bfhi(w.x), bflo(w.y), bfhi(w.y)}; v[2 * k + 1] = (f32x4){bflo(w.z), bfhi(w.z), bflo(w.w), bfhi(w.w)}; }
#pragma unroll
            for (int k = 0; k < 16; ++k) q += (v[k].x * v[k].x + v[k].y * v[k].y) + (v[k].z * v[k].z + v[k].w * v[k].w);
            q += __builtin_bit_cast(float, __builtin_amdgcn_update_dpp(0, __builtin_bit_cast(int, q), 0xB1, 0xF, 0xF, true));
            q += __builtin_bit_cast(float, __builtin_amdgcn_update_dpp(0, __builtin_bit_cast(int, q), 0x4E, 0xF, 0xF, true));
            q += __builtin_bit_cast(float, __builtin_amdgcn_update_dpp(0, __builtin_bit_cast(int, q), 0x141, 0xF, 0xF, true));
            const float rstd = rsqrtf(q * (1.f / DB) + LN_EPS);
            const float* gp = C.gm + DA + which * DB + 64 * scg;
            bf16_t* yp = C.Y + (size_t)(row0 + st) * DM + DA + which * DB + 64 * scg;
#pragma unroll
            for (int k = 0; k < 8; ++k) {
                const f32x4 ga = *(const f32x4*)(gp + 8 * k), gb = *(const f32x4*)(gp + 8 * k + 4);
                const f32x4 a = v[2 * k] * rstd * ga, bq = v[2 * k + 1] * rstd * gb;
                u32x4 o; o.x = pkbf(a.x, a.y); o.y = pkbf(a.z, a.w); o.z = pkbf(bq.x, bq.y); o.w = pkbf(bq.z, bq.w);
                *(u32x4*)(yp + 8 * k) = o;
            }
        }
    }
    __syncthreads();
}
constexpr int CW_BAR = 4096;
constexpr int N_MV = 8192;
constexpr int CV_I_IN = (DM / 64) * (DINP / 32), CV_I_OUT = (DM / 64) * (DM / 32), CV_I_UP = (DM / 64) * (DFF / 32), CV_I_DN = (DFF / 64) * (DM / 32), CV_I_G = 16 * 8, CV_I_L = CV_I_IN + CV_I_OUT + CV_I_UP + CV_I_DN + CV_I_G;
constexpr int CV2_A0 = CV_I_IN + N_MV, CV2_AN = CV_I_OUT + CV_I_UP - N_MV + CV_I_DN, CV2_B0 = CV_I_L, CV2_BN = 4096, N_MV2 = CV2_AN + CV2_BN;
static_assert(CV2_A0 + CV2_AN == CV_I_IN + CV_I_OUT + CV_I_UP + CV_I_DN && CV2_BN <= CV_I_IN && CV2_AN % 2048 == 0 && CV2_BN % 2048 == 0, "filler ranges");
constexpr int CW_QUEUE = 65536;
constexpr int CW_LRUCNT = 98304;
constexpr int CW_SPLITK = 131072;
constexpr size_t CTL_ZERO_BYTES = 1 * MiB;
constexpr int NPH = 2 + 8 * DEPTH;

__device__ __forceinline__ unsigned pk2(float lo, float hi) { return pg8::cvt_pk_bf16(lo, hi); }

struct Args { const float* in[27]; float* out; unsigned char* ws; int ph_lo, ph_hi, li, flags; };

__device__ __forceinline__ void tr_item(const float* W, int K, int ld, int ncols, bf16_t* WT, LAS float* scr, int item, int lane) {
    const int nblk = ncols / 32, kb = item / nblk, nb = item % nblk, k0 = 64 * kb, n0 = 32 * nb;
    float wv[32];
#pragma unroll
    for (int i = 0; i < 32; ++i) wv[i] = W[(size_t)(k0 + 2 * i + (lane >> 5)) * ld + n0 + (lane & 31)];
#pragma unroll
    for (int i = 0; i < 32; ++i) scr[(2 * i + (lane >> 5)) * 33 + (lane & 31)] = wv[i];
    LDS_WAIT(); asm volatile("" ::: "memory");
    const int c = lane & 7;
#pragma unroll
    for (int j = 0; j < 4; ++j) { const int n = (lane >> 3) + 8 * j; const LAS float* s = scr + (8 * c) * 33 + n;
        u32x4 o; o.x = pk2(s[0 * 33], s[1 * 33]); o.y = pk2(s[2 * 33], s[3 * 33]); o.z = pk2(s[4 * 33], s[5 * 33]); o.w = pk2(s[6 * 33], s[7 * 33]);
        *(u32x4*)(WT + (size_t)(n0 + n) * K + k0 + 8 * c) = o; }
    LDS_WAIT(); asm volatile("" ::: "memory");
}
__device__ __forceinline__ void conv_item(int it, const float* w_in, const float* w_out, const float* w_up, const float* w_dn, const float* w_ra, const float* w_rx,
                                          bf16_t* WinT, bf16_t* WoutT, bf16_t* WupT, bf16_t* WdnT, bf16_t* WgT, LAS float* scr, int lane) {
    const int l = it / CV_I_L; int r = it % CV_I_L;
    if (r < CV_I_IN) { tr_item(w_in + (size_t)l * DM * DIN, DM, DIN, DINP, WinT + (size_t)l * DINP * DM, scr, r, lane); return; } r -= CV_I_IN;
    if (r < CV_I_OUT) { tr_item(w_out + (size_t)l * DM * DM, DM, DM, DM, WoutT + (size_t)l * DM * DM, scr, r, lane); return; } r -= CV_I_OUT;
    if (r < CV_I_UP) { tr_item(w_up + (size_t)l * DM * DFF, DM, DFF, DFF, WupT + (size_t)l * DFF * DM, scr, r, lane); return; } r -= CV_I_UP;
    if (r < CV_I_DN) { tr_item(w_dn + (size_t)l * DFF * DM, DFF, DM, DM, WdnT + (size_t)l * DM * DFF, scr, r, lane); return; } r -= CV_I_DN;
    { const int mat = r >> 3, sub = r & 7, gate = mat >> 3, n = mat & 7;
      const float* src = (gate ? w_rx : w_ra) + ((size_t)l * 8 + n) * HD * HD;
      tr_item(src, HD, HD, HD, WgT + (((size_t)l * 2 + gate) * 8 + n) * HD * HD, scr, sub, lane); }
}
__device__ __forceinline__ void logf_store(float d0, float d1, float d2, float d3, const float* bfg, float* out, int l, int row, int lane) {
    d0 = wave_sum(d0); d1 = wave_sum(d1); d2 = wave_sum(d2); d3 = wave_sum(d3);
    if (lane < 4) {
        const float d = lane == 0 ? d0 : lane == 1 ? d1 : lane == 2 ? d2 : d3;
        const float lf = log_sigmoid_f(d + bfg[lane]);
        bool prm; int b, t; row_bt(row, prm, b, t);
        if (prm) out[O_PFL + ((size_t)(l * NB_P + b) * SEQ + t) * NH + lane] = lf;
        else out[O_SFL + ((size_t)(l * NB_S + b) * TS + t) * NH + lane] = lf;
    }
}
template <int NR>
__device__ __forceinline__ void xcvt_rows(const float* x_p, const float* x_s, const float* wf, const float* bfg, bf16_t* xb, float* out, int l, int row0, int rstep, int nvalid, int lane) {
    f32x4 v[NR][8];
#pragma unroll
    for (int r = 0; r < NR; ++r) {
        const float* xr = xrow0(x_p, x_s, (r < nvalid) ? row0 + r * rstep : row0);
#pragma unroll
        for (int j = 0; j < 8; ++j) v[r][j] = ((const f32x4*)xr)[lane + 64 * j];
    }
    float d[NR][4];
#pragma unroll
    for (int r = 0; r < NR; ++r) { d[r][0] = 0.f; d[r][1] = 0.f; d[r][2] = 0.f; d[r][3] = 0.f; }
#pragma unroll
    for (int j = 0; j < 8; ++j) {
        const int c = lane + 64 * j;
        const f32x4 w0 = ((const f32x4*)wf)[c], w1 = ((const f32x4*)(wf + DM))[c], w2 = ((const f32x4*)(wf + 2 * DM))[c], w3 = ((const f32x4*)(wf + 3 * DM))[c];
#pragma unroll
        for (int r = 0; r < NR; ++r) {
            if (r < nvalid) {
                const f32x4 o = v[r][j];
                u32x2 p; p.x = pk2(o.x, o.y); p.y = pk2(o.z, o.w);
                ((u32x2*)(xb + (size_t)(row0 + r * rstep) * DM))[c] = p;
                d[r][0] += o.x * w0.x + o.y * w0.y + o.z * w0.z + o.w * w0.w; d[r][1] += o.x * w1.x + o.y * w1.y + o.z * w1.z + o.w * w1.w;
                d[r][2] += o.x * w2.x + o.y * w2.y + o.z * w2.z + o.w * w2.w; d[r][3] += o.x * w3.x + o.y * w3.y + o.z * w3.z + o.w * w3.w;
            }
        }
    }
#pragma unroll
    for (int r = 0; r < NR; ++r) if (r < nvalid) logf_store(d[r][0], d[r][1], d[r][2], d[r][3], bfg, out, l, row0 + r * rstep, lane);
}
template <int NR>
__device__ __forceinline__ void ln_rows(const bf16_t* z, const float* g, const float* bta, float* xf, bf16_t* xb, const float* wf_next, const float* bfg_next, float* out, int lnext, int row0, int rstep, int nvalid, int lane) {
    u32x4 w[NR][4]; float s[NR];
#pragma unroll
    for (int r = 0; r < NR; ++r) {
        const int row = (r < nvalid) ? row0 + r * rstep : row0;
#pragma unroll
        for (int jj = 0; jj < 4; ++jj) w[r][jj] = ((const u32x4*)(z + (size_t)row * DM))[lane + 64 * jj];
    }
#define LN_V(r, j) ((j & 1) ? (f32x4){bflo(w[r][(j) >> 1].z), bfhi(w[r][(j) >> 1].z), bflo(w[r][(j) >> 1].w), bfhi(w[r][(j) >> 1].w)} : (f32x4){bflo(w[r][(j) >> 1].x), bfhi(w[r][(j) >> 1].x), bflo(w[r][(j) >> 1].y), bfhi(w[r][(j) >> 1].y)})
    float mu[NR], rstd[NR];
#pragma unroll
    for (int r = 0; r < NR; ++r) {
        s[r] = 0.f;
#pragma unroll
        for (int j = 0; j < 8; ++j) { const f32x4 v = LN_V(r, j); s[r] += (v.x + v.y) + (v.z + v.w); }
        mu[r] = wave_sum(s[r]) * (1.f / DM); float q = 0.f;
#pragma unroll
        for (int j = 0; j < 8; ++j) { const f32x4 v = LN_V(r, j) - mu[r]; q += (v.x * v.x + v.y * v.y) + (v.z * v.z + v.w * v.w); }
        rstd[r] = rsqrtf(wave_sum(q) * (1.f / DM) + LN_EPS);
    }
    float d[NR][4];
#pragma unroll
    for (int r = 0; r < NR; ++r) { d[r][0] = 0.f; d[r][1] = 0.f; d[r][2] = 0.f; d[r][3] = 0.f; }
#pragma unroll
    for (int j = 0; j < 8; ++j) {
        const int c = 2 * (lane + 64 * (j >> 1)) + (j & 1);
        const f32x4 gg = ((const f32x4*)g)[c], bb = ((const f32x4*)bta)[c];
        f32x4 w0, w1, w2, w3;
        if (wf_next) { w0 = ((const f32x4*)wf_next)[c]; w1 = ((const f32x4*)(wf_next + DM))[c]; w2 = ((const f32x4*)(wf_next + 2 * DM))[c]; w3 = ((const f32x4*)(wf_next + 3 * DM))[c]; }
#pragma unroll
        for (int r = 0; r < NR; ++r) {
            if (r < nvalid) {
                const int row = row0 + r * rstep;
                const f32x4 o = (LN_V(r, j) - mu[r]) * rstd[r] * gg + bb;
                if (xf) ((f32x4*)(xf + (size_t)row * DM))[c] = o;
                u32x2 p; p.x = pk2(o.x, o.y); p.y = pk2(o.z, o.w);
                if (xb) ((u32x2*)(xb + (size_t)row * DM))[c] = p;
                if (wf_next) { d[r][0] += o.x * w0.x + o.y * w0.y + o.z * w0.z + o.w * w0.w; d[r][1] += o.x * w1.x + o.y * w1.y + o.z * w1.z + o.w * w1.w;
                               d[r][2] += o.x * w2.x + o.y * w2.y + o.z * w2.z + o.w * w2.w; d[r][3] += o.x * w3.x + o.y * w3.y + o.z * w3.z + o.w * w3.w; }
            }
        }
    }
#undef LN_V
    if (wf_next) {
#pragma unroll
        for (int r = 0; r < NR; ++r) if (r < nvalid) logf_store(d[r][0], d[r][1], d[r][2], d[r][3], bfg_next, out, lnext, row0 + r * rstep, lane);
    }
}
__device__ __forceinline__ void mixnorm_row(const float* OA, const bf16_t* OB, const bf16_t* OC, const float* PO, const float* PM, const float* PL, const float* gm, bf16_t* Y, bool with_a, int row, int lane) {
    if (with_a) {
        f32x4 a[4]; float sa = 0.f;
#pragma unroll
        for (int j = 0; j < 4; ++j) { a[j] = ((const f32x4*)(OA + (size_t)row * DA))[lane + 64 * j]; sa += (a[j].x * a[j].x + a[j].y * a[j].y) + (a[j].z * a[j].z + a[j].w * a[j].w); }
        const float ra = rsqrtf(wave_sum(sa) * (1.f / DA) + LN_EPS);
#pragma unroll
        for (int j = 0; j < 4; ++j) { const int c = lane + 64 * j; const f32x4 gg = ((const f32x4*)gm)[c]; const f32x4 o = a[j] * ra * gg;
            u32x2 p; p.x = pk2(o.x, o.y); p.y = pk2(o.z, o.w); ((u32x2*)(Y + (size_t)row * DM))[c] = p; }
    }
    {
        f32x4 b[2]; float sb = 0.f;
        { const u32x4 w = ((const u32x4*)(OB + (size_t)row * DB))[lane]; b[0] = (f32x4){bflo(w.x), bfhi(w.x), bflo(w.y), bfhi(w.y)}; b[1] = (f32x4){bflo(w.z), bfhi(w.z), bflo(w.w), bfhi(w.w)}; }
#pragma unroll
        for (int j = 0; j < 2; ++j) sb += (b[j].x * b[j].x + b[j].y * b[j].y) + (b[j].z * b[j].z + b[j].w * b[j].w);
        const float rb = rsqrtf(wave_sum(sb) * (1.f / DB) + LN_EPS);
#pragma unroll
        for (int j = 0; j < 2; ++j) { const int c = 2 * lane + j; const f32x4 gb = ((const f32x4*)(gm + DA))[c]; const f32x4 ob = b[j] * rb * gb;
            u32x2 p; p.x = pk2(ob.x, ob.y); p.y = pk2(ob.z, ob.w); ((u32x2*)(Y + (size_t)row * DM + DA))[c] = p; }
    }
    if (row < TP) {
        f32x4 cc[2]; float sc = 0.f;
        { const u32x4 w = ((const u32x4*)(OC + (size_t)row * DB))[lane]; cc[0] = (f32x4){bflo(w.x), bfhi(w.x), bflo(w.y), bfhi(w.y)}; cc[1] = (f32x4){bflo(w.z), bfhi(w.z), bflo(w.w), bfhi(w.w)}; }
#pragma unroll
        for (int j = 0; j < 2; ++j) sc += (cc[j].x * cc[j].x + cc[j].y * cc[j].y) + (cc[j].z * cc[j].z + cc[j].w * cc[j].w);
        const float rc = rsqrtf(wave_sum(sc) * (1.f / DB) + LN_EPS);
#pragma unroll
        for (int j = 0; j < 2; ++j) { const int c = 2 * lane + j; const f32x4 gc = ((const f32x4*)(gm + DA + DB))[c]; const f32x4 oc = cc[j] * rc * gc;
            u32x2 q; q.x = pk2(oc.x, oc.y); q.y = pk2(oc.z, oc.w); ((u32x2*)(Y + (size_t)row * DM + DA + DB))[c] = q; }
    } else {
        const int r = row - TP, b = r >> 6, qi = r & 63;
        float cv[NH][2]; float sc = 0.f;
#pragma unroll
        for (int hh = 0; hh < NH; ++hh) {
            const int bh = b * NH + hh;
            float m = -1e30f;
#pragma unroll
            for (int sp = 0; sp < NSPLIT; ++sp) m = fmaxf(m, PM[((size_t)bh * NSPLIT + sp) * TS + qi]);
            float l = 0.f, o0 = 0.f, o1 = 0.f;
#pragma unroll
            for (int sp = 0; sp < NSPLIT; ++sp) {
                const size_t pr = ((size_t)bh * NSPLIT + sp) * TS + qi;
                const float w = __builtin_amdgcn_exp2f(PM[pr] - m);
                l += PL[pr] * w; o0 += PO[pr * HD + lane] * w; o1 += PO[pr * HD + lane + 64] * w;
            }
            const float inv = 1.f / l;
            cv[hh][0] = o0 * inv; cv[hh][1] = o1 * inv; sc += cv[hh][0] * cv[hh][0] + cv[hh][1] * cv[hh][1];
        }
        const float rc = rsqrtf(wave_sum(sc) * (1.f / DB) + LN_EPS);
#pragma unroll
        for (int hh = 0; hh < NH; ++hh) {
            const int c0 = DA + DB + hh * HD + lane;
            Y[(size_t)row * DM + c0] = f2bf(cv[hh][0] * rc * gm[c0]); Y[(size_t)row * DM + c0 + 64] = f2bf(cv[hh][1] * rc * gm[c0 + 64]);
        }
    }
}
__device__ __forceinline__ void cumsum_seq(LAS float* scr, const float* out, const float* cfl_l, float* Fp, float* Fs, int l, int seq, int tid) {
    const int lane = tid & 63, wave = tid >> 6;
    const bool prm = seq < 16; const int bh = prm ? seq : seq - 16, b = bh >> 2, h = bh & 3;
    const int n = prm ? SEQ : PAST + TS, seg = prm ? 8 : 9;
    const int i0 = tid * seg, i1 = min(n, i0 + seg);
    float s = 0.f;
    for (int i = i0; i < i1; ++i) s += logf_get(out, cfl_l, l, prm, b, h, i);
    float v = s;
#pragma unroll
    for (int o = 1; o < 64; o <<= 1) { const float t = __builtin_bit_cast(float, __builtin_amdgcn_ds_bpermute((lane - o) << 2, __builtin_bit_cast(int, v))); if (lane >= o) v += t; }
    __syncthreads();
    if (lane == 63) scr[wave] = v;
    __syncthreads();
    float pre = 0.f;
    for (int w = 0; w < wave; ++w) pre += scr[w];
    float run = pre + v - s;
    float* dst = prm ? Fp + (size_t)bh * SEQ : Fs + (size_t)bh * (PAST + TS);
    for (int i = i0; i < i1; ++i) { run += logf_get(out, cfl_l, l, prm, b, h, i); dst[i] = run; }
}

__global__ void __launch_bounds__(NTHREADS, 2) mk_fwd(Args args) {
    extern __shared__ __attribute__((aligned(16))) unsigned char lds_raw[];
    LAS unsigned char* lds = (LAS unsigned char*)lds_raw;
    volatile LAS unsigned* MISC = (volatile LAS unsigned*)(lds + MISC_OFF);
    const int wave = __builtin_amdgcn_readfirstlane((int)threadIdx.x >> 6);
#define TIDF() ([]() __attribute__((always_inline)) { int t_ = threadIdx.x; asm volatile("" : "+v"(t_)); return t_; }())
#define tid TIDF()
#define lane (TIDF() & 63)
    typedef const __attribute__((address_space(4))) Args* KArgs;
#define KA() ([]() __attribute__((always_inline)) { KArgs a_ = (KArgs)__builtin_amdgcn_kernarg_segment_ptr(); asm volatile("" : "+s"(a_)); return a_; }())
    { unsigned* ctl0 = (unsigned*)(args.ws + WS_CTL);
      for (int u = tid; u < (LDS_BYTES - RING_BYTES) / 4; u += NTHREADS) ((LAS unsigned*)(lds + RING_BYTES))[u] = 0u;
      __syncthreads();
      (void)xcd_barrier_post(ctl0 + CW_BAR + args.li * XCD_BAR_WORDS, MISC + 8); }
#ifdef PROBE_PHASE
#define NB_LRU ((KA()->flags >> 16) & 15 ? ((KA()->flags >> 16) & 15) - 1 : 8)
#define PF_LRU ((KA()->flags >> 21) & 3)
#define ATT_SKIP ((KA()->flags >> 24) & 7)
#else
#define NB_LRU 8
#define PF_LRU 0
#define ATT_SKIP 0
#endif
#define IN(k) (KA()->ph_lo <= (k) && (k) < KA()->ph_hi)
#define SEAM(k) do { if (IN(k) && IN((k) + 1)) { XcdBarrier b_; b_.bar = (unsigned*)(KA()->ws + WS_CTL) + CW_BAR + KA()->li * XCD_BAR_WORDS; b_.x = xb_xcc_id(); b_.st = MISC + 8; xcd_barrier(b_); } } while (0)
#define PHASE_PTRS \
    KArgs A_ = KA(); \
    const int G = gridDim.x, gw = blockIdx.x * NWAVES + wave, NGW = G * NWAVES; unsigned* ctl = (unsigned*)(A_->ws + WS_CTL); (void)G; (void)gw; (void)NGW; (void)ctl; \
    unsigned char* ws = A_->ws; float* out = A_->out; \
    const float *x_p = A_->in[0], *x_s = A_->in[1], *st_conv = A_->in[2], *st_lru = A_->in[3], *c_bk = A_->in[4], *c_bv = A_->in[5], *c_fk = A_->in[6], *c_fv = A_->in[7], *c_fl = A_->in[8], *w_in = A_->in[9]; \
    const float *w_conv = A_->in[10], *b_conv = A_->in[11], *w_ra = A_->in[12], *b_ra = A_->in[13], *w_rx = A_->in[14], *b_rx = A_->in[15], *lam = A_->in[16], *relb = A_->in[17], *bfg = A_->in[18], *gmix = A_->in[19], *w_out = A_->in[20]; \
    const float *ln1g = A_->in[21], *ln1b = A_->in[22], *w_up = A_->in[23], *w_dn = A_->in[24], *ln2g = A_->in[25], *ln2b = A_->in[26]; \
    bf16_t* WinT = (bf16_t*)(ws + WS_WIN); bf16_t* WoutT = (bf16_t*)(ws + WS_WOUT); bf16_t* WupT = (bf16_t*)(ws + WS_WUP); bf16_t* WdnT = (bf16_t*)(ws + WS_WDN); bf16_t* WgT = (bf16_t*)(ws + WS_WG); \
    float* WF = (float*)(ws + WS_WF); bf16_t* Xb = (bf16_t*)(ws + WS_XB); float* X1f = (float*)(ws + WS_X1F); bf16_t* X1b = (bf16_t*)(ws + WS_X1B); float* X2f = (float*)(ws + WS_X2F); \
    bf16_t* Z = (bf16_t*)(ws + WS_Z); bf16_t* H = (bf16_t*)(ws + WS_H); bf16_t* Y = (bf16_t*)(ws + WS_Y); bf16_t* HDN = (bf16_t*)(ws + WS_HDN); \
    bf16_t* OB = (bf16_t*)(ws + WS_OB); bf16_t* OC = (bf16_t*)(ws + WS_OC); float* Fp = (float*)(ws + WS_FP); float* Fs = (float*)(ws + WS_FS); float* OA = (float*)(ws + WS_OA); \
    float* PO = (float*)(ws + WS_PO); float* PM = (float*)(ws + WS_PM); float* PL = (float*)(ws + WS_PL); float* SA = (float*)(ws + WS_SA); float* SH = (float*)(ws + WS_SH); \
    (void)x_p; (void)x_s; (void)st_conv; (void)st_lru; (void)c_bk; (void)c_bv; (void)c_fk; (void)c_fv; (void)c_fl; (void)w_in; (void)w_conv; (void)b_conv; (void)w_ra; (void)b_ra; (void)w_rx; (void)b_rx; (void)lam; (void)relb; (void)bfg; (void)gmix; (void)w_out; \
    (void)ln1g; (void)ln1b; (void)w_up; (void)w_dn; (void)ln2g; (void)ln2b; (void)WinT; (void)WoutT; (void)WupT; (void)WdnT; (void)WgT; (void)WF; (void)Xb; (void)X1f; (void)X1b; (void)X2f; (void)Z; (void)H; (void)Y; (void)HDN; (void)OB; (void)OC; (void)Fp; (void)Fs; (void)OA; \
    (void)PO; (void)PM; (void)PL; (void)SA; (void)SH; (void)out;

    if (IN(0)) {
        PHASE_PTRS
        LAS float* scr = (LAS float*)(lds + wave * 16384);
        const bool mv = (G > 0) && (1440 % G) != 0;
        const bool mv2 = (G > 0) && (576 % G) != 0;
        for (int it = gw; it < DEPTH * CV_I_L; it += NGW) {
            const int r = it % CV_I_L;
            if (mv && r >= CV_I_IN && r < CV_I_IN + N_MV) continue;
            if (mv2 && ((it >= CV2_A0 && it < CV2_A0 + CV2_AN) || (it >= CV2_B0 && it < CV2_B0 + CV2_BN))) continue;
            conv_item(it, w_in, w_out, w_up, w_dn, w_ra, w_rx, WinT, WoutT, WupT, WdnT, WgT, scr, lane);
        }
        for (int i = blockIdx.x * NTHREADS + tid; i < DEPTH * 4 * DM; i += G * NTHREADS) { const int l = i / (4 * DM), r = i % (4 * DM), j = r / DM, k = r % DM; WF[i] = w_in[(size_t)l * DM * DIN + (size_t)k * DIN + DINP + j]; }
        VM_WAIT(); __syncthreads();
    }
    SEAM(0);
    if (IN(1)) {
        PHASE_PTRS
        int ln = lane; asm volatile("" : "+v"(ln));
        for (int row = gw; row < TT; row += 2 * NGW) { const int nv = (TT - row + NGW - 1) / NGW; xcvt_rows<2>(x_p, x_s, WF, bfg, Xb, out, 0, row, NGW, nv < 3 ? nv : 3, ln); }
    }
    SEAM(1);

    for (int l = 0; l < DEPTH; ++l) {
        const int pb = 2 + 8 * l;
        if (IN(pb + 0)) {
            PHASE_PTRS
            int td = tid; asm volatile("" : "+v"(td));
            { const int spare0 = (G > 0) ? (1440 % G) : 0, nspare = (spare0 > 0) ? G - spare0 : G;
              if ((int)blockIdx.x >= ((spare0 > 0) ? spare0 : 0)) for (int seq = (int)blockIdx.x - ((spare0 > 0) ? spare0 : 0); seq < 144; seq += nspare) cumsum_seq((LAS float*)lds, out, c_fl + (size_t)l * NB_S * PAST * NH, Fp, Fs, l, seq, td); }
            __syncthreads();
            pg8::Gemm g{Xb, WinT + (size_t)l * DINP * DM, TT, DINP, DM}; pg8::StaticOrder S; S.init(TT, DINP, DM, G, (int)blockIdx.x, false);
            pg8::EpiInP E{H, out, l};
            pg8::gemm_phase<pg8::EpiInP, pg8::StaticOrder, true, true>(lds, g, S, E);
            { const int spare0 = (G > 0) ? (1440 % G) : 0;
              if (spare0 > 0 && (int)blockIdx.x >= spare0) {
                  VM_WAIT(); __syncthreads();
                  LAS float* scr = (LAS float*)(lds + wave * 16384);
                  const int nsw = (G - spare0) * NWAVES;
                  for (int r = nsw - 1 - (((int)blockIdx.x - spare0) * NWAVES + wave); r < N_MV; r += nsw)
                      conv_item(l * CV_I_L + CV_I_IN + r, w_in, w_out, w_up, w_dn, w_ra, w_rx, WinT, WoutT, WupT, WdnT, WgT, scr, lane);
                  VM_WAIT(); __syncthreads();
              } }
        }
        SEAM(pb + 0);
        if (IN(pb + 1)) {
            constexpr int N_AT = 256 + 512 + 256 + 32 + 256 + 128;
            for (;;) {
                if (tid == 0) MISC[16] = atomicAdd((unsigned*)(KA()->ws + WS_CTL) + CW_QUEUE + 64 * (l + 2 * ((KA()->flags >> 1) & 7)), 1u);
                __syncthreads();
                const int item = __builtin_amdgcn_readfirstlane((int)MISC[16]);
                __syncthreads();
                if (item >= N_AT) break;
                int kind, j;
                if (item < 128) { kind = 0; j = item; }
                else if (item < 1056) { const int m = item - 128, per = m / 29, p = m - 29 * per, cs0 = (p * 16) / 29, cs1 = ((p + 1) * 16) / 29;
                    if (cs1 > cs0) { kind = 1; j = 16 * per + cs0; }
                    else { const int o = 13 * per + (p - cs0); if (o < 288) { kind = 2; j = o; } else { kind = 0; j = (o < 352) ? 128 + (o - 288) : 192 + (o - 352); } } }
                else if (item < 1312) { kind = 3; j = item - 1056; } else { kind = 4; j = item - 1312; }
#ifdef PROBE_PHASE
                { const int mask = (KA()->flags >> 8) & 255; if (mask && !((mask >> kind) & 1)) continue; }
#endif
                if (kind == 0) { PHASE_PTRS const AttnCtx Cfp{H, nullptr, nullptr, Fp, nullptr, OC, nullptr, nullptr, nullptr}; attn_item<0>(lds, Cfp, j & 15, 15 - (j >> 4), 0); }
                else if (kind == 1) { PHASE_PTRS const AttnCtx Cfs{H, c_fk + (size_t)l * NB_S * PAST * DB, c_fv + (size_t)l * NB_S * PAST * DB, Fs, nullptr, nullptr, PO, PM, PL};
                                      fox_sample_item(lds, Cfs, j >> 2, j & 3); }
                else if (kind == 2) { PHASE_PTRS const LruCtx CL{H, st_conv + (size_t)l * NB_S * 3 * DA, st_lru + (size_t)l * NB_S * DA, w_conv + (size_t)l * 4 * DA, b_conv + (size_t)l * DA, WgT + (size_t)l * 2 * 8 * HD * HD,
                                          b_ra + (size_t)l * DA, b_rx + (size_t)l * DA, lam + (size_t)l * DA, gmix + (size_t)l * DM, SA, SH, Y, out, l, NB_LRU, PF_LRU, nullptr, nullptr, (float*)(ws + WS_AA), (bf16_t*)(ws + WS_UU)};
                                      if (j < 256) lru_item2<false, true>(lds, CL, j); else lru_item2<true>(lds, CL, j); }
                else if (kind == 3) { PHASE_PTRS const AttnCtx Cbp{H, nullptr, nullptr, nullptr, relb + (size_t)l * NH * NREL, OB, nullptr, nullptr, nullptr};
                                      const int bh = j & 15; attn_item<1>(lds, Cbp, bh >> 2, 15 - (j >> 4), bh & 3); }
                else { PHASE_PTRS const AttnCtx Cbs{H, c_bk + (size_t)l * NB_S * BAND * DB, c_bv + (size_t)l * NB_S * BAND * DB, nullptr, relb + (size_t)l * NH * NREL, OB, nullptr, nullptr, nullptr};
                       attn_item<2>(lds, Cbs, j >> 2, j & 3, 0); }
            }
        }
        SEAM(pb + 1);
        if (IN(pb + 2)) {
            { PHASE_PTRS
              const LruCtx CL{H, st_conv + (size_t)l * NB_S * 3 * DA, st_lru + (size_t)l * NB_S * DA, w_conv + (size_t)l * 4 * DA, b_conv + (size_t)l * DA, WgT + (size_t)l * 2 * 8 * HD * HD,
                              b_ra + (size_t)l * DA, b_rx + (size_t)l * DA, lam + (size_t)l * DA, gmix + (size_t)l * DM, SA, SH, Y, out, l, NB_LRU, PF_LRU, LRU_STREAM ? nullptr : OB, LRU_STREAM ? nullptr : OC, (float*)(ws + WS_AA), (bf16_t*)(ws + WS_UU)};
              if constexpr (LRU_STREAM) { for (int chunk = blockIdx.x; chunk < 256; chunk += G) lru_pass2_stream(lds, CL, chunk); }
              else { for (int chunk = blockIdx.x; chunk < 256; chunk += G) lru_fin(lds, CL, chunk); } }
            { PHASE_PTRS
              int ln = lane; asm volatile("" : "+v"(ln));
              for (int row = (LRU_STREAM ? 0 : TP) + gw; row < TT; row += NGW) mixnorm_row(OA, OB, OC, PO, PM, PL, gmix + (size_t)l * DM, Y, false, row, ln); }
        }
        SEAM(pb + 2);
        for (int half = 0; half < 2; ++half) {
            if (IN(pb + 3 + 3 * half)) {
                PHASE_PTRS
                const int Kg = half ? DFF : DM;
                pg8::Gemm g{half ? HDN : Y, half ? WdnT + (size_t)l * DM * DFF : WoutT + (size_t)l * DM * DM, TT, DM, Kg}; pg8::StaticOrder S; const int rem2 = (G > 0) ? (576 % G) : 0; const bool fill2 = (half == 0) && (l == 0) && rem2 > 0;
                S.init(TT, DM, Kg, G, (int)blockIdx.x, !fill2);
                pg8::EpiResP<true> E{Z, nullptr, nullptr, half ? X1b : Xb};
                pg8::gemm_phase<pg8::EpiResP<true>, pg8::StaticOrder, true, true>(lds, g, S, E, (float*)(ws + WS_SK), ctl + CW_SPLITK + (2 * l + half) * 64 * 16);
                if (fill2 && (int)blockIdx.x >= rem2) {
                    VM_WAIT(); __syncthreads();
                    LAS float* scr = (LAS float*)(lds + wave * 16384);
                    const int nsw = (G - rem2) * NWAVES;
                    for (int q = ((int)blockIdx.x - rem2) * NWAVES + wave; q < N_MV2; q += nsw)
                        conv_item(q < CV2_AN ? CV2_A0 + q : CV2_B0 + (q - CV2_AN), w_in, w_out, w_up, w_dn, w_ra, w_rx, WinT, WoutT, WupT, WdnT, WgT, scr, lane);
                    VM_WAIT(); __syncthreads();
                }
            }
            SEAM(pb + 3 + 3 * half);
            if (IN(pb + 4 + 3 * half)) {
                PHASE_PTRS
                const bool nxt = half && (l + 1 < DEPTH), last = half && (l == DEPTH - 1);
                const float* gg = (half ? ln2g : ln1g) + (size_t)l * DM; const float* bb = (half ? ln2b : ln1b) + (size_t)l * DM;
                float* xf = last ? out + O_YP : nullptr; bf16_t* xbo = half ? (last ? nullptr : Xb) : X1b;
                int ln = lane; asm volatile("" : "+v"(ln));
                for (int row = gw; row < TT; row += 3 * NGW) { const int nv = (TT - row + NGW - 1) / NGW; int l2 = ln; asm volatile("" : "+v"(l2));
                    ln_rows<3>(Z, gg, bb, xf, xbo, nxt ? WF + (size_t)(l + 1) * 4 * DM : nullptr, nxt ? bfg + (l + 1) * NH : nullptr, out, l + 1, row, NGW, nv < 3 ? nv : 3, l2); }
            }
            SEAM(pb + 4 + 3 * half);
            if (half == 0) {
                if (IN(pb + 5)) {
                    PHASE_PTRS
                    pg8::Gemm g{X1b, WupT + (size_t)l * DFF * DM, TT, DFF, DM}; pg8::StaticOrder S; S.init(TT, DFF, DM, G, (int)blockIdx.x, false);
                    pg8::EpiUpP E{HDN};
                    pg8::gemm_phase<pg8::EpiUpP, pg8::StaticOrder, true, true>(lds, g, S, E);
                }
                SEAM(pb + 5);
            }
        }
    }
#undef IN
#undef SEAM
#undef PHASE_PTRS
#undef tid
#undef lane
#undef TIDF
}
extern "C" void kernel_launch(void* const* d_in, const int* in_sizes, int n_in, void* d_out, int out_size, void* d_ws, size_t ws_size, hipStream_t stream) {
    static int grid = 0;
    if (grid == 0) {
        if (n_in != 27 || (size_t)out_size != O_END || ws_size < WS_END) { fprintf(stderr, "kernel_launch: unexpected sizes n_in %d out %d ws %zu (need %zu)\n", n_in, out_size, ws_size, (size_t)WS_END); grid = -1; return; }
        int dev = 0, cus = 0, per_cu = 0;
        if (hipGetDevice(&dev) != hipSuccess || hipDeviceGetAttribute(&cus, hipDeviceAttributeMultiprocessorCount, dev) != hipSuccess) { grid = -1; return; }
        if (hipFuncSetAttribute((const void*)mk_fwd, hipFuncAttributeMaxDynamicSharedMemorySize, LDS_BYTES) != hipSuccess) { fprintf(stderr, "kernel_launch: hipFuncSetAttribute failed\n"); grid = -1; return; }
        if (hipOccupancyMaxActiveBlocksPerMultiprocessor(&per_cu, (const void*)mk_fwd, NTHREADS, LDS_BYTES) != hipSuccess || per_cu < 1) fprintf(stderr, "kernel_launch: occupancy query says %d\n", per_cu);
        (void)hipGetLastError();
        grid = cus;
    }
    if (grid < 0) return;
    (void)hipMemsetAsync((unsigned char*)d_ws + WS_CTL, 0, CTL_ZERO_BYTES, stream);
    Args a{};
    for (int i = 0; i < 27; ++i) a.in[i] = (const float*)d_in[i];
    a.out = (float*)d_out; a.ws = (unsigned char*)d_ws; a.ph_lo = 0; a.ph_hi = NPH; a.li = 0; a.flags = 0;
    hipLaunchKernelGGL(mk_fwd, dim3(grid), dim3(NTHREADS), LDS_BYTES, stream, a);
#ifdef PROBE_PHASE
    { Args p = a; p.ph_lo = PROBE_PHASE; p.ph_hi = PROBE_PHASE + 1; p.li = 1; p.flags = 2;
      for (int r = 0; r < PROBE_REPS; ++r) { p.flags = 2 + 4 * r + (PROBE_MASK << 8) + (PROBE_NB << 16) + (PROBE_SKIP << 24); hipLaunchKernelGGL(mk_fwd, dim3(grid), dim3(NTHREADS), LDS_BYTES, stream, p); } }
#endif
    const hipError_t le = hipPeekAtLastError();
    if (le != hipSuccess) fprintf(stderr, "kernel_launch: mk_fwd launch failed: %s\n", hipGetErrorName(le));
}
```

```cpp
#include <hip/hip_runtime.h>
#include <cstdio>
#include <cstdint>

typedef unsigned short bf16_t;

constexpr int DM = 2048, NB_P = 4, SEQ = 4096, DEPTH = 2, NB_S = 32, TS = 64, PAST = 4096;
constexpr int TP = NB_P * SEQ;
constexpr int TT = TP + NB_S * TS;
constexpr int DA = 1024, HD = 128, NH = 4, DB = 512, DIN = 5124, DINP = 5120, DFF = 8192, NREL = 513, BAND = 512;
constexpr int HP = DINP;
constexpr float ALPHA = 1.41421356237309515f, SCALE = 0.08838834764831845f, LN_EPS = 1e-5f, NEGBIG = -1e30f;
constexpr int C_AX = 0, C_AG = 1024, C_BQ = 2048, C_BK = 2560, C_BV = 3072, C_CQ = 3584, C_CK = 4096, C_CV = 4608;

constexpr size_t O_YP = 0;
constexpr size_t O_YS = O_YP + (size_t)NB_P * SEQ * DM;
constexpr size_t O_PCONV = O_YS + (size_t)NB_S * TS * DM;
constexpr size_t O_PLRU = O_PCONV + (size_t)DEPTH * NB_P * 3 * DA;
constexpr size_t O_PBK = O_PLRU + (size_t)DEPTH * NB_P * DA;
constexpr size_t O_PBV = O_PBK + (size_t)DEPTH * NB_P * BAND * DB;
constexpr size_t O_PFK = O_PBV + (size_t)DEPTH * NB_P * BAND * DB;
constexpr size_t O_PFV = O_PFK + (size_t)DEPTH * NB_P * SEQ * DB;
constexpr size_t O_PFL = O_PFV + (size_t)DEPTH * NB_P * SEQ * DB;
constexpr size_t O_SCONV = O_PFL + (size_t)DEPTH * NB_P * SEQ * NH;
constexpr size_t O_SLRU = O_SCONV + (size_t)DEPTH * NB_S * 3 * DA;
constexpr size_t O_SBK = O_SLRU + (size_t)DEPTH * NB_S * DA;
constexpr size_t O_SBV = O_SBK + (size_t)DEPTH * NB_S * TS * DB;
constexpr size_t O_SFK = O_SBV + (size_t)DEPTH * NB_S * TS * DB;
constexpr size_t O_SFV = O_SFK + (size_t)DEPTH * NB_S * TS * DB;
constexpr size_t O_SFL = O_SFV + (size_t)DEPTH * NB_S * TS * DB;
constexpr size_t O_END = O_SFL + (size_t)DEPTH * NB_S * TS * NH;
static_assert(O_END == 84328448ull, "output size");

constexpr size_t MiB = 1ull << 20;
constexpr size_t WS_CTL = 0;
constexpr size_t WS_WIN = 1 * MiB;
constexpr size_t WS_WOUT = WS_WIN + 40 * MiB;
constexpr size_t WS_WUP = WS_WOUT + 16 * MiB;
constexpr size_t WS_WDN = WS_WUP + 64 * MiB;
constexpr size_t WS_WF = WS_WDN + 64 * MiB;
constexpr size_t WS_XB = WS_WF + 1 * MiB;
constexpr size_t WS_X1F = WS_XB + 72 * MiB;
constexpr size_t WS_X1B = WS_X1F + 144 * MiB;
constexpr size_t WS_X2F = WS_X1B + 72 * MiB;
constexpr size_t WS_Z = WS_X2F + 144 * MiB;
constexpr size_t WS_H = WS_Z + 144 * MiB;
constexpr size_t WS_Y = WS_H + 186 * MiB;
constexpr size_t WS_HDN = WS_Y + 72 * MiB;
constexpr size_t WS_OB = WS_HDN + 288 * MiB;
constexpr size_t WS_OC = WS_OB + 36 * MiB;
constexpr size_t WS_FP = WS_OC + 36 * MiB;
constexpr size_t WS_FS = WS_FP + 1 * MiB;
constexpr size_t WS_OA = WS_FS + 3 * MiB;
constexpr size_t WS_XC = WS_OA + 72 * MiB;
constexpr size_t WS_AA = WS_XC + 72 * MiB;
constexpr size_t WS_UU = WS_AA + 72 * MiB;
constexpr size_t WS_WG = WS_UU + 72 * MiB;
constexpr size_t WS_PO = WS_WG + 1 * MiB;
constexpr size_t WS_PM = WS_PO + 16 * MiB;
constexpr size_t WS_PL = WS_PM + 1 * MiB;
constexpr size_t WS_SA = WS_PL + 1 * MiB;
constexpr size_t WS_SH = WS_SA + 1 * MiB;
constexpr size_t WS_SK = WS_SH + 1 * MiB;
constexpr size_t WS_END = WS_SK + 64 * MiB;
static_assert(WS_END <= 2048 * MiB, "workspace");

__device__ __forceinline__ float bf2f(bf16_t b) { return __uint_as_float(((unsigned)b) << 16); }
__device__ __forceinline__ float bflo(unsigned w) { return __uint_as_float(w << 16); }
__device__ __forceinline__ float bfhi(unsigned w) { return __uint_as_float(w & 0xffff0000u); }
__device__ __forceinline__ bf16_t f2bf(float f) { unsigned u = __float_as_uint(f); u += 0x7fffu + ((u >> 16) & 1u); return (bf16_t)(u >> 16); }
__device__ __forceinline__ float xshfl32(float v, int lane) { return __builtin_bit_cast(float, __builtin_amdgcn_ds_bpermute((lane ^ 32) << 2, __builtin_bit_cast(int, v))); }
__device__ __forceinline__ float wave_sum(float v) {
#define WS_DPP(x, ctrl, rmask) __builtin_bit_cast(float, __builtin_amdgcn_update_dpp(0, __builtin_bit_cast(int, (x)), (ctrl), (rmask), 0xF, false))
    v += WS_DPP(v, 0xB1, 0xF);
    v += WS_DPP(v, 0x4E, 0xF);
    v += WS_DPP(v, 0x141, 0xF);
    v += WS_DPP(v, 0x140, 0xF);
    v += WS_DPP(v, 0x142, 0xA);
    v += WS_DPP(v, 0x143, 0xC);
#undef WS_DPP
    return __builtin_bit_cast(float, __builtin_amdgcn_readlane(__builtin_bit_cast(int, v), 63));
}
__device__ __forceinline__ float wave_max(float v) {
#pragma unroll
    for (int o = 1; o < 64; o <<= 1) v = fmaxf(v, __shfl_xor(v, o));
    return v;
}
__device__ __forceinline__ float log_sigmoid_f(float z) { return fminf(z, 0.f) - log1pf(expf(-fabsf(z))); }
__device__ __forceinline__ float sigmoid_f(float z) { return 1.f / (1.f + expf(-z)); }
__device__ __forceinline__ float gelu_tanh_f(float x) { return 0.5f * x * (1.f + tanhf(0.7978845608028654f * (x + 0.044715f * x * x * x))); }
__device__ __forceinline__ const float* xrow0(const float* xp, const float* xs, int row) { return row < TP ? xp + (size_t)row * DM : xs + (size_t)(row - TP) * DM; }
__device__ __forceinline__ void row_bt(int row, bool& prm, int& b, int& t) { prm = row < TP; if (prm) { b = row >> 12; t = row & 4095; } else { const int r = row - TP; b = r >> 6; t = r & 63; } }

__device__ __forceinline__ float logf_get(const float* out, const float* cfl_l, int l, bool prm, int b, int h, int i) {
    if (prm) return out[O_PFL + ((size_t)(l * NB_P + b) * SEQ + i) * NH + h];
    if (i < PAST) return cfl_l[((size_t)b * PAST + i) * NH + h];
    return out[O_SFL + ((size_t)(l * NB_S + b) * TS + (i - PAST)) * NH + h];
}
namespace pg8 {
#define PG8_LAS __attribute__((address_space(3)))
typedef unsigned short bf16_t;
typedef short bf16x8 __attribute__((ext_vector_type(8)));
typedef float f32x4 __attribute__((ext_vector_type(4)));
typedef unsigned u32x4 __attribute__((ext_vector_type(4)));
constexpr int BM = 256, BK = 64, HALF = 128, HTB = HALF * BK * 2  , STAGE_BYTES = 8 * HTB, NXCD = 8, WGM = 8;

__host__ __device__ __forceinline__ int lds_byte(int r, int c) { const int st = (r >> 4) * 2 + (c >> 5), rr = r & 15, cc = c & 31, ob = rr * 64 + cc * 2; return st * 1024 + (ob ^ (((ob >> 9) & 1) << 5)); }
__host__ __device__ __forceinline__ void stage_rc(int b, int& R, int& C) { const int st = b / 1024, sb = b % 1024, swz = sb ^ (((sb >> 9) & 1) << 5); R = (st >> 1) * 16 + swz / 64; C = (st & 1) * 32 + (swz % 64) / 2; }
__host__ __device__ __forceinline__ int perm32(int rho) { const int n = rho >> 4, i = rho & 15; return 8 * (i >> 2) + 4 * n + (i & 3); }

struct Unit { int pm, pn, k0, nt, part, slot; };
struct Gemm { const bf16_t* A; const bf16_t* Bt; int M, N, K; };

struct StaticOrder {
    int nM, nN, nwg, G, c, ntk, R, SF;
    __host__ __device__ __forceinline__ void init(int M, int N, int K, int G_, int c_, bool split) {
        nM = M / BM; nN = N / BM; nwg = nM * nN; G = G_; c = c_; ntk = K / BK; R = nwg / G;
        const int rem = nwg - R * G; SF = rem ? 1 : 0;
        if (split && rem && (G % rem) == 0) { const int sf = G / rem; if (sf == 4 && (ntk % (2 * sf)) == 0 && ntk / sf >= 4) SF = sf; }
    }
    __host__ __device__ __forceinline__ Unit tile_of(int L, int k0, int nt, int part, int slot) const {
        int wgid = L; { const int q = nwg / NXCD, r = nwg % NXCD, xcd = wgid % NXCD, off = wgid / NXCD; wgid = (xcd < r ? xcd * (q + 1) : r * (q + 1) + (xcd - r) * q) + off; }
        const int nig = WGM * nN, gid = wgid / nig, fm = gid * WGM, gsz = (nM - fm) < WGM ? (nM - fm) : WGM;
        return Unit{fm + ((wgid % nig) % gsz), (wgid % nig) / gsz, k0, nt, part, slot};
    }
    __host__ __device__ __forceinline__ Unit next(int i) const {
        if (SF >= 2) {
            if (i == 0) { const int j = c / SF, part = c % SF, ntp = ntk / SF; return tile_of(R * G + j, part * ntp, ntp, part, j); }
            if (i <= R) return tile_of((i - 1) * G + c, 0, ntk, -1, 0);
            return Unit{0, 0, 0, 0, -1, 0};
        }
        if (i < R) return tile_of(i * G + c, 0, ntk, -1, 0);
        if (i > R || SF == 0) return Unit{0, 0, 0, 0, -1, 0};
        { const int L = R * G + c; if (L >= nwg) return Unit{0, 0, 0, 0, -1, 0}; return tile_of(L, 0, ntk, -1, 0); }
    }
    __device__ __forceinline__ void a_ready(const Unit&) const {}
    __device__ __forceinline__ void done(const Unit&) const {}
};
typedef unsigned u32x2 __attribute__((ext_vector_type(2)));
__device__ __forceinline__ unsigned cvt_pk_bf16(float lo, float hi) { unsigned r; asm volatile("v_cvt_pk_bf16_f32 %0, %1, %2" : "=v"(r) : "v"(lo), "v"(hi)); return r; }

struct EpiInP {
    static constexpr bool PERM = true, AFTER_DRAIN = false, HAS_FRAG = false;
    bf16_t* H; float* out; int l;
    __device__ __forceinline__ void operator()(const f32x4 (&acc)[2][2][4][2], const Unit& u, int wr, int wc, int fr, int fq) const {
        const int pn = u.pn, pm = u.pm;
        const bool prm = pm < 64;
        const int ccol = (pn & 1) * 256 + wc * 32 + 8 * fq;
        const int col0 = pn * 256 + wc * 32 + 8 * fq;
        const int kind = (pn < 4) ? 3 : ((pn >= 10 && pn < 14) ? 1 : ((pn >= 16) ? 2 : 0));
        const bool isv = (kind == 1) ? (pn >= 12) : (pn >= 18);
#pragma unroll
        for (int ai = 0; ai < 2; ++ai)
#pragma unroll
            for (int m = 0; m < 4; ++m) {
                const int rloc = ai * 128 + wr * 64 + m * 16 + fr;
                const int row = pm * 256 + rloc;
                int b, t; if (prm) { b = pm >> 4; t = (pm & 15) * 256 + rloc; } else { const int r = row - TP; b = r >> 6; t = r & 63; }
                float* fp = nullptr;
                if (kind == 1) { if (prm) { if (t >= SEQ - BAND) fp = out + (isv ? O_PBV : O_PBK) + ((size_t)(l * NB_P + b) * BAND + (t - (SEQ - BAND))) * DB + ccol; }
                                 else fp = out + (isv ? O_SBV : O_SBK) + ((size_t)(l * NB_S + b) * TS + t) * DB + ccol; }
                else if (kind == 2) { if (prm) fp = out + (isv ? O_PFV : O_PFK) + ((size_t)(l * NB_P + b) * SEQ + t) * DB + ccol;
                                      else fp = out + (isv ? O_SFV : O_SFK) + ((size_t)(l * NB_S + b) * TS + t) * DB + ccol; }
                else if (kind == 3) { if (prm) { if (t >= SEQ - 3) fp = out + O_PCONV + ((size_t)(l * NB_P + b) * 3 + (t - (SEQ - 3))) * DA + col0; }
                                      else { if (t >= TS - 3) fp = out + O_SCONV + ((size_t)(l * NB_S + b) * 3 + (t - (TS - 3))) * DA + col0; } }
                bf16_t* hp = H + (size_t)row * HP + col0;
#pragma unroll
                for (int bj = 0; bj < 2; ++bj) {
                    const f32x4 v0 = acc[ai][bj][m][0], v1 = acc[ai][bj][m][1];
                    u32x4 w; w.x = cvt_pk_bf16(v0[0], v0[1]); w.y = cvt_pk_bf16(v0[2], v0[3]); w.z = cvt_pk_bf16(v1[0], v1[1]); w.w = cvt_pk_bf16(v1[2], v1[3]);
                    *(u32x4*)(hp + bj * HALF) = w;
                    if (fp) { *(f32x4*)(fp + bj * HALF) = v0; *(f32x4*)(fp + bj * HALF + 4) = v1; }
                }
            }
    }
};
template <bool XB16> struct EpiResP {
    static constexpr bool PERM = true, AFTER_DRAIN = false, HAS_FRAG = true;
    bf16_t* Z; const float* xa; const float* xb; const bf16_t* xh;
    __device__ __forceinline__ f32x4 xload(const Unit& u, size_t o) const {
        if constexpr (XB16) { const unsigned long long w = *(const unsigned long long*)(xh + (size_t)u.pm * BM * DM + o); const unsigned lo = (unsigned)w, hi = (unsigned)(w >> 32);
                              return (f32x4){__uint_as_float(lo << 16), __uint_as_float(lo & 0xffff0000u), __uint_as_float(hi << 16), __uint_as_float(hi & 0xffff0000u)}; }
        else { const float* xbase = (u.pm < TP / BM) ? xa + (size_t)u.pm * BM * DM : xb + (size_t)(u.pm - TP / BM) * BM * DM; return *(const f32x4*)(xbase + o); }
    }
    __device__ __forceinline__ void frag(const f32x4 v, const Unit& u, int ai, int bj, int m, int n, int wr, int wc, int fr, int fq) const {
        const size_t o = (size_t)(wr * 64 + fr + ai * HALF + m * 16) * DM + u.pn * BM + wc * 32 + 8 * fq + bj * HALF + 4 * n;
        const f32x4 r = xload(u, o) * ALPHA + v;
        u32x2 w; w.x = cvt_pk_bf16(r[0], r[1]); w.y = cvt_pk_bf16(r[2], r[3]);
        *(u32x2*)(Z + (size_t)u.pm * BM * DM + o) = w;
    }
    __device__ __forceinline__ void operator()(const f32x4 (&acc)[2][2][4][2], const Unit& u, int wr, int wc, int fr, int fq) const {
        const int rloc0 = wr * 64 + fr, col0 = u.pn * BM + wc * 32 + 8 * fq;
        bf16_t* zbase = Z + (size_t)u.pm * BM * DM;
#pragma unroll
        for (int ai = 0; ai < 2; ++ai)
#pragma unroll
            for (int m = 0; m < 4; ++m) {
                const size_t ro = (size_t)(rloc0 + ai * HALF + m * 16) * DM + col0;
#pragma unroll
                for (int bj = 0; bj < 2; ++bj) {
                    const f32x4 r0 = xload(u, ro + bj * HALF) * ALPHA + acc[ai][bj][m][0], r1 = xload(u, ro + bj * HALF + 4) * ALPHA + acc[ai][bj][m][1];
                    u32x4 w; w.x = cvt_pk_bf16(r0[0], r0[1]); w.y = cvt_pk_bf16(r0[2], r0[3]); w.z = cvt_pk_bf16(r1[0], r1[1]); w.w = cvt_pk_bf16(r1[2], r1[3]);
                    *(u32x4*)(zbase + ro + bj * HALF) = w;
                }
            }
    }
};
struct EpiUpP {
    static constexpr bool PERM = true, AFTER_DRAIN = false, HAS_FRAG = false;
    bf16_t* HDN;
    __device__ __forceinline__ void operator()(const f32x4 (&acc)[2][2][4][2], const Unit& u, int wr, int wc, int fr, int fq) const {
        const int row0 = u.pm * BM + wr * 64 + fr, col0 = u.pn * BM + wc * 32 + 8 * fq;
#pragma unroll
        for (int ai = 0; ai < 2; ++ai)
#pragma unroll
            for (int m = 0; m < 4; ++m) {
                bf16_t* rowp = HDN + (size_t)(row0 + ai * HALF + m * 16) * DFF + col0;
#pragma unroll
                for (int bj = 0; bj < 2; ++bj) {
                    f32x4 v0 = acc[ai][bj][m][0], v1 = acc[ai][bj][m][1];
#pragma unroll
                    for (int j = 0; j < 4; ++j) { const float a = fmaxf(v0[j], 0.f), b = fmaxf(v1[j], 0.f); v0[j] = a * a; v1[j] = b * b; }
                    u32x4 w; w.x = cvt_pk_bf16(v0[0], v0[1]); w.y = cvt_pk_bf16(v0[2], v0[3]); w.z = cvt_pk_bf16(v1[0], v1[1]); w.w = cvt_pk_bf16(v1[2], v1[3]);
                    *(u32x4*)(rowp + bj * HALF) = w;
                }
            }
    }
};
#ifdef PROBE_PLAIN_SLAB
#define SK_AUX 0
#else
#define SK_AUX 16
#endif
template <class Epi, class Sched, bool ALIGN_EPI = false, bool SP2 = false>
__device__ __forceinline__ void gemm_phase(PG8_LAS unsigned char* lds, const Gemm g, const Sched& S, const Epi& E, float* sk_slab = nullptr, unsigned* sk_cnt = nullptr) {
    int tid_ = threadIdx.x; asm volatile("" : "+v"(tid_));
    const int tid = tid_, wid = __builtin_amdgcn_readfirstlane(tid >> 6), lane = tid & 63, wr = wid >> 2, wc = wid & 3, fr = lane & 15, fq = lane >> 4;
    const int K = g.K;
    unsigned voffA[2], voffB[2];
#pragma unroll
    for (int i = 0; i < 2; ++i) { int R, C; stage_rc(tid * 16 + i * 8192, R, C); const int Rb = Epi::PERM ? ((R & ~31) + perm32(R & 31)) : R;
        voffA[i] = (unsigned)(R * K + C) * 2u; voffB[i] = (unsigned)(Rb * K + C) * 2u; }
    const size_t kstep = (size_t)(BK * 2);
    const size_t hstep = (size_t)HALF * K * 2;
    const size_t tstep = 2 * hstep;
    const unsigned ldsw = (unsigned)wid * 1024u;
    const int aoff = lds_byte(wr * 64 + fr, fq * 8), boff = lds_byte(wc * 32 + fr, fq * 8);
#define PG8_SA(b, h) (((b) * 2 + (h)) * HTB)
#define PG8_SB(b, h) ((4 + (b) * 2 + (h)) * HTB)
#define PG8_STAGE(bufoff, gbase, voff) do { _Pragma("unroll") for (int _i = 0; _i < 2; ++_i) \
        __builtin_amdgcn_global_load_lds((const unsigned*)((const char*)(gbase) + (voff)[_i]), (PG8_LAS unsigned*)(lds + (bufoff) + ldsw + _i * 8192), 16, 0, 0); } while (0)
#define PG8_LDA(dst, b, h) do { _Pragma("unroll") for (int m = 0; m < 4; ++m) _Pragma("unroll") for (int k = 0; k < 2; ++k) dst[m][k] = *(const PG8_LAS bf16x8*)(lds + PG8_SA(b, h) + aoff + m * 2048 + k * 1024); } while (0)
#define PG8_LDB(dst, b, h) do { _Pragma("unroll") for (int n = 0; n < 2; ++n) _Pragma("unroll") for (int k = 0; k < 2; ++k) dst[n][k] = *(const PG8_LAS bf16x8*)(lds + PG8_SB(b, h) + boff + n * 2048 + k * 1024); } while (0)
#define PG8_MMA(ai, bj, At, Bt) do { __builtin_amdgcn_s_setprio(1); _Pragma("unroll") for (int m = 0; m < 4; ++m) _Pragma("unroll") for (int n = 0; n < 2; ++n) _Pragma("unroll") for (int k = 0; k < 2; ++k) \
        acc[ai][bj][m][n] = __builtin_amdgcn_mfma_f32_16x16x32_bf16(Bt[n][k], At[m][k], acc[ai][bj][m][n], 0, 0, 0); __builtin_amdgcn_s_setprio(0); } while (0)
#define PG8_WAIT_V(n) asm volatile("s_waitcnt vmcnt(" #n ")" ::: "memory")
#define PG8_WAIT_L(n) asm volatile("s_waitcnt lgkmcnt(" #n ")" ::: "memory")
#define PG8_BAR __builtin_amdgcn_s_barrier()
#define PG8_SCHED __builtin_amdgcn_sched_barrier(0)
    int ui = 0;
    Unit cur = S.next(0), nxt = cur;
    if (cur.nt == 0) return;
    const Unit first = cur;
    f32x4 acc[2][2][4][2];
#pragma unroll
    for (int a = 0; a < 2; ++a)
#pragma unroll
        for (int b = 0; b < 2; ++b)
#pragma unroll
            for (int m = 0; m < 4; ++m)
#pragma unroll
                for (int n = 0; n < 2; ++n) acc[a][b][m][n] = (f32x4){0.f, 0.f, 0.f, 0.f};
    bf16x8 At[4][2], B0[2][2], B1[2][2];
    const char* cA = (const char*)g.A + (size_t)cur.pm * tstep + (size_t)cur.k0 * kstep; const char* cB = (const char*)g.Bt + (size_t)cur.pn * tstep + (size_t)cur.k0 * kstep;
    S.a_ready(cur);
    if constexpr (SP2) {
        PG8_STAGE(PG8_SB(0, 0), cB, voffB); PG8_STAGE(PG8_SB(0, 1), cB + hstep, voffB); PG8_STAGE(PG8_SA(0, 0), cA, voffA); PG8_STAGE(PG8_SA(0, 1), cA + hstep, voffA);
        if (wr == 1) PG8_BAR;
        PG8_WAIT_V(2); PG8_BAR;
        PG8_STAGE(PG8_SB(1, 0), cB + kstep, voffB); PG8_STAGE(PG8_SA(1, 0), cA + kstep, voffA); PG8_STAGE(PG8_SB(1, 1), cB + hstep + kstep, voffB);
        PG8_WAIT_V(6); PG8_BAR;
    } else {
        PG8_STAGE(PG8_SB(0, 0), cB, voffB); PG8_STAGE(PG8_SA(0, 0), cA, voffA); PG8_STAGE(PG8_SB(0, 1), cB + hstep, voffB); PG8_STAGE(PG8_SA(0, 1), cA + hstep, voffA);
        if (wr == 1) PG8_BAR;
        PG8_WAIT_V(4); PG8_BAR;
        PG8_STAGE(PG8_SB(1, 0), cB + kstep, voffB); PG8_STAGE(PG8_SA(1, 0), cA + kstep, voffA); PG8_STAGE(PG8_SB(1, 1), cB + hstep + kstep, voffB);
        PG8_WAIT_V(6); PG8_BAR;
    }
    for (;;) {
        nxt = S.next(ui + 1); const bool has_next = nxt.nt != 0;
        const char* nA = has_next ? (const char*)g.A + (size_t)nxt.pm * tstep + (size_t)nxt.k0 * kstep : cA; const char* nB = has_next ? (const char*)g.Bt + (size_t)nxt.pn * tstep + (size_t)nxt.k0 * kstep : cB;
        const int nt = cur.nt;
        for (int t = 0; t < nt; t += 2) {
            const bool last = (t == nt - 2);
            const char* a1 = cA + (size_t)(t + 1) * kstep;
            const char* a2 = last ? nA : cA + (size_t)(t + 2) * kstep; const char* b2 = last ? nB : cB + (size_t)(t + 2) * kstep;
            const char* a3 = a2 + kstep; const char* b3 = b2 + kstep;
            if (last && has_next) S.a_ready(nxt);
            if constexpr (SP2) {
            PG8_LDB(B0, 0, 0); PG8_LDB(B1, 0, 1); PG8_SCHED; PG8_LDA(At, 0, 0); PG8_STAGE(PG8_SA(1, 1), a1 + hstep, voffA);
            PG8_WAIT_V(8); PG8_WAIT_L(0); PG8_BAR; PG8_MMA(0, 0, At, B0); PG8_MMA(0, 1, At, B1); PG8_BAR; PG8_SCHED;
            PG8_LDA(At, 0, 1); PG8_STAGE(PG8_SB(0, 0), b2, voffB); PG8_STAGE(PG8_SB(0, 1), b2 + hstep, voffB); PG8_STAGE(PG8_SA(0, 0), a2, voffA);
            PG8_WAIT_V(8); PG8_WAIT_L(0); PG8_BAR; PG8_MMA(1, 0, At, B0); PG8_MMA(1, 1, At, B1); PG8_BAR; PG8_SCHED;
            PG8_LDB(B0, 1, 0); PG8_LDB(B1, 1, 1); PG8_SCHED; PG8_LDA(At, 1, 0); PG8_STAGE(PG8_SA(0, 1), a2 + hstep, voffA);
            PG8_WAIT_V(8); PG8_WAIT_L(0); PG8_BAR; PG8_MMA(0, 0, At, B0); PG8_MMA(0, 1, At, B1); PG8_BAR; PG8_SCHED;
            PG8_LDA(At, 1, 1); PG8_STAGE(PG8_SB(1, 0), b3, voffB); PG8_STAGE(PG8_SB(1, 1), b3 + hstep, voffB); PG8_STAGE(PG8_SA(1, 0), a3, voffA);
            PG8_WAIT_V(8); PG8_WAIT_L(0); PG8_BAR; PG8_MMA(1, 0, At, B0); PG8_MMA(1, 1, At, B1); PG8_BAR; PG8_SCHED;
            } else {
            PG8_LDB(B0, 0, 0); PG8_SCHED; PG8_LDA(At, 0, 0); PG8_STAGE(PG8_SA(1, 1), a1 + hstep, voffA);
            PG8_WAIT_L(8); PG8_BAR; PG8_WAIT_L(0); PG8_MMA(0, 0, At, B0); PG8_BAR; PG8_SCHED;
            PG8_LDB(B1, 0, 1); PG8_STAGE(PG8_SB(0, 0), b2, voffB);
            PG8_BAR; PG8_WAIT_L(0); PG8_MMA(0, 1, At, B1); PG8_BAR;
            PG8_LDA(At, 0, 1); PG8_STAGE(PG8_SA(0, 0), a2, voffA);
            PG8_BAR; PG8_WAIT_L(0); PG8_MMA(1, 0, At, B0); PG8_BAR; PG8_SCHED;
            PG8_STAGE(PG8_SB(0, 1), b2 + hstep, voffB);
            PG8_WAIT_V(6); PG8_BAR; PG8_MMA(1, 1, At, B1); PG8_BAR;
            PG8_LDB(B0, 1, 0); PG8_SCHED; PG8_LDA(At, 1, 0); PG8_STAGE(PG8_SA(0, 1), a2 + hstep, voffA);
            PG8_WAIT_L(8); PG8_BAR; PG8_WAIT_L(0); PG8_MMA(0, 0, At, B0); PG8_BAR; PG8_SCHED;
            PG8_LDB(B1, 1, 1); PG8_STAGE(PG8_SB(1, 0), b3, voffB);
            PG8_BAR; PG8_WAIT_L(0); PG8_MMA(0, 1, At, B1); PG8_BAR;
            PG8_LDA(At, 1, 1); PG8_STAGE(PG8_SA(1, 0), a3, voffA);
            PG8_BAR; PG8_WAIT_L(0); PG8_MMA(1, 0, At, B0); PG8_BAR; PG8_SCHED;
            PG8_STAGE(PG8_SB(1, 1), b3 + hstep, voffB);
            PG8_WAIT_V(6); PG8_BAR; PG8_MMA(1, 1, At, B1); PG8_BAR;
            }
        }
        if constexpr (ALIGN_EPI) { if (wr == 0) PG8_BAR; }
        if constexpr (!Epi::AFTER_DRAIN) {
            if (cur.part < 0) E(acc, cur, wr, wc, fr, fq);
            else {
                const __amdgpu_buffer_rsrc_t rs = __builtin_amdgcn_make_buffer_rsrc((void*)((char*)sk_slab + ((size_t)cur.slot * 4 + cur.part) * (BM * BM * 2)), (short)0, BM * BM * 2, 0x00020000);
#pragma unroll
                for (int a = 0; a < 2; ++a)
#pragma unroll
                    for (int b = 0; b < 2; ++b)
#pragma unroll
                        for (int m = 0; m < 4; ++m) {
                            const f32x4 v0 = acc[a][b][m][0], v1 = acc[a][b][m][1];
                            u32x4 w; w.x = cvt_pk_bf16(v0[0], v0[1]); w.y = cvt_pk_bf16(v0[2], v0[3]); w.z = cvt_pk_bf16(v1[0], v1[1]); w.w = cvt_pk_bf16(v1[2], v1[3]);
                            __builtin_amdgcn_raw_buffer_store_b128(w, rs, tid * 16, (((a * 2 + b) * 4 + m) * 512) * 16, SK_AUX);
                        }
                asm volatile("s_waitcnt vmcnt(0)" ::: "memory");
                if (lane == 0) __hip_atomic_fetch_add(sk_cnt + 16 * cur.slot, 1u, __ATOMIC_RELAXED, __HIP_MEMORY_SCOPE_AGENT);
            }
            S.done(cur); }
        if (!has_next) break;
#pragma unroll
        for (int a = 0; a < 2; ++a)
#pragma unroll
            for (int b = 0; b < 2; ++b)
#pragma unroll
                for (int m = 0; m < 4; ++m)
#pragma unroll
                    for (int n = 0; n < 2; ++n) acc[a][b][m][n] = (f32x4){0.f, 0.f, 0.f, 0.f};
        cur = nxt; cA = nA; cB = nB; ++ui;
        if constexpr (ALIGN_EPI) { if (wr == 1) PG8_BAR; }
    }
    PG8_WAIT_V(0);
    if constexpr (!ALIGN_EPI) { if (wr == 0) PG8_BAR; }
    PG8_BAR;
    if constexpr (Epi::AFTER_DRAIN) { E.fused(acc, cur, wr, wc, fr, fq, lds, wid, lane); S.done(cur); }
    if constexpr (Epi::HAS_FRAG) {
        if (first.part >= 0) {
            if (wid == 0) {
                unsigned spins = 0;
                while ((unsigned)__builtin_amdgcn_readfirstlane(__hip_atomic_load(sk_cnt + 16 * first.slot, __ATOMIC_RELAXED, __HIP_MEMORY_SCOPE_AGENT)) < 32u) { __builtin_amdgcn_s_sleep(2); if (++spins > (1u << 22)) break; }
                __builtin_amdgcn_fence(__ATOMIC_ACQUIRE, "agent");
                asm volatile("s_waitcnt vmcnt(0)" ::: "memory");
            }
            asm volatile("" ::: "memory"); PG8_BAR; asm volatile("" ::: "memory");
            const __amdgpu_buffer_rsrc_t rs4 = __builtin_amdgcn_make_buffer_rsrc((void*)((char*)sk_slab + (size_t)first.slot * 4 * (BM * BM * 2)), (short)0, 4 * BM * BM * 2, 0x00020000);
            const int a = first.part >> 1, b = first.part & 1;
            u32x4 pv[4][4];
#pragma unroll
            for (int m = 0; m < 4; ++m)
#pragma unroll
                for (int q = 0; q < 4; ++q) pv[m][q] = __builtin_amdgcn_raw_buffer_load_b128(rs4, tid * 16, (((a * 2 + b) * 4 + m) * 512) * 16 + q * (BM * BM * 2), 0);
            __builtin_amdgcn_sched_barrier(0);
#pragma unroll
            for (int m = 0; m < 4; ++m) {
                f32x4 v0 = (f32x4){0.f, 0.f, 0.f, 0.f}, v1 = v0;
#pragma unroll
                for (int q = 0; q < 4; ++q) { const u32x4 w = pv[m][q];
                    v0 += (f32x4){__uint_as_float(w.x << 16), __uint_as_float(w.x & 0xffff0000u), __uint_as_float(w.y << 16), __uint_as_float(w.y & 0xffff0000u)};
                    v1 += (f32x4){__uint_as_float(w.z << 16), __uint_as_float(w.z & 0xffff0000u), __uint_as_float(w.w << 16), __uint_as_float(w.w & 0xffff0000u)}; }
                E.frag(v0, first, a, b, m, 0, wr, wc, fr, fq); E.frag(v1, first, a, b, m, 1, wr, wc, fr, fq);
            }
        }
    }
#undef PG8_SA
#undef PG8_SB
#undef PG8_STAGE
#undef PG8_LDA
#undef PG8_LDB
#undef PG8_MMA
#undef PG8_WAIT_V
#undef PG8_WAIT_L
#undef PG8_BAR
#undef PG8_SCHED
}
}
#define GAS __attribute__((address_space(1)))
#define LAS __attribute__((address_space(3)))
typedef float f32x4 __attribute__((ext_vector_type(4)));
typedef unsigned u32x2 __attribute__((ext_vector_type(2)));
typedef unsigned u32x4 __attribute__((ext_vector_type(4)));
constexpr int NWAVES = 8, NTHREADS = 512;
#define LDS_WAIT() asm volatile("s_waitcnt lgkmcnt(0)" ::: "memory")
#define VM_WAIT() asm volatile("s_waitcnt vmcnt(0)" ::: "memory")
constexpr int RING_BYTES = 145408;
constexpr int MISC_OFF = RING_BYTES + 320;
constexpr int LDS_BYTES = 147456;
#define XB_TMO      128
#define XB_XCNT(j)  (256  + 64 * (j))
#define XB_XSUB(j)  (1280 + 64 * (j))
#define XB_XGEN(j)  (2304 + 64 * (j))
#define XB_TOP      3328
#define XB_TOPGEN   3392
#define XCD_BAR_WORDS 3456
#define XB_SPIN_CAP (1u << 18)

__device__ __forceinline__ unsigned xb_ld(unsigned* p)              { return __hip_atomic_load(p, __ATOMIC_RELAXED, __HIP_MEMORY_SCOPE_AGENT); }
__device__ __forceinline__ unsigned xb_add(unsigned* p, unsigned v) { return __hip_atomic_fetch_add(p, v, __ATOMIC_RELAXED, __HIP_MEMORY_SCOPE_AGENT); }
__device__ __forceinline__ unsigned xb_xcc_id() { return (unsigned)__builtin_amdgcn_s_getreg((3 << 11) | 20) & 0xFu; }
#define XB_SPIN(cond, bar) do { unsigned _sp = 0; while (cond) { __builtin_amdgcn_s_sleep(1); \
    if ((++_sp & 255u) == 0u) { if (xb_ld(&(bar)[XB_TMO])) break; if (_sp > XB_SPIN_CAP) { atomicAdd(&(bar)[XB_TMO], 1u); break; } } } } while (0)

struct XcdBarrier {
    unsigned* bar; unsigned x;
    volatile LAS unsigned* st;
};

__device__ __forceinline__ XcdBarrier xcd_barrier_post(unsigned* bar, volatile LAS unsigned* st) {
    XcdBarrier b; b.bar = bar; b.x = xb_xcc_id(); b.st = st;
    if (threadIdx.x == 0) (void)xb_add(&bar[XB_XCNT(b.x)], 1u);
    return b;
}
__device__ __forceinline__ void xcd_barrier_complete(unsigned* bar, unsigned x, unsigned& nloc, unsigned& nx) {
    const unsigned G = gridDim.x * gridDim.y * gridDim.z;
    unsigned sum, cnt, mine, sp = 0u;
    for (;;) {
        sum = 0u; cnt = 0u; mine = 0u;
#pragma unroll
        for (unsigned j = 0; j < 16; ++j) { const unsigned c = xb_ld(&bar[XB_XCNT(j)]); sum += c; cnt += (c > 0u) ? 1u : 0u; mine = (j == x) ? c : mine; }
        if (sum == G) break;
        __builtin_amdgcn_s_sleep(1);
        if ((++sp & 255u) == 0u) { if (xb_ld(&bar[XB_TMO])) break; if (sp > XB_SPIN_CAP) { atomicAdd(&bar[XB_TMO], 1u); break; } }
    }
    nloc = mine > 0u ? mine : 1u; nx = cnt > 0u ? cnt : 1u;
}

__device__ __forceinline__ void xcd_barrier(const XcdBarrier& b) {
    asm volatile("s_waitcnt vmcnt(0)" ::: "memory");
    __syncthreads();
    if (threadIdx.x == 0) {
        unsigned* bar = b.bar;
        __builtin_amdgcn_s_waitcnt(0);
        unsigned nloc = b.st[0], nx = b.st[1];
        if (nloc == 0u) { xcd_barrier_complete(bar, b.x, nloc, nx); b.st[0] = nloc; b.st[1] = nx; }
        const unsigned old = xb_add(&bar[XB_XSUB(b.x)], 1u);
        const unsigned gen = old / nloc;
        if (old + 1u == (gen + 1u) * nloc) {
            __builtin_amdgcn_fence(__ATOMIC_RELEASE, "agent");
            asm volatile("s_waitcnt vmcnt(0)" ::: "memory");
            const unsigned og = xb_add(&bar[XB_TOP], 1u);
            const unsigned tg = og / nx;
            if (og + 1u == (tg + 1u) * nx) xb_add(&bar[XB_TOPGEN], 1u);
            else XB_SPIN(xb_ld(&bar[XB_TOPGEN]) == tg, bar);
            __builtin_amdgcn_fence(__ATOMIC_ACQUIRE, "agent");
            xb_add(&bar[XB_XGEN(b.x)], 1u);
            asm volatile("s_waitcnt vmcnt(0)" ::: "memory");
        } else {
            XB_SPIN(xb_ld(&bar[XB_XGEN(b.x)]) == gen, bar);
            __builtin_amdgcn_fence(__ATOMIC_ACQUIRE, "agent");
            asm volatile("s_waitcnt vmcnt(0)" ::: "memory");
        }
    }
    __syncthreads();
}
typedef short bf16x8 __attribute__((ext_vector_type(8)));
typedef short s16x4 __attribute__((ext_vector_type(4)));
typedef float f32x16 __attribute__((ext_vector_type(16)));
typedef float f32x2 __attribute__((ext_vector_type(2)));
constexpr float DEFER_THR = 8.0f;
typedef float f32x8v __attribute__((ext_vector_type(8)));
typedef __bf16 bfv2 __attribute__((ext_vector_type(2)));
constexpr float LOG2E = 1.4426950408889634f;
constexpr float QSCALE = SCALE * LOG2E;
constexpr int KS = 272, VS = 320;
constexpr int KTILE = 64 * KS, VTILE = 64 * VS;
constexpr int AT_K = 0, AT_V = 2 * KTILE, AT_FK = AT_V + 2 * VTILE, AT_REL = AT_FK + 512, AT_Q = AT_REL + 2064 + 48, AT_END = AT_Q + 16384;
static_assert(AT_END <= 131072 && AT_Q % 16 == 0, "attention LDS map");
constexpr int NSPLIT = 4;

__device__ __forceinline__ unsigned pkbf(float a, float b) { const f32x2 v = {a, b}; return __builtin_bit_cast(unsigned, __builtin_convertvector(v, bfv2)); }
__device__ __forceinline__ int off_b(int row, int ch) { return 256 * row + 16 * (ch ^ (((row & 3) << 2) | ((row >> 2) & 3))); }
__device__ __forceinline__ s16x4 tr_read4(const LAS unsigned char* p) { return __builtin_amdgcn_ds_read_tr16_b64_v4i16((LAS s16x4*)p); }
#define MFMA32(a, b, c) __builtin_amdgcn_mfma_f32_32x32x16_bf16((a), (b), (c), 0, 0, 0)

struct AttnCtx {
    const bf16_t* H; const float* ck; const float* cv;
    const float* F;
    const float* relb;
    bf16_t* O;
    float* PO; float* PM; float* PL;
};

struct TileRegs { f32x4 k0a, k0b, k1a, k1b, v0a, v0b, v1a, v1b; float fkr; };
struct TileGeo { int b, h, bh, kbase_row, kcol, vcol, tlast_new, ncache; };
template <int KIND>
__device__ __forceinline__ void tile_load1(f32x4& ka, f32x4& kb2, f32x4& va, f32x4& vb2, const AttnCtx& C, const TileGeo& G, int t, int c) {
    constexpr bool F32SRC = (KIND == 2 || KIND == 3);
    const int row = c >> 4, ch = c & 15;
    bool f32t = false;
    if constexpr (F32SRC) f32t = (t != G.tlast_new);
    if (f32t) {
        const size_t e = (((size_t)G.b * G.ncache + 64 * t + row) * NH + G.h) * HD + ch * 8;
        ka = *(const f32x4*)(C.ck + e); kb2 = *(const f32x4*)(C.ck + e + 4);
        va = *(const f32x4*)(C.cv + e); vb2 = *(const f32x4*)(C.cv + e + 4);
    } else {
        int hrow;
        if constexpr (KIND == 0 || KIND == 1) hrow = G.kbase_row + 64 * t + row; else hrow = TP + G.b * TS + row;
        const bf16_t* hp = C.H + (size_t)hrow * HP + ch * 8;
        ka = *(const f32x4*)(hp + G.kcol); va = *(const f32x4*)(hp + G.vcol);
    }
}
template <int KIND>
__device__ __forceinline__ void tile_load(TileRegs& TR, const AttnCtx& C, const TileGeo& G, int t, int tid) {
    constexpr bool FOX = (KIND == 0 || KIND == 3);
    tile_load1<KIND>(TR.k0a, TR.k0b, TR.v0a, TR.v0b, C, G, t, tid);
    tile_load1<KIND>(TR.k1a, TR.k1b, TR.v1a, TR.v1b, C, G, t, tid + 512);
    if constexpr (FOX) { if (tid < 64) TR.fkr = C.F[(size_t)G.bh * (KIND == 0 ? SEQ : PAST + TS) + 64 * t + tid]; }
}
template <int KIND, int KOFF = AT_K, int VOFF = AT_V>
__device__ __forceinline__ void tile_store1(const f32x4& ka, const f32x4& kb2, const f32x4& va, const f32x4& vb2, LAS unsigned char* lds, const TileGeo& G, int t, int buf, int c) {
    constexpr bool F32SRC = (KIND == 2 || KIND == 3);
    const int row = c >> 4, ch = c & 15;
    bool f32t = false;
    if constexpr (F32SRC) f32t = (t != G.tlast_new);
    u32x4 kc, vc;
    if (f32t) {
        kc.x = pkbf(ka.x, ka.y); kc.y = pkbf(ka.z, ka.w); kc.z = pkbf(kb2.x, kb2.y); kc.w = pkbf(kb2.z, kb2.w);
        vc.x = pkbf(va.x, va.y); vc.y = pkbf(va.z, va.w); vc.z = pkbf(vb2.x, vb2.y); vc.w = pkbf(vb2.z, vb2.w);
    } else { kc = __builtin_bit_cast(u32x4, ka); vc = __builtin_bit_cast(u32x4, va); }
    *(LAS u32x4*)(lds + KOFF + buf * KTILE + KS * row + 16 * ch) = kc; *(LAS u32x4*)(lds + VOFF + buf * VTILE + VS * row + 16 * ch) = vc;
}
template <int KIND, int KOFF = AT_K, int VOFF = AT_V, int FKOFF = AT_FK>
__device__ __forceinline__ void tile_store(const TileRegs& TR, LAS unsigned char* lds, const TileGeo& G, int t, int buf, int tid) {
    constexpr bool FOX = (KIND == 0 || KIND == 3);
    tile_store1<KIND, KOFF, VOFF>(TR.k0a, TR.k0b, TR.v0a, TR.v0b, lds, G, t, buf, tid);
    tile_store1<KIND, KOFF, VOFF>(TR.k1a, TR.k1b, TR.v1a, TR.v1b, lds, G, t, buf, tid + 512);
    if constexpr (FOX) { if (tid < 64) ((LAS float*)(lds + FKOFF))[buf * 64 + tid] = -LOG2E * TR.fkr; }
}
template <int KIND>
__device__ __forceinline__ void attn_item(LAS unsigned char* lds, const AttnCtx& C, int p0, int p1, int p2) {
    int tid_ = threadIdx.x; asm volatile("" : "+v"(tid_));
    const int tid = tid_, lane = tid & 63, wave = __builtin_amdgcn_readfirstlane(tid >> 6), lq = lane & 31, lh = lane >> 5;
    constexpr bool FOX = (KIND == 0 || KIND == 3), F32SRC = (KIND == 2 || KIND == 3);
    int b, h, bh = 0, t0, t1, qrow0, kbase_row = 0;
    if constexpr (KIND == 0) { bh = p0; b = bh >> 2; h = bh & 3; t0 = 0; t1 = 4 * p1 + 4; qrow0 = b * SEQ + 256 * p1 + 32 * wave; kbase_row = b * SEQ; }
    else if constexpr (KIND == 1) { b = p0; h = p2; t0 = (8 - 4 * p1) > 0 ? (8 - 4 * p1) : 0; t1 = 12; qrow0 = b * SEQ + 256 * p1 + 32 * wave; kbase_row = b * SEQ + 64 * (4 * p1 - 8); }
    else if constexpr (KIND == 2) { b = p0; h = p1; t0 = 0; t1 = 9; qrow0 = TP + b * TS + 32 * (wave & 1); }
    else { bh = p0; b = bh >> 2; h = bh & 3; t0 = 16 * p1; t1 = 16 * p1 + 16 + (p1 == NSPLIT - 1 ? 1 : 0); qrow0 = TP + b * TS + 32 * (wave & 1); }
    const int qcol = (FOX ? C_CQ : C_BQ) + h * HD, kcol = (FOX ? C_CK : C_BK) + h * HD, vcol = (FOX ? C_CV : C_BV) + h * HD;
    const bool qwave = (KIND <= 1) ? true : (wave < 2);
    const int tlast_new = (KIND == 2) ? 8 : 64;
    const int ncache = (KIND == 2) ? BAND : PAST;
    constexpr bool QLDS = (KIND >= 2);
    bf16x8 qf[QLDS ? 1 : 8];
    if (qwave) {
        const bf16_t* qp = C.H + (size_t)(qrow0 + lq) * HP + qcol + 8 * lh;
#pragma unroll
        for (int s = 0; s < 8; ++s) {
            const u32x4 raw = *(const u32x4*)(qp + 16 * s);
            u32x4 o; o.x = pkbf(bflo(raw.x) * QSCALE, bfhi(raw.x) * QSCALE); o.y = pkbf(bflo(raw.y) * QSCALE, bfhi(raw.y) * QSCALE);
            o.z = pkbf(bflo(raw.z) * QSCALE, bfhi(raw.z) * QSCALE); o.w = pkbf(bflo(raw.w) * QSCALE, bfhi(raw.w) * QSCALE);
            if constexpr (QLDS) *(LAS u32x4*)(lds + AT_Q + (wave & 1) * 8192 + s * 1024 + lane * 16) = o;
            else qf[s] = __builtin_bit_cast(bf16x8, o);
        }
    } else if constexpr (!QLDS) {
#pragma unroll
        for (int s = 0; s < 8; ++s) qf[s] = (bf16x8){0, 0, 0, 0, 0, 0, 0, 0};
    }
    const LAS unsigned char* Qb = lds + AT_Q + (wave & 1) * 8192 + lane * 16;
    if constexpr (!FOX) { LAS float* rel = (LAS float*)(lds + AT_REL); for (int i = tid; i < NREL; i += NTHREADS) rel[i] = C.relb[h * NREL + i] * LOG2E; }
    TileRegs TR; TR.fkr = 0.f; TR.k0b = TR.k1b = TR.v0b = TR.v1b = (f32x4){0.f, 0.f, 0.f, 0.f};
    constexpr bool DEEP = false && (KIND <= 1);
    TileRegs TR2; TR2.fkr = 0.f; TR2.k0a = TR2.k1a = TR2.v0a = TR2.v1a = TR2.k0b = TR2.k1b = TR2.v0b = TR2.v1b = (f32x4){0.f, 0.f, 0.f, 0.f};
    const TileGeo TG{b, h, bh, kbase_row, kcol, vcol, tlast_new, ncache};
#define load_tile(t) tile_load<KIND>(TR, C, TG, (t), tid)
#define store_tile(t, buf) tile_store<KIND>(TR, lds, TG, (t), (buf), tid)
#define load_tile2(t) tile_load<KIND>(TR2, C, TG, (t), tid)
#define store_tile2(t, buf) tile_store<KIND>(TR2, lds, TG, (t), (buf), tid)
    f32x16 oacc[4];
#pragma unroll
    for (int c = 0; c < 4; ++c)
#pragma unroll
        for (int r = 0; r < 16; ++r) oacc[c][r] = 0.f;
    float m_run = -1e30f, l_run = 0.f;
    const int wh = (KIND <= 1) ? (wave >> 1) : 0;
    const int qi = 32 * (wave & 1) + lq;
    const int q4 = (lane & 15) >> 2, p4 = lane & 3, blk = (lane >> 4) & 1;

    const int kofs0 = AT_K + KS * lq + 16 * lh;
    const int vofs0 = AT_V + VS * (4 * lh + q4) + 32 * blk + 8 * p4;
    load_tile(t0); store_tile(t0, 0);
    if (DEEP && t0 + 1 < t1) load_tile2(t0 + 1);
    __syncthreads();
#pragma unroll 2
    for (int st_ = 0; st_ < t1 - t0; ++st_) {
        const int t = t0 + st_;
        const int buf = st_ & 1;
        if constexpr (DEEP) { if (t + 2 < t1) { if (buf) load_tile2(t + 2); else load_tile(t + 2); } }
        else { if (t + 1 < t1) load_tile(t + 1); }
        bool active;
        if constexpr (KIND == 0) active = (t <= 4 * p1 + wh);
        else if constexpr (KIND == 1) active = (wh <= t) && (t <= wh + 8);
        else active = (wave < 2);
        if (active) {
            const LAS unsigned char* Kb = lds + kofs0 + buf * KTILE; const LAS unsigned char* Vb = lds + vofs0 + buf * VTILE;
            f32x16 sacc[2];
            if constexpr (FOX) {
                const LAS float* fk = (const LAS float*)(lds + AT_FK) + buf * 64;
#pragma unroll
                for (int kb = 0; kb < 2; ++kb) {
                    const f32x4 fa = *(const LAS f32x4*)(fk + 32 * kb + 4 * lh), fb = *(const LAS f32x4*)(fk + 32 * kb + 8 + 4 * lh), fc = *(const LAS f32x4*)(fk + 32 * kb + 16 + 4 * lh), fd = *(const LAS f32x4*)(fk + 32 * kb + 24 + 4 * lh);
                    sacc[kb] = __builtin_shufflevector(__builtin_shufflevector(fa, fb, 0, 1, 2, 3, 4, 5, 6, 7), __builtin_shufflevector(fc, fd, 0, 1, 2, 3, 4, 5, 6, 7), 0, 1, 2, 3, 4, 5, 6, 7, 8, 9, 10, 11, 12, 13, 14, 15);
                }
            } else {
#pragma unroll
                for (int r = 0; r < 16; ++r) { sacc[0][r] = 0.f; sacc[1][r] = 0.f; }
            }
            if constexpr (!QLDS) {
                constexpr int KR = 4;
                bf16x8 kf[KR];
#pragma unroll
                for (int s = 0; s < KR; ++s) kf[s] = *(const LAS bf16x8*)(Kb + 32 * s);
#pragma unroll
                for (int s = 0; s < 16; ++s) {
                    const int kb = s >> 3, ss = s & 7;
                    sacc[kb] = MFMA32(kf[s % KR], qf[ss], sacc[kb]);
                    if (s + KR < 16) kf[s % KR] = *(const LAS bf16x8*)(Kb + 32 * ((s + KR) & 7) + 32 * KS * ((s + KR) >> 3));
                }
            } else {
#pragma unroll
                for (int s = 0; s < 8; ++s) {
                    const bf16x8 q = *(const LAS bf16x8*)(Qb + 1024 * s);
                    const bf16x8 k0 = *(const LAS bf16x8*)(Kb + 32 * s), k1 = *(const LAS bf16x8*)(Kb + 32 * s + 32 * KS);
                    sacc[0] = MFMA32(k0, q, sacc[0]); sacc[1] = MFMA32(k1, q, sacc[1]);
                }
            }
            s16x4 vlo[4], vhi[4];
#define AT_VREAD(kb_, s2_) do { _Pragma("unroll") for (int c = 0; c < 4; ++c) { \
                vlo[c] = tr_read4(Vb + VS * (32 * (kb_) + 16 * (s2_)) + 64 * c); vhi[c] = tr_read4(Vb + VS * (32 * (kb_) + 16 * (s2_) + 8) + 64 * c); } } while (0)
            AT_VREAD(0, 0);
            if constexpr (FOX) {
                bool need_mask;
                if constexpr (KIND == 0) need_mask = (t == 4 * p1 + wh); else need_mask = (t == tlast_new);
                if (need_mask) {
                    asm volatile("" ::: "memory");
#pragma unroll
                    for (int kb = 0; kb < 2; ++kb)
#pragma unroll
                        for (int r = 0; r < 16; ++r) { const int key = 32 * kb + 8 * (r >> 2) + 4 * lh + (r & 3); if (key > qi) sacc[kb][r] = -__builtin_inff(); }
                }
            } else {
                const LAS float* rel = (const LAS float*)(lds + AT_REL);
                const int dchunk = wh + 8 - t;
                if (dchunk >= 5) {
                    const float cb = rel[512];
#pragma unroll
                    for (int kb = 0; kb < 2; ++kb)
#pragma unroll
                        for (int r = 0; r < 16; ++r) sacc[kb][r] += cb;
                } else {
                    const int d0 = 64 * dchunk + qi - 4 * lh;
#pragma unroll
                    for (int kb = 0; kb < 2; ++kb)
#pragma unroll
                        for (int r = 0; r < 16; ++r) {
                            int idx = d0 - (32 * kb + 8 * (r >> 2) + (r & 3));
                            idx = idx < -256 ? -256 : (idx > 256 ? 256 : idx);
                            sacc[kb][r] += rel[idx + 256];
                        }
                }
            }
            float mx = sacc[0][0];
#pragma unroll
            for (int kb = 0; kb < 2; ++kb)
#pragma unroll
                for (int r = 0; r < 16; ++r) mx = fmaxf(mx, sacc[kb][r]);
            mx = fmaxf(mx, xshfl32(mx, lane));
            float m_new = m_run;
            if (__any(mx > m_run + DEFER_THR)) {
                m_new = fmaxf(m_run, mx);
                const float corr = __builtin_amdgcn_exp2f(m_run - m_new);
                l_run *= corr;
#pragma unroll
                for (int c = 0; c < 4; ++c)
#pragma unroll
                    for (int r = 0; r < 16; ++r) oacc[c][r] *= corr;
            }
            m_run = m_new;
            sacc[0] -= m_new; sacc[1] -= m_new;
#pragma unroll
            for (int kb = 0; kb < 2; ++kb)
#pragma unroll
                for (int r = 0; r < 16; ++r) sacc[kb][r] = __builtin_amdgcn_exp2f(sacc[kb][r]);
            float ps;
            { const f32x16 t16 = sacc[0] + sacc[1];
              const f32x8v t8 = __builtin_shufflevector(t16, t16, 0, 1, 2, 3, 4, 5, 6, 7) + __builtin_shufflevector(t16, t16, 8, 9, 10, 11, 12, 13, 14, 15);
              const f32x4 t4 = __builtin_shufflevector(t8, t8, 0, 1, 2, 3) + __builtin_shufflevector(t8, t8, 4, 5, 6, 7);
              ps = (t4.x + t4.y) + (t4.z + t4.w); }
            ps += xshfl32(ps, lane);
            l_run += ps;
#pragma unroll
            for (int kk = 0; kk < 4; ++kk) {
                const int kb = kk >> 1, s2 = kk & 1;
                u32x4 pw; pw.x = pkbf(sacc[kb][8 * s2 + 0], sacc[kb][8 * s2 + 1]); pw.y = pkbf(sacc[kb][8 * s2 + 2], sacc[kb][8 * s2 + 3]);
                pw.z = pkbf(sacc[kb][8 * s2 + 4], sacc[kb][8 * s2 + 5]); pw.w = pkbf(sacc[kb][8 * s2 + 6], sacc[kb][8 * s2 + 7]);
                const bf16x8 pf = __builtin_bit_cast(bf16x8, pw);
#pragma unroll
                for (int c = 0; c < 4; ++c) oacc[c] = MFMA32(__builtin_shufflevector(vlo[c], vhi[c], 0, 1, 2, 3, 4, 5, 6, 7), pf, oacc[c]);
                if (kk < 3) { AT_VREAD((kk + 1) >> 1, (kk + 1) & 1); }
            }
#undef AT_VREAD
        }
        if constexpr (DEEP) { if (t + 1 < t1) { if (buf) store_tile(t + 1, 0); else store_tile2(t + 1, 1); } }
        else { if (t + 1 < t1) store_tile(t + 1, buf ^ 1); }
        __syncthreads();
    }
    if (qwave) {
        if constexpr (KIND == 3) {
            const size_t pr = ((size_t)bh * NSPLIT + p1) * TS + qi;
#pragma unroll
            for (int c = 0; c < 4; ++c)
#pragma unroll
                for (int g = 0; g < 4; ++g) { const f32x4 v = {oacc[c][4 * g], oacc[c][4 * g + 1], oacc[c][4 * g + 2], oacc[c][4 * g + 3]}; *(f32x4*)(C.PO + pr * HD + 32 * c + 8 * g + 4 * lh) = v; }
            if (lh == 0) { C.PM[pr] = m_run; C.PL[pr] = l_run; }
        } else {
            const float inv = 1.f / l_run;
            bf16_t* op = C.O + (size_t)(qrow0 + lq) * DB + h * HD + 4 * lh;
#pragma unroll
            for (int c = 0; c < 4; ++c)
#pragma unroll
                for (int g = 0; g < 4; ++g) { u32x2 w; w.x = pkbf(oacc[c][4 * g] * inv, oacc[c][4 * g + 1] * inv); w.y = pkbf(oacc[c][4 * g + 2] * inv, oacc[c][4 * g + 3] * inv); *(u32x2*)(op + 32 * c + 8 * g) = w; }
        }
    }
}
#undef load_tile
#undef store_tile
#undef load_tile2
#undef store_tile2


__device__ __forceinline__ void fox_combine_row(const float* PO, const float* PM, const float* PL, float* OC, int idx, int lane) {
    const int bh = idx >> 6, qi = idx & 63, b = bh >> 2, h = bh & 3;
    float m = -1e30f;
#pragma unroll
    for (int s = 0; s < NSPLIT; ++s) m = fmaxf(m, PM[((size_t)bh * NSPLIT + s) * TS + qi]);
    float l = 0.f, o0 = 0.f, o1 = 0.f;
#pragma unroll
    for (int s = 0; s < NSPLIT; ++s) {
        const size_t pr = ((size_t)bh * NSPLIT + s) * TS + qi;
        const float w = __builtin_amdgcn_exp2f(PM[pr] - m);
        l += PL[pr] * w; o0 += PO[pr * HD + lane] * w; o1 += PO[pr * HD + lane + 64] * w;
    }
    const float inv = 1.f / l;
    float* op = OC + (size_t)(TP + b * TS + qi) * DB + h * HD;
    op[lane] = o0 * inv; op[lane + 64] = o1 * inv;
}

constexpr int FS_K = 0, FS_V = 3 * KTILE, FS_FK = FS_V + 3 * VTILE, FS_Q = FS_FK + 768, FS_END = FS_Q + 16384;
static_assert(FS_END <= RING_BYTES && FS_Q % 16 == 0, "fox-sample LDS map");
#define FS_BAR() do { asm volatile("s_waitcnt lgkmcnt(0)" ::: "memory"); __builtin_amdgcn_s_barrier(); asm volatile("" ::: "memory"); } while (0)

__device__ __forceinline__ void fox_sample_item(LAS unsigned char* lds, const AttnCtx& C, int bh, int sp) {
    int tid_ = threadIdx.x; asm volatile("" : "+v"(tid_));
    const int tid = tid_, lane = tid & 63, wave = __builtin_amdgcn_readfirstlane(tid >> 6);
    const int b = bh >> 2, h = bh & 3, t0 = 16 * sp;
    const bool has_new = (sp == NSPLIT - 1);
    const int nsteps = 16 + (has_new ? 1 : 0);
    if (wave >= 2) {
        const int ltid = tid - 128;
        const float* kbase = C.ck + (((size_t)b * PAST) * NH + h) * HD; const float* vbase = C.cv + (((size_t)b * PAST) * NH + h) * HD;
        const bool six = ltid < 128;
        constexpr int FD = 3;
        f32x4 R[FD][12]; float fk[FD];
#define FS_LOAD(SET, T) do { _Pragma("unroll") for (int i = 0; i < 6; ++i) { if (i < 5 || six) { const int it = ltid + 384 * i, isv = it >> 10, ii = it & 1023, row = ii >> 4, ch = ii & 15; \
            const float* src = (isv ? vbase : kbase) + ((size_t)(64 * (T) + row) * NH) * HD + 8 * ch; R[SET][2 * i] = *(const f32x4*)src; R[SET][2 * i + 1] = *(const f32x4*)(src + 4); } } \
            if (ltid < 64) fk[SET] = C.F[(size_t)bh * (PAST + TS) + 64 * (T) + ltid]; } while (0)
#define FS_STORE(SET, BUF) do { _Pragma("unroll") for (int i = 0; i < 6; ++i) { if (i < 5 || six) { const int it = ltid + 384 * i, isv = it >> 10, ii = it & 1023, row = ii >> 4, ch = ii & 15; \
            const f32x4 a = R[SET][2 * i], c4 = R[SET][2 * i + 1]; u32x4 w; w.x = pkbf(a.x, a.y); w.y = pkbf(a.z, a.w); w.z = pkbf(c4.x, c4.y); w.w = pkbf(c4.z, c4.w); \
            if (isv) *(LAS u32x4*)(lds + FS_V + (BUF) * VTILE + VS * row + 16 * ch) = w; else *(LAS u32x4*)(lds + FS_K + (BUF) * KTILE + KS * row + 16 * ch) = w; } } \
            if (ltid < 64) ((LAS float*)(lds + FS_FK))[(BUF) * 64 + ltid] = -LOG2E * fk[SET]; } while (0)
#pragma unroll
        for (int d = 0; d < FD; ++d) FS_LOAD(d, t0 + d);
#pragma unroll
        for (int s = 0; s < 16; ++s) {
            FS_STORE(s % FD, s % 3);
            if (s + FD < 16) FS_LOAD(s % FD, t0 + s + FD);
            FS_BAR();
        }
#undef FS_LOAD
#undef FS_STORE
        if (has_new) {
            for (int it = ltid; it < 2048; it += 384) {
                const int isv = it >> 10, ii = it & 1023, row = ii >> 4, ch = ii & 15;
                const u32x4 w = *(const u32x4*)(C.H + (size_t)(TP + b * TS + row) * HP + (isv ? C_CV : C_CK) + h * HD + 8 * ch);
                if (isv) *(LAS u32x4*)(lds + FS_V + 1 * VTILE + VS * row + 16 * ch) = w; else *(LAS u32x4*)(lds + FS_K + 1 * KTILE + KS * row + 16 * ch) = w;
            }
            if (ltid < 64) ((LAS float*)(lds + FS_FK))[1 * 64 + ltid] = -LOG2E * C.F[(size_t)bh * (PAST + TS) + PAST + ltid];
            FS_BAR();
        }
    } else {
        const int lq = lane & 31, lh = lane >> 5, qi = 32 * wave + lq;
        const int q4 = (lane & 15) >> 2, p4 = lane & 3, blk = (lane >> 4) & 1;
        {
            const bf16_t* qp = C.H + (size_t)(TP + b * TS + qi) * HP + C_CQ + h * HD + 8 * lh;
#pragma unroll
            for (int s = 0; s < 8; ++s) {
                const u32x4 raw = *(const u32x4*)(qp + 16 * s);
                u32x4 o; o.x = pkbf(bflo(raw.x) * QSCALE, bfhi(raw.x) * QSCALE); o.y = pkbf(bflo(raw.y) * QSCALE, bfhi(raw.y) * QSCALE);
                o.z = pkbf(bflo(raw.z) * QSCALE, bfhi(raw.z) * QSCALE); o.w = pkbf(bflo(raw.w) * QSCALE, bfhi(raw.w) * QSCALE);
                *(LAS u32x4*)(lds + FS_Q + wave * 8192 + s * 1024 + lane * 16) = o;
            }
        }
        const LAS unsigned char* Qb = lds + FS_Q + wave * 8192 + lane * 16;
        const int kofs0 = FS_K + KS * lq + 16 * lh, vofs0 = FS_V + VS * (4 * lh + q4) + 32 * blk + 8 * p4;
        f32x16 oacc[4];
#pragma unroll
        for (int c = 0; c < 4; ++c)
#pragma unroll
            for (int r = 0; r < 16; ++r) oacc[c][r] = 0.f;
        float m_run = -1e30f, l_run = 0.f;
        for (int s = 0; s < nsteps; ++s) {
            FS_BAR();
            const int buf = s % 3;
            const LAS unsigned char* Kb = lds + kofs0 + buf * KTILE; const LAS unsigned char* Vb = lds + vofs0 + buf * VTILE;
            f32x16 sacc[2];
#pragma unroll
            for (int r = 0; r < 16; ++r) { sacc[0][r] = 0.f; sacc[1][r] = 0.f; }
#pragma unroll
            for (int ss = 0; ss < 8; ++ss) {
                const bf16x8 q = *(const LAS bf16x8*)(Qb + 1024 * ss);
                const bf16x8 k0 = *(const LAS bf16x8*)(Kb + 32 * ss), k1 = *(const LAS bf16x8*)(Kb + 32 * ss + 32 * KS);
                sacc[0] = MFMA32(k0, q, sacc[0]); sacc[1] = MFMA32(k1, q, sacc[1]);
            }
            s16x4 vlo[4], vhi[4];
#define FS_VREAD(kb_, s2_) do { _Pragma("unroll") for (int c = 0; c < 4; ++c) { \
                vlo[c] = tr_read4(Vb + VS * (32 * (kb_) + 16 * (s2_)) + 64 * c); vhi[c] = tr_read4(Vb + VS * (32 * (kb_) + 16 * (s2_) + 8) + 64 * c); } } while (0)
            FS_VREAD(0, 0);
            {
                const LAS float* fkp = (const LAS float*)(lds + FS_FK) + buf * 64;
#pragma unroll
                for (int kb = 0; kb < 2; ++kb) {
                    { const f32x4 fa = *(const LAS f32x4*)(fkp + 32 * kb + 4 * lh), fb = *(const LAS f32x4*)(fkp + 32 * kb + 8 + 4 * lh), fc = *(const LAS f32x4*)(fkp + 32 * kb + 16 + 4 * lh), fd = *(const LAS f32x4*)(fkp + 32 * kb + 24 + 4 * lh);
                      sacc[kb] += __builtin_shufflevector(__builtin_shufflevector(fa, fb, 0, 1, 2, 3, 4, 5, 6, 7), __builtin_shufflevector(fc, fd, 0, 1, 2, 3, 4, 5, 6, 7), 0, 1, 2, 3, 4, 5, 6, 7, 8, 9, 10, 11, 12, 13, 14, 15); }
                    __builtin_amdgcn_sched_barrier(0);
                }
                if (s == 16) {
                    asm volatile("" ::: "memory");
#pragma unroll
                    for (int kb = 0; kb < 2; ++kb)
#pragma unroll
                        for (int r = 0; r < 16; ++r) { const int key = 32 * kb + 8 * (r >> 2) + 4 * lh + (r & 3); if (key > qi) sacc[kb][r] = -__builtin_inff(); }
                }
            }
            float mx = sacc[0][0];
#pragma unroll
            for (int kb = 0; kb < 2; ++kb)
#pragma unroll
                for (int r = 0; r < 16; ++r) mx = fmaxf(mx, sacc[kb][r]);
            mx = fmaxf(mx, xshfl32(mx, lane));
            float m_new = m_run;
            if (__any(mx > m_run + DEFER_THR)) {
                m_new = fmaxf(m_run, mx);
                const float corr = __builtin_amdgcn_exp2f(m_run - m_new);
                l_run *= corr;
#pragma unroll
                for (int c = 0; c < 4; ++c)
#pragma unroll
                    for (int r = 0; r < 16; ++r) oacc[c][r] *= corr;
            }
            m_run = m_new;
            sacc[0] -= m_new; sacc[1] -= m_new;
#pragma unroll
            for (int kb = 0; kb < 2; ++kb)
#pragma unroll
                for (int r = 0; r < 16; ++r) sacc[kb][r] = __builtin_amdgcn_exp2f(sacc[kb][r]);
            float ps;
            { const f32x16 t16 = sacc[0] + sacc[1];
              const f32x8v t8 = __builtin_shufflevector(t16, t16, 0, 1, 2, 3, 4, 5, 6, 7) + __builtin_shufflevector(t16, t16, 8, 9, 10, 11, 12, 13, 14, 15);
              const f32x4 t4 = __builtin_shufflevector(t8, t8, 0, 1, 2, 3) + __builtin_shufflevector(t8, t8, 4, 5, 6, 7);
              ps = (t4.x + t4.y) + (t4.z + t4.w); }
            ps += xshfl32(ps, lane);
            l_run += ps;
#pragma unroll
            for (int kk = 0; kk < 4; ++kk) {
                const int kb = kk >> 1, s2 = kk & 1;
                u32x4 pw; pw.x = pkbf(sacc[kb][8 * s2 + 0], sacc[kb][8 * s2 + 1]); pw.y = pkbf(sacc[kb][8 * s2 + 2], sacc[kb][8 * s2 + 3]);
                pw.z = pkbf(sacc[kb][8 * s2 + 4], sacc[kb][8 * s2 + 5]); pw.w = pkbf(sacc[kb][8 * s2 + 6], sacc[kb][8 * s2 + 7]);
                const bf16x8 pf = __builtin_bit_cast(bf16x8, pw);
#pragma unroll
                for (int c = 0; c < 4; ++c) oacc[c] = MFMA32(__builtin_shufflevector(vlo[c], vhi[c], 0, 1, 2, 3, 4, 5, 6, 7), pf, oacc[c]);
                if (kk < 3) { FS_VREAD((kk + 1) >> 1, (kk + 1) & 1); }
            }
#undef FS_VREAD
        }
        const size_t pr = ((size_t)bh * NSPLIT + sp) * TS + qi;
#pragma unroll
        for (int c = 0; c < 4; ++c)
#pragma unroll
            for (int g = 0; g < 4; ++g) { const f32x4 v = {oacc[c][4 * g], oacc[c][4 * g + 1], oacc[c][4 * g + 2], oacc[c][4 * g + 3]}; *(f32x4*)(C.PO + pr * HD + 32 * c + 8 * g + 4 * lh) = v; }
        if (lh == 0) { C.PM[pr] = m_run; C.PL[pr] = l_run; }
    }
}
constexpr int LR_XCF = 0  , LR_XCB = 32768, LR_A = 49152, LR_AG = 81920  ,
              LR_QS = 98304, LR_SS = 102400, LR_H0 = 102912, LR_CW = 107008  , LR_GC = 127488  , LR_GM = 139776  , LR_END = 143872;
static_assert(LR_END <= RING_BYTES, "lru LDS map");
constexpr bool LRU_STREAM = false;
struct LruCtx { const bf16_t* H; const float* sconv; const float* slru; const float* wconv; const float* bconv; const bf16_t* WgT; const float* bra; const float* brx; const float* lam;
                const float* gm; float* SA; float* SH; bf16_t* Y; float* out; int l; int nb; int pf; const bf16_t* OB; const bf16_t* OC; float* AG_; bf16_t* UG_; };

__device__ __forceinline__ float fast_sigmoid(float x) { return __builtin_amdgcn_rcpf(1.f + __builtin_amdgcn_exp2f(-1.4426950408889634f * x)); }
__device__ __forceinline__ float fast_gelu_tanh(float x) {
    const float z2 = 1.5957691216057308f * (x + 0.044715f * x * x * x);
    return x * __builtin_amdgcn_rcpf(1.f + __builtin_amdgcn_exp2f(-1.4426950408889634f * z2));
}
__device__ __forceinline__ float fast_gelu_tanh2(float x) {
    constexpr float c1 = -1.4426950408889634f * 1.5957691216057308f, c2 = c1 * 0.044715f;
    return x * __builtin_amdgcn_rcpf(1.f + __builtin_amdgcn_exp2f(x * (c2 * (x * x) + c1)));
}
__device__ __forceinline__ float one_minus_exp(float x, float ehalf  ) {
    const float big = 1.f - ehalf * ehalf;
    const float small = -x * (1.f + x * (0.5f + x * (0.16666667f + x * (0.041666668f + x * 0.0083333338f))));
    return (x > -0.25f) ? small : big;
}

struct LruRows { u32x4 r[4][2]; u32x4 ag[2]; };

template <bool PASS2>
__device__ __forceinline__ void lru_fetch(u32x4 (&r)[4][2], u32x4 (&ag)[2], const LruCtx& C, bool prm, int b, int c, int row0, int n, int t, int cg) {
    const int col = n * HD + 16 * cg;
#pragma unroll
    for (int j = 0; j < 4; ++j) {
        const int tt = t + j - 3, tpos = (prm ? 64 * c : 0) + tt;
        if (tpos >= 0) { const bf16_t* hp = C.H + (size_t)(row0 + tt) * HP + C_AX + col; r[j][0] = *(const u32x4*)hp; r[j][1] = *(const u32x4*)(hp + 8); }
        else { r[j][0] = (u32x4){0u, 0u, 0u, 0u}; r[j][1] = (u32x4){0u, 0u, 0u, 0u}; }
    }
    if constexpr (PASS2) { const bf16_t* gp = C.H + (size_t)(row0 + t) * HP + C_AG + col; ag[0] = *(const u32x4*)gp; ag[1] = *(const u32x4*)(gp + 8); }
}

template <bool PASS2>
__device__ __forceinline__ void lru_item(LAS unsigned char* lds, const LruCtx& C, int chunk) {
    int tid_ = threadIdx.x; asm volatile("" : "+v"(tid_));
    const int tid = tid_, lane = tid & 63, wave = __builtin_amdgcn_readfirstlane(tid >> 6);
    const bool prm = chunk < 256; const int b = prm ? (chunk >> 6) : (chunk - 256), c = prm ? (chunk & 63) : 0;
    const int row0 = prm ? b * SEQ + 64 * c : TP + b * TS;
    LAS float* XCF = (LAS float*)(lds + LR_XCF); LAS unsigned char* XCB = lds + LR_XCB; LAS float* AA = (LAS float*)(lds + LR_A); LAS float* UU = XCF;
    LAS float* QS = (LAS float*)(lds + LR_QS); LAS float* SS = (LAS float*)(lds + LR_SS); LAS float* H0 = (LAS float*)(lds + LR_H0); LAS bf16_t* AG = (LAS bf16_t*)(lds + LR_AG); LAS float* CW = (LAS float*)(lds + LR_CW); LAS float* GC = (LAS float*)(lds + LR_GC);
    const int st_ = tid >> 3, scg_ = tid & 7;
    u32x4 rr[4][2], rag[2];
    lru_fetch<PASS2>(rr, rag, C, prm, b, c, row0, 0, st_, scg_);
#pragma unroll
    for (int i = 0; i < 2; ++i) {
        const int ch = tid + 512 * i;
        CW[ch] = C.bconv[ch];
#pragma unroll
        for (int j = 0; j < 4; ++j) CW[(1 + j) * DA + ch] = C.wconv[(size_t)j * DA + ch];
        GC[ch] = C.bra[ch]; GC[DA + ch] = C.brx[ch]; GC[2 * DA + ch] = log1pf(expf(-C.lam[ch]));
        if constexpr (PASS2) ((LAS float*)(lds + LR_GM))[ch] = C.gm[ch];
    }
    if constexpr (PASS2) {
#pragma unroll
        for (int i = 0; i < 2; ++i) {
            const int ch = tid + 512 * i; float h;
            if (prm && !(C.pf & 1)) { h = 0.f; const float* sa = C.SA + (size_t)b * 64 * DA + ch; const float* sh = C.SH + (size_t)b * 64 * DA + ch;
                for (int j0 = 0; j0 < c; j0 += 16) {
                    float av[16], hv[16];
#pragma unroll
                    for (int k = 0; k < 16; ++k) { av[k] = sa[(size_t)(j0 + k) * DA]; hv[k] = sh[(size_t)(j0 + k) * DA]; }
#pragma unroll
                    for (int k = 0; k < 16; ++k) if (j0 + k < c) h = av[k] * h + hv[k];
                } }
            else h = prm ? 0.f : C.slru[(size_t)b * DA + ch];
            H0[ch] = h;
        }
        if (tid < 64) SS[tid] = 0.f;
    }
    __syncthreads();
    for (int n = 0; n < C.nb; ++n) {
        u32x4 wq0[8], wq1[8];
        { int ln = lane; asm volatile("" : "+v"(ln));
          const int ch = 32 * (wave >> 1) + (ln & 31);
          const bf16_t* b0p = C.WgT + ((size_t)(0 * 8 + n) * HD + ch) * HD + 8 * (ln >> 5); const bf16_t* b1p = C.WgT + ((size_t)(1 * 8 + n) * HD + ch) * HD + 8 * (ln >> 5);
#pragma unroll
          for (int s = 0; s < 8; ++s) { wq0[s] = *(const u32x4*)(b0p + 16 * s); wq1[s] = *(const u32x4*)(b1p + 16 * s); } }
        {
            int st = st_, scg = scg_; asm volatile("" : "+v"(st), "+v"(scg));
            const int col = n * HD + 16 * scg;
            f32x4 acc[4];
#pragma unroll
            for (int k = 0; k < 4; ++k) acc[k] = *(const LAS f32x4*)(CW + col + 4 * k);
#pragma unroll
            for (int j = 0; j < 4; ++j) {
                const int tpos = (prm ? 64 * c : 0) + st + j - 3;
                f32x4 x[4];
                if (tpos >= 0 || prm) {
                    const u32x4 r0 = rr[j][0], r1 = rr[j][1];
                    x[0] = (f32x4){bflo(r0.x), bfhi(r0.x), bflo(r0.y), bfhi(r0.y)}; x[1] = (f32x4){bflo(r0.z), bfhi(r0.z), bflo(r0.w), bfhi(r0.w)};
                    x[2] = (f32x4){bflo(r1.x), bfhi(r1.x), bflo(r1.y), bfhi(r1.y)}; x[3] = (f32x4){bflo(r1.z), bfhi(r1.z), bflo(r1.w), bfhi(r1.w)};
                } else {
                    const float* sp = C.sconv + ((size_t)b * 3 + (tpos + 3)) * DA + col;
#pragma unroll
                    for (int k = 0; k < 4; ++k) x[k] = *(const f32x4*)(sp + 4 * k);
                }
#pragma unroll
                for (int k = 0; k < 4; ++k) { const f32x4 w = *(const LAS f32x4*)(CW + (1 + j) * DA + col + 4 * k); acc[k] += w * x[k]; }
            }
#pragma unroll
            for (int k = 0; k < 4; ++k) *(LAS f32x4*)(XCF + st * HD + 16 * scg + 4 * k) = acc[k];
            u32x4 w0, w1;
            w0.x = pkbf(acc[0].x, acc[0].y); w0.y = pkbf(acc[0].z, acc[0].w); w0.z = pkbf(acc[1].x, acc[1].y); w0.w = pkbf(acc[1].z, acc[1].w);
            w1.x = pkbf(acc[2].x, acc[2].y); w1.y = pkbf(acc[2].z, acc[2].w); w1.z = pkbf(acc[3].x, acc[3].y); w1.w = pkbf(acc[3].z, acc[3].w);
            *(LAS u32x4*)(XCB + off_b(st, 2 * scg)) = w0; *(LAS u32x4*)(XCB + off_b(st, 2 * scg + 1)) = w1;
            if constexpr (PASS2) { *(LAS u32x4*)(AG + st * HD + 16 * scg) = rag[0]; *(LAS u32x4*)(AG + st * HD + 16 * scg + 8) = rag[1]; }
            if (n + 1 < 8) { int st2 = st, cg2 = scg; asm volatile("" : "+v"(st2), "+v"(cg2)); lru_fetch<PASS2>(rr, rag, C, prm, b, c, row0, n + 1, st2, cg2); }
        }
        {
            int ln = lane; asm volatile("" : "+v"(ln));
            const int lq = ln & 31, lh = ln >> 5;
            const int rt = wave & 1, ct = wave >> 1, ch = 32 * ct + lq, gch = n * HD + ch;
            const float bra = GC[gch], brx = GC[DA + gch], sp = GC[2 * DA + gch];
            __syncthreads();
            f32x16 g0, g1;
#pragma unroll
            for (int r = 0; r < 16; ++r) { g0[r] = 0.f; g1[r] = 0.f; }
#pragma unroll
            for (int s = 0; s < 8; ++s) {
                const bf16x8 a = *(const LAS bf16x8*)(XCB + off_b(32 * rt + lq, 2 * s + lh));
                g0 = MFMA32(a, __builtin_bit_cast(bf16x8, wq0[s]), g0); g1 = MFMA32(a, __builtin_bit_cast(bf16x8, wq1[s]), g1);
            }
#pragma unroll
            for (int r = 0; r < 16; ++r) {
                const int t = 32 * rt + 8 * (r >> 2) + 4 * lh + (r & 3);
                const float rg = fast_sigmoid(g0[r] + bra), ig = fast_sigmoid(g1[r] + brx);
                const float log_a = -8.0f * rg * sp, a = __builtin_amdgcn_exp2f(1.4426950408889634f * log_a);
                float mult = __builtin_amdgcn_sqrtf(one_minus_exp(2.0f * log_a, a));
                if (prm && c == 0 && t == 0) mult = 1.0f;
                const float uv = mult * (ig * XCF[t * HD + ch]);
                AA[t * HD + ch] = a; UU[t * HD + ch] = uv;
                if constexpr (!PASS2 && LRU_STREAM) { C.AG_[(size_t)(row0 + t) * DA + gch] = a; C.UG_[(size_t)(row0 + t) * DA + gch] = f2bf(uv); }
            }
        }
        __syncthreads();
        {
            int tn = tid; asm volatile("" : "+v"(tn));
            const int ch = tn & 127, q = tn >> 7, gch = n * HD + ch;
            const LAS float* ap = AA + (16 * q) * HD + ch; const LAS float* up = UU + (16 * q) * HD + ch;
            float ra = 1.f, rh = 0.f;
#pragma unroll 4
            for (int i = 0; i < 16; ++i) { const float a = ap[i * HD], u = up[i * HD]; rh = a * rh + u; ra *= a; }
            QS[(q * HD + ch) * 2] = ra; QS[(q * HD + ch) * 2 + 1] = rh;
            __syncthreads();
            float cin = PASS2 ? H0[gch] : 0.f;
            for (int qq = 0; qq < q; ++qq) cin = QS[(qq * HD + ch) * 2] * cin + QS[(qq * HD + ch) * 2 + 1];
            if constexpr (!PASS2) {
                if (q == 3) {
                    const float atot = QS[(0 * HD + ch) * 2] * QS[(1 * HD + ch) * 2] * QS[(2 * HD + ch) * 2] * ra;
                    C.SA[((size_t)b * 64 + c) * DA + gch] = atot; C.SH[((size_t)b * 64 + c) * DA + gch] = ra * cin + rh;
                }
            } else {
                float h = cin;
                LAS bf16_t* agp = AG + (16 * q) * HD + ch;
#pragma unroll 4
                for (int i = 0; i < 16; ++i) {
                    h = ap[i * HD] * h + up[i * HD];
                    agp[i * HD] = f2bf(h * fast_gelu_tanh(bf2f(agp[i * HD])));
                }
                if (q == 3 && (!prm || c == 63)) { if (prm) C.out[O_PLRU + (size_t)(C.l * NB_P + b) * DA + gch] = h; else C.out[O_SLRU + (size_t)(C.l * NB_S + b) * DA + gch] = h; }
            }
        }
        __syncthreads();
        if constexpr (PASS2) {
            int st = st_, scg = scg_; asm volatile("" : "+v"(st), "+v"(scg));
            const u32x4 y0 = *(const LAS u32x4*)(AG + st * HD + 16 * scg), y1 = *(const LAS u32x4*)(AG + st * HD + 16 * scg + 8);
            bf16_t* yp = C.Y + (size_t)(row0 + st) * DM + n * HD + 16 * scg;
            *(u32x4*)yp = y0; *(u32x4*)(yp + 8) = y1;
            float q = 0.f;
            { const unsigned w[8] = {y0.x, y0.y, y0.z, y0.w, y1.x, y1.y, y1.z, y1.w};
#pragma unroll
              for (int k = 0; k < 8; ++k) { const float a = bflo(w[k]), bq = bfhi(w[k]); q += a * a + bq * bq; } }
            q += __builtin_bit_cast(float, __builtin_amdgcn_update_dpp(0, __builtin_bit_cast(int, q), 0xB1, 0xF, 0xF, true));
            q += __builtin_bit_cast(float, __builtin_amdgcn_update_dpp(0, __builtin_bit_cast(int, q), 0x4E, 0xF, 0xF, true));
            q += __builtin_bit_cast(float, __builtin_amdgcn_update_dpp(0, __builtin_bit_cast(int, q), 0x141, 0xF, 0xF, true));
            if (scg == 0) SS[st] += q;
            __syncthreads();
        }
    }
    if (PASS2 && !(C.pf & 2)) {
        VM_WAIT();
        __syncthreads();
#pragma unroll
        for (int hf = 0; hf < 2; ++hf) {
            u32x4 raw[8];
#pragma unroll
            for (int i = 0; i < 8; ++i) { const int k = tid + 512 * (8 * hf + i), t = k >> 7, cc = k & 127; raw[i] = *(const u32x4*)(C.Y + (size_t)(row0 + t) * DM + 8 * cc); }
#pragma unroll
            for (int i = 0; i < 8; ++i) {
                const int k = tid + 512 * (8 * hf + i), t = k >> 7, cc = k & 127;
                const float rstd = rsqrtf(SS[t] * (1.f / DA) + LN_EPS);
                const LAS float* gp = (const LAS float*)(lds + LR_GM) + 8 * cc;
                const f32x4 ga = *(const LAS f32x4*)gp, gb = *(const LAS f32x4*)(gp + 4);
                u32x4 o; o.x = pkbf(bflo(raw[i].x) * rstd * ga.x, bfhi(raw[i].x) * rstd * ga.y); o.y = pkbf(bflo(raw[i].y) * rstd * ga.z, bfhi(raw[i].y) * rstd * ga.w);
                o.z = pkbf(bflo(raw[i].z) * rstd * gb.x, bfhi(raw[i].z) * rstd * gb.y); o.w = pkbf(bflo(raw[i].w) * rstd * gb.z, bfhi(raw[i].w) * rstd * gb.w);
                *(u32x4*)(C.Y + (size_t)(row0 + t) * DM + 8 * cc) = o;
            }
        }
        __syncthreads();
    }
    if constexpr (PASS2) {
        if (C.OB) {
#pragma unroll
            for (int which = 0; which < 2; ++which) {
                int st = st_, scg = scg_; asm volatile("" : "+v"(st), "+v"(scg));
                const bf16_t* src = (which ? C.OC : C.OB) + (size_t)(row0 + st) * DB + 64 * scg;
                f32x4 v[16]; float q = 0.f;
#pragma unroll
                for (int k = 0; k < 8; ++k) { const u32x4 w = *(const u32x4*)(src + 8 * k);
                    v[2 * k] = (f32x4){bflo(w.x), bfhi(w.x), bflo(w.y), bfhi(w.y)}; v[2 * k + 1] = (f32x4){bflo(w.z), bfhi(w.z), bflo(w.w), bfhi(w.w)}; }
#pragma unroll
                for (int k = 0; k < 16; ++k) q += (v[k].x * v[k].x + v[k].y * v[k].y) + (v[k].z * v[k].z + v[k].w * v[k].w);
                q += __builtin_bit_cast(float, __builtin_amdgcn_update_dpp(0, __builtin_bit_cast(int, q), 0xB1, 0xF, 0xF, true));
                q += __builtin_bit_cast(float, __builtin_amdgcn_update_dpp(0, __builtin_bit_cast(int, q), 0x4E, 0xF, 0xF, true));
                q += __builtin_bit_cast(float, __builtin_amdgcn_update_dpp(0, __builtin_bit_cast(int, q), 0x141, 0xF, 0xF, true));
                const float rstd = rsqrtf(q * (1.f / DB) + LN_EPS);
                const float* gp = C.gm + DA + which * DB + 64 * scg;
                bf16_t* yp = C.Y + (size_t)(row0 + st) * DM + DA + which * DB + 64 * scg;
#pragma unroll
                for (int k = 0; k < 8; ++k) {
                    const f32x4 ga = *(const f32x4*)(gp + 8 * k), gb = *(const f32x4*)(gp + 8 * k + 4);
                    const f32x4 a = v[2 * k] * rstd * ga, bq = v[2 * k + 1] * rstd * gb;
                    u32x4 o; o.x = pkbf(a.x, a.y); o.y = pkbf(a.z, a.w); o.z = pkbf(bq.x, bq.y); o.w = pkbf(bq.z, bq.w);
                    *(u32x4*)(yp + 8 * k) = o;
                }
            }
        }
    }
}

constexpr int L2_YT = 0, L2_QS = 131072, L2_H0 = 139264, L2_SS = 143360, L2_END = 143616;
static_assert(L2_END <= RING_BYTES, "lru pass-2 LDS map");
__device__ __forceinline__ void lru_pass2_stream(LAS unsigned char* lds, const LruCtx& C, int chunk) {
    int tid_ = threadIdx.x; asm volatile("" : "+v"(tid_));
    const int tid = tid_;
    const int b = chunk >> 6, c = chunk & 63, row0 = b * SEQ + 64 * c;
    LAS bf16_t* YT = (LAS bf16_t*)(lds + L2_YT); LAS float* QS = (LAS float*)(lds + L2_QS); LAS float* H0 = (LAS float*)(lds + L2_H0);
    const int ch = tid & 127, q = tid >> 7;
    float av[16], uv[16], gv[16];
#define L2_LOAD(n_) do { const size_t e0 = (size_t)(row0 + 16 * q) * DA + (n_) * HD + ch; const bf16_t* gp = C.H + (size_t)(row0 + 16 * q) * HP + C_AG + (n_) * HD + ch; \
        _Pragma("unroll") for (int i = 0; i < 16; ++i) { av[i] = C.AG_[e0 + (size_t)i * DA]; uv[i] = bf2f(C.UG_[e0 + (size_t)i * DA]); gv[i] = bf2f(gp[(size_t)i * HP]); } } while (0)
    L2_LOAD(0);
#pragma unroll
    for (int i = 0; i < 2; ++i) {
        const int cc = tid + 512 * i; float h = 0.f; const float* sa = C.SA + (size_t)b * 64 * DA + cc; const float* sh = C.SH + (size_t)b * 64 * DA + cc;
        for (int j0 = 0; j0 < c; j0 += 16) {
            float fa[16], fh[16];
#pragma unroll
            for (int k = 0; k < 16; ++k) { fa[k] = sa[(size_t)(j0 + k) * DA]; fh[k] = sh[(size_t)(j0 + k) * DA]; }
#pragma unroll
            for (int k = 0; k < 16; ++k) if (j0 + k < c) h = fa[k] * h + fh[k];
        }
        H0[cc] = h;
    }
    for (int n = 0; n < 8; ++n) {
        float ra = 1.f, rh = 0.f;
#pragma unroll
        for (int i = 0; i < 16; ++i) { rh = av[i] * rh + uv[i]; ra *= av[i]; }
        LAS float* qs = QS + (n & 1) * 1024;
        qs[(q * HD + ch) * 2] = ra; qs[(q * HD + ch) * 2 + 1] = rh;
        __syncthreads();
        float h = H0[n * HD + ch];
        for (int qq = 0; qq < q; ++qq) h = qs[(qq * HD + ch) * 2] * h + qs[(qq * HD + ch) * 2 + 1];
        LAS bf16_t* yp = YT + (16 * q) * DA + n * HD + ch;
#pragma unroll
        for (int i = 0; i < 16; ++i) { h = av[i] * h + uv[i]; yp[i * DA] = f2bf(h * fast_gelu_tanh(gv[i])); }
        if (q == 3 && c == 63) C.out[O_PLRU + (size_t)(C.l * NB_P + b) * DA + n * HD + ch] = h;
        if (n + 1 < 8) L2_LOAD(n + 1);
    }
#undef L2_LOAD
    __syncthreads();
    {
        const int st = tid >> 3, scg = tid & 7;
        const LAS bf16_t* rp = YT + st * DA + 128 * scg;
        u32x4 w[16]; float s2 = 0.f;
#pragma unroll
        for (int k = 0; k < 16; ++k) { w[k] = *(const LAS u32x4*)(rp + 8 * ((k + scg + 2 * st) & 15));
            const unsigned ww[4] = {w[k].x, w[k].y, w[k].z, w[k].w};
#pragma unroll
            for (int e = 0; e < 4; ++e) { const float a = bflo(ww[e]), bq = bfhi(ww[e]); s2 += a * a + bq * bq; } }
        s2 += __builtin_bit_cast(float, __builtin_amdgcn_update_dpp(0, __builtin_bit_cast(int, s2), 0xB1, 0xF, 0xF, true));
        s2 += __builtin_bit_cast(float, __builtin_amdgcn_update_dpp(0, __builtin_bit_cast(int, s2), 0x4E, 0xF, 0xF, true));
        s2 += __builtin_bit_cast(float, __builtin_amdgcn_update_dpp(0, __builtin_bit_cast(int, s2), 0x141, 0xF, 0xF, true));
        const float rstd = rsqrtf(s2 * (1.f / DA) + LN_EPS);
        const float* gp = C.gm + 128 * scg;
        bf16_t* yo = C.Y + (size_t)(row0 + st) * DM + 128 * scg;
#pragma unroll
        for (int k = 0; k < 16; ++k) {
            const int kk = (k + scg + 2 * st) & 15;
            const f32x4 ga = *(const f32x4*)(gp + 8 * kk), gb = *(const f32x4*)(gp + 8 * kk + 4);
            u32x4 o; o.x = pkbf(bflo(w[k].x) * rstd * ga.x, bfhi(w[k].x) * rstd * ga.y); o.y = pkbf(bflo(w[k].y) * rstd * ga.z, bfhi(w[k].y) * rstd * ga.w);
            o.z = pkbf(bflo(w[k].z) * rstd * gb.x, bfhi(w[k].z) * rstd * gb.y); o.w = pkbf(bflo(w[k].w) * rstd * gb.z, bfhi(w[k].w) * rstd * gb.w);
            *(u32x4*)(yo + 8 * kk) = o;
        }
    }
    __syncthreads();
}

constexpr int W2_XCB = 0  , W2_AG = 32768  , W2_SS = 65536, W2_H0 = 65792,
              W2_CW = 69888  , W2_GC = 90368  , W2_GM = 102656  , W2_AP = 106752  , W2_END = 139520;
static_assert(W2_END <= RING_BYTES, "lru strip LDS map");

template <bool PASS2, bool AB = false>
__device__ __forceinline__ void lru_item2(LAS unsigned char* lds, const LruCtx& C, int chunk) {
    int tid_ = threadIdx.x; asm volatile("" : "+v"(tid_));
    const int tid = tid_, lane = tid & 63, wave = __builtin_amdgcn_readfirstlane(tid >> 6);
    const bool prm = chunk < 256; const int b = prm ? (chunk >> 6) : (chunk - 256), c = prm ? (chunk & 63) : 0;
    const int row0 = prm ? b * SEQ + 64 * c : TP + b * TS;
    LAS float* SS = (LAS float*)(lds + W2_SS); LAS float* H0 = (LAS float*)(lds + W2_H0); LAS float* CW = (LAS float*)(lds + W2_CW); LAS float* GC = (LAS float*)(lds + W2_GC);
    const int st_ = tid >> 3, scg_ = tid & 7;
#pragma unroll
    for (int i = 0; i < 2; ++i) {
        const int ch = tid + 512 * i;
        CW[ch] = C.bconv[ch];
#pragma unroll
        for (int j = 0; j < 4; ++j) CW[(1 + j) * DA + ch] = C.wconv[(size_t)j * DA + ch];
        GC[ch] = C.bra[ch]; GC[DA + ch] = C.brx[ch]; GC[2 * DA + ch] = log1pf(expf(-C.lam[ch]));
        if constexpr (PASS2) ((LAS float*)(lds + W2_GM))[ch] = C.gm[ch];
    }
    if constexpr (PASS2) {
#pragma unroll
        for (int i = 0; i < 2; ++i) {
            const int ch = tid + 512 * i; float h;
            if (prm) { h = 0.f; const float* sa = C.SA + (size_t)b * 64 * DA + ch; const float* sh = C.SH + (size_t)b * 64 * DA + ch;
                for (int j0 = 0; j0 < c; j0 += 16) {
                    float av[16], hv[16];
#pragma unroll
                    for (int k = 0; k < 16; ++k) { av[k] = sa[(size_t)(j0 + k) * DA]; hv[k] = sh[(size_t)(j0 + k) * DA]; }
#pragma unroll
                    for (int k = 0; k < 16; ++k) if (j0 + k < c) h = av[k] * h + hv[k];
                } }
            else h = C.slru[(size_t)b * DA + ch];
            H0[ch] = h;
        }
        if (tid < 64) SS[tid] = 0.f;
    }
    __syncthreads();
    for (int rd = 0; rd < 4; ++rd) {
#pragma unroll
        for (int nb = 0; nb < 2; ++nb) {
            int st = st_, scg = scg_; asm volatile("" : "+v"(st), "+v"(scg));
            const int n = 2 * rd + nb, col = n * HD + 16 * scg;
            f32x4 acc[4];
#pragma unroll
            for (int k = 0; k < 4; ++k) acc[k] = *(const LAS f32x4*)(CW + col + 4 * k);
#pragma unroll
            for (int j = 0; j < 4; ++j) {
                const int tt = st + j - 3, tpos = (prm ? 64 * c : 0) + tt;
                f32x4 x[4];
                if (tpos >= 0) {
                    const bf16_t* hp = C.H + (size_t)(row0 + tt) * HP + C_AX + col;
                    const u32x4 r0 = *(const u32x4*)hp, r1 = *(const u32x4*)(hp + 8);
                    x[0] = (f32x4){bflo(r0.x), bfhi(r0.x), bflo(r0.y), bfhi(r0.y)}; x[1] = (f32x4){bflo(r0.z), bfhi(r0.z), bflo(r0.w), bfhi(r0.w)};
                    x[2] = (f32x4){bflo(r1.x), bfhi(r1.x), bflo(r1.y), bfhi(r1.y)}; x[3] = (f32x4){bflo(r1.z), bfhi(r1.z), bflo(r1.w), bfhi(r1.w)};
                } else if (!prm) {
                    const float* sp = C.sconv + ((size_t)b * 3 + (tpos + 3)) * DA + col;
#pragma unroll
                    for (int k = 0; k < 4; ++k) x[k] = *(const f32x4*)(sp + 4 * k);
                } else {
#pragma unroll
                    for (int k = 0; k < 4; ++k) x[k] = (f32x4){0.f, 0.f, 0.f, 0.f};
                }
#pragma unroll
                for (int k = 0; k < 4; ++k) { const f32x4 w = *(const LAS f32x4*)(CW + (1 + j) * DA + col + 4 * k); acc[k] += w * x[k]; }
            }
            u32x4 w0, w1;
            w0.x = pkbf(acc[0].x, acc[0].y); w0.y = pkbf(acc[0].z, acc[0].w); w0.z = pkbf(acc[1].x, acc[1].y); w0.w = pkbf(acc[1].z, acc[1].w);
            w1.x = pkbf(acc[2].x, acc[2].y); w1.y = pkbf(acc[2].z, acc[2].w); w1.z = pkbf(acc[3].x, acc[3].y); w1.w = pkbf(acc[3].z, acc[3].w);
            LAS unsigned char* XCB = lds + W2_XCB + nb * 16384;
            *(LAS u32x4*)(XCB + off_b(st, 2 * scg)) = w0; *(LAS u32x4*)(XCB + off_b(st, 2 * scg + 1)) = w1;
            { LAS unsigned char* XP = lds + W2_AP + nb * 16384 + st * 256 + 32 * scg; *(LAS u32x4*)XP = w0; *(LAS u32x4*)(XP + 16) = w1; }
            if constexpr (PASS2 || AB) {
                const bf16_t* gp = C.H + (size_t)(row0 + st) * HP + C_AG + col;
                LAS bf16_t* AG = (LAS bf16_t*)(lds + W2_AG + nb * 16384);
                *(LAS u32x4*)(AG + st * HD + 16 * scg) = *(const u32x4*)gp; *(LAS u32x4*)(AG + st * HD + 16 * scg + 8) = *(const u32x4*)(gp + 8);
            }
        }
        {
            int ln = lane; asm volatile("" : "+v"(ln));
            const int lq = ln & 31, lh = ln >> 5;
            const int nb = wave >> 2, ct = wave & 3, n = 2 * rd + nb, ch = 32 * ct + lq, gch = n * HD + ch;
            u32x4 wq0[8], wq1[8];
            { const bf16_t* b0p = C.WgT + ((size_t)(0 * 8 + n) * HD + ch) * HD + 8 * lh; const bf16_t* b1p = C.WgT + ((size_t)(1 * 8 + n) * HD + ch) * HD + 8 * lh;
#pragma unroll
              for (int s = 0; s < 8; ++s) { wq0[s] = *(const u32x4*)(b0p + 16 * s); wq1[s] = *(const u32x4*)(b1p + 16 * s); } }
            __syncthreads();
            const LAS unsigned char* XCB = lds + W2_XCB + nb * 16384;
            f32x16 g[2][2];
#pragma unroll
            for (int r = 0; r < 16; ++r) { g[0][0][r] = 0.f; g[0][1][r] = 0.f; g[1][0][r] = 0.f; g[1][1][r] = 0.f; }
#pragma unroll
            for (int s = 0; s < 8; ++s) {
                const bf16x8 w0 = __builtin_bit_cast(bf16x8, wq0[s]), w1 = __builtin_bit_cast(bf16x8, wq1[s]);
                const bf16x8 a0 = *(const LAS bf16x8*)(XCB + off_b(lq, 2 * s + lh)), a1 = *(const LAS bf16x8*)(XCB + off_b(32 + lq, 2 * s + lh));
                g[0][0] = MFMA32(a0, w0, g[0][0]); g[1][0] = MFMA32(a0, w1, g[1][0]); g[0][1] = MFMA32(a1, w0, g[0][1]); g[1][1] = MFMA32(a1, w1, g[1][1]);
            }
            const float bra = GC[gch], brx = GC[DA + gch], sp = GC[2 * DA + gch];
            {
                constexpr float L2E = 1.4426950408889634f;
                const LAS unsigned char* XPL = lds + W2_AP + nb * 16384;
                const float nb0 = -L2E * bra, nb1 = -L2E * brx, ka = -8.0f * L2E * sp, kx = -16.0f * sp;
#pragma unroll
                for (int rt = 0; rt < 2; ++rt)
#pragma unroll
                    for (int rp = 0; rp < 8; ++rp) {
                        const int r = 2 * rp, t = 32 * rt + 8 * (r >> 2) + 4 * lh + (r & 3);
                        const f32x2 e0 = (f32x2){g[0][rt][r], g[0][rt][r + 1]} * -L2E + nb0, e1 = (f32x2){g[1][rt][r], g[1][rt][r + 1]} * -L2E + nb1;
                        const f32x2 d0 = (f32x2){__builtin_amdgcn_exp2f(e0.x), __builtin_amdgcn_exp2f(e0.y)} + 1.f, d1 = (f32x2){__builtin_amdgcn_exp2f(e1.x), __builtin_amdgcn_exp2f(e1.y)} + 1.f;
                        const f32x2 rg = {__builtin_amdgcn_rcpf(d0.x), __builtin_amdgcn_rcpf(d0.y)}, ig = {__builtin_amdgcn_rcpf(d1.x), __builtin_amdgcn_rcpf(d1.y)};
                        const f32x2 la = rg * ka;
                        const f32x2 a = {__builtin_amdgcn_exp2f(la.x), __builtin_amdgcn_exp2f(la.y)};
                        const f32x2 x = rg * kx;
                        const f32x2 big = 1.f - a * a;
                        const f32x2 sm = -x * (1.f + x * (0.5f + x * (0.16666667f + x * (0.041666668f + x * 0.0083333338f))));
                        const f32x2 om = {(x.x > -0.25f) ? sm.x : big.x, (x.y > -0.25f) ? sm.y : big.y};
                        f32x2 mult = {__builtin_amdgcn_sqrtf(om.x), __builtin_amdgcn_sqrtf(om.y)};
                        if (prm && c == 0 && t == 0) mult.x = 1.0f;
                        const f32x2 xc = {bf2f(*(const LAS bf16_t*)(XPL + t * 256 + 2 * ch)), bf2f(*(const LAS bf16_t*)(XPL + (t + 1) * 256 + 2 * ch))};
                        const f32x2 u = mult * (ig * xc);
                        g[0][rt][r] = a.x; g[0][rt][r + 1] = a.y; g[1][rt][r] = u.x; g[1][rt][r + 1] = u.y;
                    }
            }
            float sa[8], sh[8];
#pragma unroll
            for (int k = 0; k < 8; ++k) {
                float A = 1.f, Hh = 0.f;
#pragma unroll
                for (int i = 0; i < 4; ++i) { const float a = g[0][k >> 2][4 * (k & 3) + i], u = g[1][k >> 2][4 * (k & 3) + i]; Hh = a * Hh + u; A *= a; }
                sa[k] = A; sh[k] = Hh;
            }
            float cin = PASS2 ? H0[gch] : 0.f;
            float ck[8];
            float cA = 1.f, pk[8];
#pragma unroll
            for (int k = 0; k < 8; ++k) {
                const float pa = xshfl32(sa[k], ln), ph = xshfl32(sh[k], ln);
                const float a_even = lh ? pa : sa[k], h_even = lh ? ph : sh[k], a_odd = lh ? sa[k] : pa, h_odd = lh ? sh[k] : ph;
                const float c_even = cin, c_odd = a_even * cin + h_even;
                ck[k] = lh ? c_odd : c_even;
                cin = a_odd * c_odd + h_odd;
                if constexpr (AB) { const float q_odd = a_even * cA; pk[k] = lh ? q_odd : cA; cA = a_odd * q_odd; }
            }
            if constexpr (!PASS2) {
                float atot = 1.f;
                if constexpr (AB) atot = cA;
                else {
#pragma unroll
                    for (int k = 0; k < 8; ++k) atot *= sa[k];
                    atot *= xshfl32(atot, ln);
                }
                if (lh == 0) { C.SA[((size_t)b * 64 + c) * DA + gch] = atot; C.SH[((size_t)b * 64 + c) * DA + gch] = cin; }
                if constexpr (AB) {
                    LAS bf16_t* AG = (LAS bf16_t*)(lds + W2_AG + nb * 16384); LAS bf16_t* AP = (LAS bf16_t*)(lds + W2_AP + nb * 16384);
#pragma unroll
                    for (int k = 0; k < 8; ++k) {
                        float h = ck[k], p = pk[k];
#pragma unroll
                        for (int i = 0; i < 4; ++i) {
                            const int r = 4 * (k & 3) + i, rt = k >> 2, t = 32 * rt + 8 * (k & 3) + 4 * lh + i;
                            h = g[0][rt][r] * h + g[1][rt][r]; p *= g[0][rt][r];
                            LAS bf16_t* yp = AG + t * HD + ch;
                            const float gl = fast_gelu_tanh2(bf2f(*yp));
                            const unsigned w2 = pkbf(h * gl, p * gl);
                            *yp = (bf16_t)w2; AP[t * HD + ch] = (bf16_t)(w2 >> 16);
                        }
                    }
                }
            } else {
                LAS bf16_t* AG = (LAS bf16_t*)(lds + W2_AG + nb * 16384);
#pragma unroll
                for (int k = 0; k < 8; ++k) {
                    float h = ck[k];
#pragma unroll
                    for (int i = 0; i < 4; ++i) {
                        const int r = 4 * (k & 3) + i, rt = k >> 2, t = 32 * rt + 8 * (k & 3) + 4 * lh + i;
                        h = g[0][rt][r] * h + g[1][rt][r];
                        LAS bf16_t* yp = AG + t * HD + ch;
                        *yp = (bf16_t)pkbf(h * fast_gelu_tanh2(bf2f(*yp)), 0.f);
                    }
                }
                if (lh == 1 && (!prm || c == 63)) { if (prm) C.out[O_PLRU + (size_t)(C.l * NB_P + b) * DA + gch] = cin; else C.out[O_SLRU + (size_t)(C.l * NB_S + b) * DA + gch] = cin; }
            }
        }
        __syncthreads();
        if constexpr (AB) {
            int st = st_, scg = scg_; asm volatile("" : "+v"(st), "+v"(scg));
#pragma unroll
            for (int nb = 0; nb < 2; ++nb) {
                const LAS bf16_t* AG = (const LAS bf16_t*)(lds + W2_AG + nb * 16384); const LAS bf16_t* AP = (const LAS bf16_t*)(lds + W2_AP + nb * 16384);
                const u32x4 y0 = *(const LAS u32x4*)(AG + st * HD + 16 * scg), y1 = *(const LAS u32x4*)(AG + st * HD + 16 * scg + 8);
                const u32x4 p0 = *(const LAS u32x4*)(AP + st * HD + 16 * scg), p1 = *(const LAS u32x4*)(AP + st * HD + 16 * scg + 8);
                const size_t o = (size_t)(row0 + st) * DA + (2 * rd + nb) * HD + 16 * scg;
                bf16_t* bp = C.UG_ + o; bf16_t* ap = bp - (WS_UU - WS_AA) / 2;
                *(u32x4*)bp = y0; *(u32x4*)(bp + 8) = y1; *(u32x4*)ap = p0; *(u32x4*)(ap + 8) = p1;
            }
            __syncthreads();
        }
        if constexpr (PASS2) {
            int st = st_, scg = scg_; asm volatile("" : "+v"(st), "+v"(scg));
            float q = 0.f;
#pragma unroll
            for (int nb = 0; nb < 2; ++nb) {
                const LAS bf16_t* AG = (const LAS bf16_t*)(lds + W2_AG + nb * 16384);
                const u32x4 y0 = *(const LAS u32x4*)(AG + st * HD + 16 * scg), y1 = *(const LAS u32x4*)(AG + st * HD + 16 * scg + 8);
                bf16_t* yp = C.Y + (size_t)(row0 + st) * DM + (2 * rd + nb) * HD + 16 * scg;
                *(u32x4*)yp = y0; *(u32x4*)(yp + 8) = y1;
                const unsigned w[8] = {y0.x, y0.y, y0.z, y0.w, y1.x, y1.y, y1.z, y1.w};
#pragma unroll
                for (int k = 0; k < 8; ++k) { const float a = bflo(w[k]), bq = bfhi(w[k]); q += a * a + bq * bq; }
            }
            q += __builtin_bit_cast(float, __builtin_amdgcn_update_dpp(0, __builtin_bit_cast(int, q), 0xB1, 0xF, 0xF, true));
            q += __builtin_bit_cast(float, __builtin_amdgcn_update_dpp(0, __builtin_bit_cast(int, q), 0x4E, 0xF, 0xF, true));
            q += __builtin_bit_cast(float, __builtin_amdgcn_update_dpp(0, __builtin_bit_cast(int, q), 0x141, 0xF, 0xF, true));
            if (scg == 0) SS[st] += q;
            __syncthreads();
        }
    }
    if constexpr (PASS2) {
        VM_WAIT();
        __syncthreads();
#pragma unroll
        for (int hf = 0; hf < 2; ++hf) {
            u32x4 raw[8];
#pragma unroll
            for (int i = 0; i < 8; ++i) { const int k = tid + 512 * (8 * hf + i), t = k >> 7, cc = k & 127; raw[i] = *(const u32x4*)(C.Y + (size_t)(row0 + t) * DM + 8 * cc); }
#pragma unroll
            for (int i = 0; i < 8; ++i) {
                const int k = tid + 512 * (8 * hf + i), t = k >> 7, cc = k & 127;
                const float rstd = rsqrtf(SS[t] * (1.f / DA) + LN_EPS);
                const LAS float* gp = (const LAS float*)(lds + W2_GM) + 8 * cc;
                const f32x4 ga = *(const LAS f32x4*)gp, gb = *(const LAS f32x4*)(gp + 4);
                u32x4 o; o.x = pkbf(bflo(raw[i].x) * rstd * ga.x, bfhi(raw[i].x) * rstd * ga.y); o.y = pkbf(bflo(raw[i].y) * rstd * ga.z, bfhi(raw[i].y) * rstd * ga.w);
                o.z = pkbf(bflo(raw[i].z) * rstd * gb.x, bfhi(raw[i].z) * rstd * gb.y); o.w = pkbf(bflo(raw[i].w) * rstd * gb.z, bfhi(raw[i].w) * rstd * gb.w);
                *(u32x4*)(C.Y + (size_t)(row0 + t) * DM + 8 * cc) = o;
            }
        }
        if (C.OB) {
#pragma unroll
            for (int which = 0; which < 2; ++which) {
                int st = st_, scg = scg_; asm volatile("" : "+v"(st), "+v"(scg));
                const bf16_t* src = (which ? C.OC : C.OB) + (size_t)(row0 + st) * DB + 64 * scg;
                f32x4 v[16]; float q = 0.f;
#pragma unroll
                for (int k = 0; k < 8; ++k) { const u32x4 w = *(const u32x4*)(src + 8 * k);
                    v[2 * k] = (f32x4){bflo(w.x), bfhi(w.x), bflo(w.y), bfhi(w.y)}; v[2 * k + 1] = (f32x4){bflo(w.z), bfhi(w.z), bflo(w.w), bfhi(w.w)}; }
#pragma unroll
                for (int k = 0; k < 16; ++k) q += (v[k].x * v[k].x + v[k].y * v[k].y) + (v[k].z * v[k].z + v[k].w * v[k].w);
                q += __builtin_bit_cast(float, __builtin_amdgcn_update_dpp(0, __builtin_bit_cast(int, q), 0xB1, 0xF, 0xF, true));
                q += __builtin_bit_cast(float, __builtin_amdgcn_update_dpp(0, __builtin_bit_cast(int, q), 0x4E, 0xF, 0xF, true));
                q += __builtin_bit_cast(float, __builtin_amdgcn_update_dpp(0, __builtin_bit_cast(int, q), 0x141, 0xF, 0xF, true));
                const float rstd = rsqrtf(q * (1.f / DB) + LN_EPS);
                const float* gp = C.gm + DA + which * DB + 64 * scg;
                bf16_t* yp = C.Y + (size_t)(row0 + st) * DM + DA + which * DB + 64 * scg;
#pragma unroll
                for (int k = 0; k < 8; ++k) {
                    const f32x4 ga = *(const f32x4*)(gp + 8 * k), gb = *(const f32x4*)(gp + 8 * k + 4);
                    const f32x4 a = v[2 * k] * rstd * ga, bq = v[2 * k + 1] * rstd * gb;
                    u32x4 o; o.x = pkbf(a.x, a.y); o.y = pkbf(a.z, a.w); o.z = pkbf(bq.x, bq.y); o.w = pkbf(bq.z, bq.w);
                    *(u32x4*)(yp + 8 * k) = o;
                }
            }
        }
    }
    __syncthreads();
}

__device__ __forceinline__ void lru_fin(LAS unsigned char* lds, const LruCtx& C, int chunk) {
    int tid_ = threadIdx.x; asm volatile("" : "+v"(tid_));
    const int tid = tid_;
    const int b = chunk >> 6, c = chunk & 63, row0 = b * SEQ + 64 * c;
    LAS float* H0 = (LAS float*)(lds + W2_H0); LAS float* GM = (LAS float*)(lds + W2_GM);
    int st = tid >> 3, scg = tid & 7; asm volatile("" : "+v"(st), "+v"(scg));
    const bf16_t* bp = C.UG_ + (size_t)(row0 + st) * DA + 8 * scg;
    const bf16_t* ap = bp - (WS_UU - WS_AA) / 2;
    u32x4 av[8], bv[8];
#pragma unroll
    for (int i = 0; i < 8; ++i) { av[i] = *(const u32x4*)(ap + 64 * i); bv[i] = *(const u32x4*)(bp + 64 * i); }
    {
        float h0 = 0.f, h1 = 0.f;
        const float* sa = C.SA + (size_t)b * 64 * DA + tid; const float* sh = C.SH + (size_t)b * 64 * DA + tid;
        for (int j0 = 0; j0 < c; j0 += 16) {
            float a0[16], s0[16], a1[16], s1[16];
#pragma unroll
            for (int k = 0; k < 16; ++k) { a0[k] = sa[(size_t)(j0 + k) * DA]; s0[k] = sh[(size_t)(j0 + k) * DA]; a1[k] = sa[(size_t)(j0 + k) * DA + 512]; s1[k] = sh[(size_t)(j0 + k) * DA + 512]; }
#pragma unroll
            for (int k = 0; k < 16; ++k) if (j0 + k < c) { h0 = a0[k] * h0 + s0[k]; h1 = a1[k] * h1 + s1[k]; }
        }
        H0[tid] = h0; H0[tid + 512] = h1; GM[tid] = C.gm[tid]; GM[tid + 512] = C.gm[tid + 512];
        if (c == 63) { float* op = C.out + O_PLRU + (size_t)(C.l * NB_P + b) * DA + tid;
                       op[0] = sa[(size_t)63 * DA] * h0 + sh[(size_t)63 * DA]; op[512] = sa[(size_t)63 * DA + 512] * h1 + sh[(size_t)63 * DA + 512]; }
    }
    __syncthreads();
    {
        u32x4 y[16]; float q = 0.f;
#pragma unroll
        for (int kb = 0; kb < 2; ++kb) {
            if (kb == 1) {
#pragma unroll
                for (int i = 0; i < 8; ++i) { av[i] = *(const u32x4*)(ap + 64 * (8 + i)); bv[i] = *(const u32x4*)(bp + 64 * (8 + i)); }
            }
#pragma unroll
            for (int i = 0; i < 8; ++i) {
                const LAS float* hp = H0 + 8 * scg + 64 * (8 * kb + i);
                const f32x4 h0 = *(const LAS f32x4*)hp, h1 = *(const LAS f32x4*)(hp + 4);
                const float r0 = bflo(bv[i].x) + bflo(av[i].x) * h0.x, r1 = bfhi(bv[i].x) + bfhi(av[i].x) * h0.y, r2 = bflo(bv[i].y) + bflo(av[i].y) * h0.z, r3 = bfhi(bv[i].y) + bfhi(av[i].y) * h0.w;
                const float r4 = bflo(bv[i].z) + bflo(av[i].z) * h1.x, r5 = bfhi(bv[i].z) + bfhi(av[i].z) * h1.y, r6 = bflo(bv[i].w) + bflo(av[i].w) * h1.z, r7 = bfhi(bv[i].w) + bfhi(av[i].w) * h1.w;
                q += (r0 * r0 + r1 * r1) + (r2 * r2 + r3 * r3) + (r4 * r4 + r5 * r5) + (r6 * r6 + r7 * r7);
                u32x4 o; o.x = pkbf(r0, r1); o.y = pkbf(r2, r3); o.z = pkbf(r4, r5); o.w = pkbf(r6, r7);
                y[8 * kb + i] = o;
            }
            __builtin_amdgcn_sched_barrier(0);
        }
        q += __builtin_bit_cast(float, __builtin_amdgcn_update_dpp(0, __builtin_bit_cast(int, q), 0xB1, 0xF, 0xF, true));
        q += __builtin_bit_cast(float, __builtin_amdgcn_update_dpp(0, __builtin_bit_cast(int, q), 0x4E, 0xF, 0xF, true));
        q += __builtin_bit_cast(float, __builtin_amdgcn_update_dpp(0, __builtin_bit_cast(int, q), 0x141, 0xF, 0xF, true));
        const float rstd = rsqrtf(q * (1.f / DA) + LN_EPS);
        bf16_t* yo = C.Y + (size_t)(row0 + st) * DM + 8 * scg;
#pragma unroll
        for (int k = 0; k < 16; ++k) {
            const LAS float* gp = GM + 8 * scg + 64 * k;
            const f32x4 ga = *(const LAS f32x4*)gp, gb = *(const LAS f32x4*)(gp + 4);
            u32x4 o; o.x = pkbf(bflo(y[k].x) * rstd * ga.x, bfhi(y[k].x) * rstd * ga.y); o.y = pkbf(bflo(y[k].y) * rstd * ga.z, bfhi(y[k].y) * rstd * ga.w);
            o.z = pkbf(bflo(y[k].z) * rstd * gb.x, bfhi(y[k].z) * rstd * gb.y); o.w = pkbf(bflo(y[k].w) * rstd * gb.z, bfhi(y[k].w) * rstd * gb.w);
            *(u32x4*)(yo + 64 * k) = o;
            if ((k & 3) == 3) __builtin_amdgcn_sched_barrier(0);
        }
    }
    __builtin_amdgcn_sched_barrier(0);
    if (C.OB) {
#pragma unroll
        for (int which = 0; which < 2; ++which) {
            int st = tid >> 3, scg = tid & 7; asm volatile("" : "+v"(st), "+v"(scg));
            const bf16_t* src = (which ? C.OC : C.OB) + (size_t)(row0 + st) * DB + 64 * scg;
            f32x4 v[16]; float q = 0.f;
#pragma unroll
            for (int k = 0; k < 8; ++k) { const u32x4 w = *(const u32x4*)(src + 8 * k);
                v[2 * k] = (f32x4){bflo(w.x), bfhi(w.x), bflo(w.y), bfhi(w.y)}; v[2 * k + 1] = (f32x4){bflo(w.z), bfhi(w.z), bflo(w.w), bfhi(w.w)}; }
#pragma unroll
            for (int k = 0; k < 16; ++k) q += (v[k].x * v[k].x + v[k].y * v[k].y) + (v[k].z * v[k].z + v[k].w * v[k].w);
            q += __builtin_bit_cast(float, __builtin_amdgcn_update_dpp(0, __builtin_bit_cast(int, q), 0xB1, 0xF, 0xF, true));
            q += __builtin_bit_cast(float, __builtin_amdgcn_update_dpp(0, __builtin_bit_cast(int, q), 0x4E, 0xF, 0xF, true));
            q += __builtin_bit_cast(float, __builtin_amdgcn_update_dpp(0, __builtin_bit_cast(int, q), 0x141, 0xF, 0xF, true));
            const float rstd = rsqrtf(q * (1.f / DB) + LN_EPS);
            const float* gp = C.gm + DA + which * DB + 64 * scg;
            bf16_t* yp = C.Y + (size_t)(row0 + st) * DM + DA + which * DB + 64 * scg;
#pragma unroll
            for (int k = 0; k < 8; ++k) {
                const f32x4 ga = *(const f32x4*)(gp + 8 * k), gb = *(const f32x4*)(gp + 8 * k + 4);
                const f32x4 a = v[2 * k] * rstd * ga, bq = v[2 * k + 1] * rstd * gb;
                u32x4 o; o.x = pkbf(a.x, a.y); o.y = pkbf(a.z, a.w); o.z = pkbf(bq.x, bq.y); o.w = pkbf(bq.z, bq.w);
                *(u32x4*)(yp + 8 * k) = o;
            }
        }
    }
    __syncthreads();
}
constexpr int CW_BAR = 4096;
constexpr int N_MV = 8192;
constexpr int CV_I_IN = (DM / 64) * (DINP / 32), CV_I_OUT = (DM / 64) * (DM / 32), CV_I_UP = (DM / 64) * (DFF / 32), CV_I_DN = (DFF / 64) * (DM / 32), CV_I_G = 16 * 8, CV_I_L = CV_I_IN + CV_I_OUT + CV_I_UP + CV_I_DN + CV_I_G;
constexpr int CV2_A0 = CV_I_IN + N_MV, CV2_AN = CV_I_OUT + CV_I_UP - N_MV + CV_I_DN, CV2_B0 = CV_I_L, CV2_BN = 4096, N_MV2 = CV2_AN + CV2_BN;
static_assert(CV2_A0 + CV2_AN == CV_I_IN + CV_I_OUT + CV_I_UP + CV_I_DN && CV2_BN <= CV_I_IN && CV2_AN % 2048 == 0 && CV2_BN % 2048 == 0, "filler ranges");
constexpr int CW_QUEUE = 65536;
constexpr int CW_LRUCNT = 98304;
constexpr int CW_SPLITK = 131072;
constexpr size_t CTL_ZERO_BYTES = 1 * MiB;
constexpr int NPH = 2 + 8 * DEPTH;

__device__ __forceinline__ unsigned pk2(float lo, float hi) { return pg8::cvt_pk_bf16(lo, hi); }

struct Args { const float* in[27]; float* out; unsigned char* ws; int ph_lo, ph_hi, li, flags; };

__device__ __forceinline__ void tr_item(const float* W, int K, int ld, int ncols, bf16_t* WT, LAS float* scr, int item, int lane) {
    const int nblk = ncols / 32, kb = item / nblk, nb = item % nblk, k0 = 64 * kb, n0 = 32 * nb;
    float wv[32];
#pragma unroll
    for (int i = 0; i < 32; ++i) wv[i] = W[(size_t)(k0 + 2 * i + (lane >> 5)) * ld + n0 + (lane & 31)];
#pragma unroll
    for (int i = 0; i < 32; ++i) scr[(2 * i + (lane >> 5)) * 33 + (lane & 31)] = wv[i];
    LDS_WAIT(); asm volatile("" ::: "memory");
    const int c = lane & 7;
#pragma unroll
    for (int j = 0; j < 4; ++j) { const int n = (lane >> 3) + 8 * j; const LAS float* s = scr + (8 * c) * 33 + n;
        u32x4 o; o.x = pk2(s[0 * 33], s[1 * 33]); o.y = pk2(s[2 * 33], s[3 * 33]); o.z = pk2(s[4 * 33], s[5 * 33]); o.w = pk2(s[6 * 33], s[7 * 33]);
        *(u32x4*)(WT + (size_t)(n0 + n) * K + k0 + 8 * c) = o; }
    LDS_WAIT(); asm volatile("" ::: "memory");
}
__device__ __forceinline__ void conv_item(int it, const float* w_in, const float* w_out, const float* w_up, const float* w_dn, const float* w_ra, const float* w_rx,
                                          bf16_t* WinT, bf16_t* WoutT, bf16_t* WupT, bf16_t* WdnT, bf16_t* WgT, LAS float* scr, int lane) {
    const int l = it / CV_I_L; int r = it % CV_I_L;
    if (r < CV_I_IN) { tr_item(w_in + (size_t)l * DM * DIN, DM, DIN, DINP, WinT + (size_t)l * DINP * DM, scr, r, lane); return; } r -= CV_I_IN;
    if (r < CV_I_OUT) { tr_item(w_out + (size_t)l * DM * DM, DM, DM, DM, WoutT + (size_t)l * DM * DM, scr, r, lane); return; } r -= CV_I_OUT;
    if (r < CV_I_UP) { tr_item(w_up + (size_t)l * DM * DFF, DM, DFF, DFF, WupT + (size_t)l * DFF * DM, scr, r, lane); return; } r -= CV_I_UP;
    if (r < CV_I_DN) { tr_item(w_dn + (size_t)l * DFF * DM, DFF, DM, DM, WdnT + (size_t)l * DM * DFF, scr, r, lane); return; } r -= CV_I_DN;
    { const int mat = r >> 3, sub = r & 7, gate = mat >> 3, n = mat & 7;
      const float* src = (gate ? w_rx : w_ra) + ((size_t)l * 8 + n) * HD * HD;
      tr_item(src, HD, HD, HD, WgT + (((size_t)l * 2 + gate) * 8 + n) * HD * HD, scr, sub, lane); }
}
__device__ __forceinline__ void logf_store(float d0, float d1, float d2, float d3, const float* bfg, float* out, int l, int row, int lane) {
    d0 = wave_sum(d0); d1 = wave_sum(d1); d2 = wave_sum(d2); d3 = wave_sum(d3);
    if (lane < 4) {
        const float d = lane == 0 ? d0 : lane == 1 ? d1 : lane == 2 ? d2 : d3;
        const float lf = log_sigmoid_f(d + bfg[lane]);
        bool prm; int b, t; row_bt(row, prm, b, t);
        if (prm) out[O_PFL + ((size_t)(l * NB_P + b) * SEQ + t) * NH + lane] = lf;
        else out[O_SFL + ((size_t)(l * NB_S + b) * TS + t) * NH + lane] = lf;
    }
}
template <int NR>
__device__ __forceinline__ void xcvt_rows(const float* x_p, const float* x_s, const float* wf, const float* bfg, bf16_t* xb, float* out, int l, int row0, int rstep, int nvalid, int lane) {
    f32x4 v[NR][8];
#pragma unroll
    for (int r = 0; r < NR; ++r) {
        const float* xr = xrow0(x_p, x_s, (r < nvalid) ? row0 + r * rstep : row0);
#pragma unroll
        for (int j = 0; j < 8; ++j) v[r][j] = ((const f32x4*)xr)[lane + 64 * j];
    }
    float d[NR][4];
#pragma unroll
    for (int r = 0; r < NR; ++r) { d[r][0] = 0.f; d[r][1] = 0.f; d[r][2] = 0.f; d[r][3] = 0.f; }
#pragma unroll
    for (int j = 0; j < 8; ++j) {
        const int c = lane + 64 * j;
        const f32x4 w0 = ((const f32x4*)wf)[c], w1 = ((const f32x4*)(wf + DM))[c], w2 = ((const f32x4*)(wf + 2 * DM))[c], w3 = ((const f32x4*)(wf + 3 * DM))[c];
#pragma unroll
        for (int r = 0; r < NR; ++r) {
            if (r < nvalid) {
                const f32x4 o = v[r][j];
                u32x2 p; p.x = pk2(o.x, o.y); p.y = pk2(o.z, o.w);
                ((u32x2*)(xb + (size_t)(row0 + r * rstep) * DM))[c] = p;
                d[r][0] += o.x * w0.x + o.y * w0.y + o.z * w0.z + o.w * w0.w; d[r][1] += o.x * w1.x + o.y * w1.y + o.z * w1.z + o.w * w1.w;
                d[r][2] += o.x * w2.x + o.y * w2.y + o.z * w2.z + o.w * w2.w; d[r][3] += o.x * w3.x + o.y * w3.y + o.z * w3.z + o.w * w3.w;
            }
        }
    }
#pragma unroll
    for (int r = 0; r < NR; ++r) if (r < nvalid) logf_store(d[r][0], d[r][1], d[r][2], d[r][3], bfg, out, l, row0 + r * rstep, lane);
}
template <int NR>
__device__ __forceinline__ void ln_rows(const bf16_t* z, const float* g, const float* bta, float* xf, bf16_t* xb, const float* wf_next, const float* bfg_next, float* out, int lnext, int row0, int rstep, int nvalid, int lane) {
    u32x4 w[NR][4]; float s[NR];
#pragma unroll
    for (int r = 0; r < NR; ++r) {
        const int row = (r < nvalid) ? row0 + r * rstep : row0;
#pragma unroll
        for (int jj = 0; jj < 4; ++jj) w[r][jj] = ((const u32x4*)(z + (size_t)row * DM))[lane + 64 * jj];
    }
#define LN_V(r, j) ((j & 1) ? (f32x4){bflo(w[r][(j) >> 1].z), bfhi(w[r][(j) >> 1].z), bflo(w[r][(j) >> 1].w), bfhi(w[r][(j) >> 1].w)} : (f32x4){bflo(w[r][(j) >> 1].x), bfhi(w[r][(j) >> 1].x), bflo(w[r][(j) >> 1].y), bfhi(w[r][(j) >> 1].y)})
    float mu[NR], rstd[NR];
#pragma unroll
    for (int r = 0; r < NR; ++r) {
        s[r] = 0.f;
#pragma unroll
        for (int j = 0; j < 8; ++j) { const f32x4 v = LN_V(r, j); s[r] += (v.x + v.y) + (v.z + v.w); }
        mu[r] = wave_sum(s[r]) * (1.f / DM); float q = 0.f;
#pragma unroll
        for (int j = 0; j < 8; ++j) { const f32x4 v = LN_V(r, j) - mu[r]; q += (v.x * v.x + v.y * v.y) + (v.z * v.z + v.w * v.w); }
        rstd[r] = rsqrtf(wave_sum(q) * (1.f / DM) + LN_EPS);
    }
    float d[NR][4];
#pragma unroll
    for (int r = 0; r < NR; ++r) { d[r][0] = 0.f; d[r][1] = 0.f; d[r][2] = 0.f; d[r][3] = 0.f; }
#pragma unroll
    for (int j = 0; j < 8; ++j) {
        const int c = 2 * (lane + 64 * (j >> 1)) + (j & 1);
        const f32x4 gg = ((const f32x4*)g)[c], bb = ((const f32x4*)bta)[c];
        f32x4 w0, w1, w2, w3;
        if (wf_next) { w0 = ((const f32x4*)wf_next)[c]; w1 = ((const f32x4*)(wf_next + DM))[c]; w2 = ((const f32x4*)(wf_next + 2 * DM))[c]; w3 = ((const f32x4*)(wf_next + 3 * DM))[c]; }
#pragma unroll
        for (int r = 0; r < NR; ++r) {
            if (r < nvalid) {
                const int row = row0 + r * rstep;
                const f32x4 o = (LN_V(r, j) - mu[r]) * rstd[r] * gg + bb;
                if (xf) ((f32x4*)(xf + (size_t)row * DM))[c] = o;
                u32x2 p; p.x = pk2(o.x, o.y); p.y = pk2(o.z, o.w);
                if (xb) ((u32x2*)(xb + (size_t)row * DM))[c] = p;
                if (wf_next) { d[r][0] += o.x * w0.x + o.y * w0.y + o.z * w0.z + o.w * w0.w; d[r][1] += o.x * w1.x + o.y * w1.y + o.z * w1.z + o.w * w1.w;
                               d[r][2] += o.x * w2.x + o.y * w2.y + o.z * w2.z + o.w * w2.w; d[r][3] += o.x * w3.x + o.y * w3.y + o.z * w3.z + o.w * w3.w; }
            }
        }
    }
#undef LN_V
    if (wf_next) {
#pragma unroll
        for (int r = 0; r < NR; ++r) if (r < nvalid) logf_store(d[r][0], d[r][1], d[r][2], d[r][3], bfg_next, out, lnext, row0 + r * rstep, lane);
    }
}
__device__ __forceinline__ void mixnorm_row(const float* OA, const bf16_t* OB, const bf16_t* OC, const float* PO, const float* PM, const float* PL, const float* gm, bf16_t* Y, bool with_a, int row, int lane) {
    if (with_a) {
        f32x4 a[4]; float sa = 0.f;
#pragma unroll
        for (int j = 0; j < 4; ++j) { a[j] = ((const f32x4*)(OA + (size_t)row * DA))[lane + 64 * j]; sa += (a[j].x * a[j].x + a[j].y * a[j].y) + (a[j].z * a[j].z + a[j].w * a[j].w); }
        const float ra = rsqrtf(wave_sum(sa) * (1.f / DA) + LN_EPS);
#pragma unroll
        for (int j = 0; j < 4; ++j) { const int c = lane + 64 * j; const f32x4 gg = ((const f32x4*)gm)[c]; const f32x4 o = a[j] * ra * gg;
            u32x2 p; p.x = pk2(o.x, o.y); p.y = pk2(o.z, o.w); ((u32x2*)(Y + (size_t)row * DM))[c] = p; }
    }
    {
        f32x4 b[2]; float sb = 0.f;
        { const u32x4 w = ((const u32x4*)(OB + (size_t)row * DB))[lane]; b[0] = (f32x4){bflo(w.x), bfhi(w.x), bflo(w.y), bfhi(w.y)}; b[1] = (f32x4){bflo(w.z), bfhi(w.z), bflo(w.w), bfhi(w.w)}; }
#pragma unroll
        for (int j = 0; j < 2; ++j) sb += (b[j].x * b[j].x + b[j].y * b[j].y) + (b[j].z * b[j].z + b[j].w * b[j].w);
        const float rb = rsqrtf(wave_sum(sb) * (1.f / DB) + LN_EPS);
#pragma unroll
        for (int j = 0; j < 2; ++j) { const int c = 2 * lane + j; const f32x4 gb = ((const f32x4*)(gm + DA))[c]; const f32x4 ob = b[j] * rb * gb;
            u32x2 p; p.x = pk2(ob.x, ob.y); p.y = pk2(ob.z, ob.w); ((u32x2*)(Y + (size_t)row * DM + DA))[c] = p; }
    }
    if (row < TP) {
        f32x4 cc[2]; float sc = 0.f;
        { const u32x4 w = ((const u32x4*)(OC + (size_t)row * DB))[lane]; cc[0] = (f32x4){bflo(w.x), bfhi(w.x), bflo(w.y), bfhi(w.y)}; cc[1] = (f32x4){bflo(w.z), bfhi(w.z), bflo(w.w), bfhi(w.w)}; }
#pragma unroll
        for (int j = 0; j < 2; ++j) sc += (cc[j].x * cc[j].x + cc[j].y * cc[j].y) + (cc[j].z * cc[j].z + cc[j].w * cc[j].w);
        const float rc = rsqrtf(wave_sum(sc) * (1.f / DB) + LN_EPS);
#pragma unroll
        for (int j = 0; j < 2; ++j) { const int c = 2 * lane + j; const f32x4 gc = ((const f32x4*)(gm + DA + DB))[c]; const f32x4 oc = cc[j] * rc * gc;
            u32x2 q; q.x = pk2(oc.x, oc.y); q.y = pk2(oc.z, oc.w); ((u32x2*)(Y + (size_t)row * DM + DA + DB))[c] = q; }
    } else {
        const int r = row - TP, b = r >> 6, qi = r & 63;
        float cv[NH][2]; float sc = 0.f;
#pragma unroll
        for (int hh = 0; hh < NH; ++hh) {
            const int bh = b * NH + hh;
            float m = -1e30f;
#pragma unroll
            for (int sp = 0; sp < NSPLIT; ++sp) m = fmaxf(m, PM[((size_t)bh * NSPLIT + sp) * TS + qi]);
            float l = 0.f, o0 = 0.f, o1 = 0.f;
#pragma unroll
            for (int sp = 0; sp < NSPLIT; ++sp) {
                const size_t pr = ((size_t)bh * NSPLIT + sp) * TS + qi;
                const float w = __builtin_amdgcn_exp2f(PM[pr] - m);
                l += PL[pr] * w; o0 += PO[pr * HD + lane] * w; o1 += PO[pr * HD + lane + 64] * w;
            }
            const float inv = 1.f / l;
            cv[hh][0] = o0 * inv; cv[hh][1] = o1 * inv; sc += cv[hh][0] * cv[hh][0] + cv[hh][1] * cv[hh][1];
        }
        const float rc = rsqrtf(wave_sum(sc) * (1.f / DB) + LN_EPS);
#pragma unroll
        for (int hh = 0; hh < NH; ++hh) {
            const int c0 = DA + DB + hh * HD + lane;
            Y[(size_t)row * DM + c0] = f2bf(cv[hh][0] * rc * gm[c0]); Y[(size_t)row * DM + c0 + 64] = f2bf(cv[hh][1] * rc * gm[c0 + 64]);
        }
    }
}
__device__ __forceinline__ void cumsum_seq(LAS float* scr, const float* out, const float* cfl_l, float* Fp, float* Fs, int l, int seq, int tid) {
    const int lane = tid & 63, wave = tid >> 6;
    const bool prm = seq < 16; const int bh = prm ? seq : seq - 16, b = bh >> 2, h = bh & 3;
    const int n = prm ? SEQ : PAST + TS, seg = prm ? 8 : 9;
    const int i0 = tid * seg, i1 = min(n, i0 + seg);
    float s = 0.f;
    for (int i = i0; i < i1; ++i) s += logf_get(out, cfl_l, l, prm, b, h, i);
    float v = s;
#pragma unroll
    for (int o = 1; o < 64; o <<= 1) { const float t = __builtin_bit_cast(float, __builtin_amdgcn_ds_bpermute((lane - o) << 2, __builtin_bit_cast(int, v))); if (lane >= o) v += t; }
    __syncthreads();
    if (lane == 63) scr[wave] = v;
    __syncthreads();
    float pre = 0.f;
    for (int w = 0; w < wave; ++w) pre += scr[w];
    float run = pre + v - s;
    float* dst = prm ? Fp + (size_t)bh * SEQ : Fs + (size_t)bh * (PAST + TS);
    for (int i = i0; i < i1; ++i) { run += logf_get(out, cfl_l, l, prm, b, h, i); dst[i] = run; }
}

__global__ void __launch_bounds__(NTHREADS, 2) mk_fwd(Args args) {
    extern __shared__ __attribute__((aligned(16))) unsigned char lds_raw[];
    LAS unsigned char* lds = (LAS unsigned char*)lds_raw;
    volatile LAS unsigned* MISC = (volatile LAS unsigned*)(lds + MISC_OFF);
    const int wave = __builtin_amdgcn_readfirstlane((int)threadIdx.x >> 6);
#define TIDF() ([]() __attribute__((always_inline)) { int t_ = threadIdx.x; asm volatile("" : "+v"(t_)); return t_; }())
#define tid TIDF()
#define lane (TIDF() & 63)
    typedef const __attribute__((address_space(4))) Args* KArgs;
#define KA() ([]() __attribute__((always_inline)) { KArgs a_ = (KArgs)__builtin_amdgcn_kernarg_segment_ptr(); asm volatile("" : "+s"(a_)); return a_; }())
    { unsigned* ctl0 = (unsigned*)(args.ws + WS_CTL);
      for (int u = tid; u < (LDS_BYTES - RING_BYTES) / 4; u += NTHREADS) ((LAS unsigned*)(lds + RING_BYTES))[u] = 0u;
      __syncthreads();
      (void)xcd_barrier_post(ctl0 + CW_BAR + args.li * XCD_BAR_WORDS, MISC + 8); }
#ifdef PROBE_PHASE
#define NB_LRU ((KA()->flags >> 16) & 15 ? ((KA()->flags >> 16) & 15) - 1 : 8)
#define PF_LRU ((KA()->flags >> 21) & 3)
#define ATT_SKIP ((KA()->flags >> 24) & 7)
#else
#define NB_LRU 8
#define PF_LRU 0
#define ATT_SKIP 0
#endif
#define IN(k) (KA()->ph_lo <= (k) && (k) < KA()->ph_hi)
#define SEAM(k) do { if (IN(k) && IN((k) + 1)) { XcdBarrier b_; b_.bar = (unsigned*)(KA()->ws + WS_CTL) + CW_BAR + KA()->li * XCD_BAR_WORDS; b_.x = xb_xcc_id(); b_.st = MISC + 8; xcd_barrier(b_); } } while (0)
#define PHASE_PTRS \
    KArgs A_ = KA(); \
    const int G = gridDim.x, gw = blockIdx.x * NWAVES + wave, NGW = G * NWAVES; unsigned* ctl = (unsigned*)(A_->ws + WS_CTL); (void)G; (void)gw; (void)NGW; (void)ctl; \
    unsigned char* ws = A_->ws; float* out = A_->out; \
    const float *x_p = A_->in[0], *x_s = A_->in[1], *st_conv = A_->in[2], *st_lru = A_->in[3], *c_bk = A_->in[4], *c_bv = A_->in[5], *c_fk = A_->in[6], *c_fv = A_->in[7], *c_fl = A_->in[8], *w_in = A_->in[9]; \
    const float *w_conv = A_->in[10], *b_conv = A_->in[11], *w_ra = A_->in[12], *b_ra = A_->in[13], *w_rx = A_->in[14], *b_rx = A_->in[15], *lam = A_->in[16], *relb = A_->in[17], *bfg = A_->in[18], *gmix = A_->in[19], *w_out = A_->in[20]; \
    const float *ln1g = A_->in[21], *ln1b = A_->in[22], *w_up = A_->in[23], *w_dn = A_->in[24], *ln2g = A_->in[25], *ln2b = A_->in[26]; \
    bf16_t* WinT = (bf16_t*)(ws + WS_WIN); bf16_t* WoutT = (bf16_t*)(ws + WS_WOUT); bf16_t* WupT = (bf16_t*)(ws + WS_WUP); bf16_t* WdnT = (bf16_t*)(ws + WS_WDN); bf16_t* WgT = (bf16_t*)(ws + WS_WG); \
    float* WF = (float*)(ws + WS_WF); bf16_t* Xb = (bf16_t*)(ws + WS_XB); float* X1f = (float*)(ws + WS_X1F); bf16_t* X1b = (bf16_t*)(ws + WS_X1B); float* X2f = (float*)(ws + WS_X2F); \
    bf16_t* Z = (bf16_t*)(ws + WS_Z); bf16_t* H = (bf16_t*)(ws + WS_H); bf16_t* Y = (bf16_t*)(ws + WS_Y); bf16_t* HDN = (bf16_t*)(ws + WS_HDN); \
    bf16_t* OB = (bf16_t*)(ws + WS_OB); bf16_t* OC = (bf16_t*)(ws + WS_OC); float* Fp = (float*)(ws + WS_FP); float* Fs = (float*)(ws + WS_FS); float* OA = (float*)(ws + WS_OA); \
    float* PO = (float*)(ws + WS_PO); float* PM = (float*)(ws + WS_PM); float* PL = (float*)(ws + WS_PL); float* SA = (float*)(ws + WS_SA); float* SH = (float*)(ws + WS_SH); \
    (void)x_p; (void)x_s; (void)st_conv; (void)st_lru; (void)c_bk; (void)c_bv; (void)c_fk; (void)c_fv; (void)c_fl; (void)w_in; (void)w_conv; (void)b_conv; (void)w_ra; (void)b_ra; (void)w_rx; (void)b_rx; (void)lam; (void)relb; (void)bfg; (void)gmix; (void)w_out; \
    (void)ln1g; (void)ln1b; (void)w_up; (void)w_dn; (void)ln2g; (void)ln2b; (void)WinT; (void)WoutT; (void)WupT; (void)WdnT; (void)WgT; (void)WF; (void)Xb; (void)X1f; (void)X1b; (void)X2f; (void)Z; (void)H; (void)Y; (void)HDN; (void)OB; (void)OC; (void)Fp; (void)Fs; (void)OA; \
    (void)PO; (void)PM; (void)PL; (void)SA; (void)SH; (void)out;

    if (IN(0)) {
        PHASE_PTRS
        LAS float* scr = (LAS float*)(lds + wave * 16384);
        const bool mv = (G > 0) && (1440 % G) != 0;
        const bool mv2 = (G > 0) && (576 % G) != 0;
        for (int it = gw; it < DEPTH * CV_I_L; it += NGW) {
            const int r = it % CV_I_L;
            if (mv && r >= CV_I_IN && r < CV_I_IN + N_MV) continue;
            if (mv2 && ((it >= CV2_A0 && it < CV2_A0 + CV2_AN) || (it >= CV2_B0 && it < CV2_B0 + CV2_BN))) continue;
            conv_item(it, w_in, w_out, w_up, w_dn, w_ra, w_rx, WinT, WoutT, WupT, WdnT, WgT, scr, lane);
        }
        for (int i = blockIdx.x * NTHREADS + tid; i < DEPTH * 4 * DM; i += G * NTHREADS) { const int l = i / (4 * DM), r = i % (4 * DM), j = r / DM, k = r % DM; WF[i] = w_in[(size_t)l * DM * DIN + (size_t)k * DIN + DINP + j]; }
        VM_WAIT(); __syncthreads();
    }
    SEAM(0);
    if (IN(1)) {
        PHASE_PTRS
        int ln = lane; asm volatile("" : "+v"(ln));
        for (int row = gw; row < TT; row += 2 * NGW) { const int nv = (TT - row + NGW - 1) / NGW; xcvt_rows<2>(x_p, x_s, WF, bfg, Xb, out, 0, row, NGW, nv < 3 ? nv : 3, ln); }
    }
    SEAM(1);

    for (int l = 0; l < DEPTH; ++l) {
        const int pb = 2 + 8 * l;
        if (IN(pb + 0)) {
            PHASE_PTRS
            int td = tid; asm volatile("" : "+v"(td));
            { const int spare0 = (G > 0) ? (1440 % G) : 0, nspare = (spare0 > 0) ? G - spare0 : G;
              if ((int)blockIdx.x >= ((spare0 > 0) ? spare0 : 0)) for (int seq = (int)blockIdx.x - ((spare0 > 0) ? spare0 : 0); seq < 144; seq += nspare) cumsum_seq((LAS float*)lds, out, c_fl + (size_t)l * NB_S * PAST * NH, Fp, Fs, l, seq, td); }
            __syncthreads();
            pg8::Gemm g{Xb, WinT + (size_t)l * DINP * DM, TT, DINP, DM}; pg8::StaticOrder S; S.init(TT, DINP, DM, G, (int)blockIdx.x, false);
            pg8::EpiInP E{H, out, l};
            pg8::gemm_phase<pg8::EpiInP, pg8::StaticOrder, true, true>(lds, g, S, E);
            { const int spare0 = (G > 0) ? (1440 % G) : 0;
              if (spare0 > 0 && (int)blockIdx.x >= spare0) {
                  VM_WAIT(); __syncthreads();
                  LAS float* scr = (LAS float*)(lds + wave * 16384);
                  const int nsw = (G - spare0) * NWAVES;
                  for (int r = nsw - 1 - (((int)blockIdx.x - spare0) * NWAVES + wave); r < N_MV; r += nsw)
                      conv_item(l * CV_I_L + CV_I_IN + r, w_in, w_out, w_up, w_dn, w_ra, w_rx, WinT, WoutT, WupT, WdnT, WgT, scr, lane);
                  VM_WAIT(); __syncthreads();
              } }
        }
        SEAM(pb + 0);
        if (IN(pb + 1)) {
            constexpr int N_AT = 256 + 512 + 256 + 32 + 256 + 128;
            for (;;) {
                if (tid == 0) MISC[16] = atomicAdd((unsigned*)(KA()->ws + WS_CTL) + CW_QUEUE + 64 * (l + 2 * ((KA()->flags >> 1) & 7)), 1u);
                __syncthreads();
                const int item = __builtin_amdgcn_readfirstlane((int)MISC[16]);
                __syncthreads();
                if (item >= N_AT) break;
                int kind, j;
                if (item < 128) { kind = 0; j = item; }
                else if (item < 1056) { const int m = item - 128, per = m / 29, p = m - 29 * per, cs0 = (p * 16) / 29, cs1 = ((p + 1) * 16) / 29;
                    if (cs1 > cs0) { kind = 1; j = 16 * per + cs0; }
                    else { const int o = 13 * per + (p - cs0); if (o < 288) { kind = 2; j = o; } else { kind = 0; j = (o < 352) ? 128 + (o - 288) : 192 + (o - 352); } } }
                else if (item < 1312) { kind = 3; j = item - 1056; } else { kind = 4; j = item - 1312; }
#ifdef PROBE_PHASE
                { const int mask = (KA()->flags >> 8) & 255; if (mask && !((mask >> kind) & 1)) continue; }
#endif
                if (kind == 0) { PHASE_PTRS const AttnCtx Cfp{H, nullptr, nullptr, Fp, nullptr, OC, nullptr, nullptr, nullptr}; attn_item<0>(lds, Cfp, j & 15, 15 - (j >> 4), 0); }
                else if (kind == 1) { PHASE_PTRS const AttnCtx Cfs{H, c_fk + (size_t)l * NB_S * PAST * DB, c_fv + (size_t)l * NB_S * PAST * DB, Fs, nullptr, nullptr, PO, PM, PL};
                                      fox_sample_item(lds, Cfs, j >> 2, j & 3); }
                else if (kind == 2) { PHASE_PTRS const LruCtx CL{H, st_conv + (size_t)l * NB_S * 3 * DA, st_lru + (size_t)l * NB_S * DA, w_conv + (size_t)l * 4 * DA, b_conv + (size_t)l * DA, WgT + (size_t)l * 2 * 8 * HD * HD,
                                          b_ra + (size_t)l * DA, b_rx + (size_t)l * DA, lam + (size_t)l * DA, gmix + (size_t)l * DM, SA, SH, Y, out, l, NB_LRU, PF_LRU, nullptr, nullptr, (float*)(ws + WS_AA), (bf16_t*)(ws + WS_UU)};
                                      if (j < 256) lru_item2<false, true>(lds, CL, j); else lru_item2<true>(lds, CL, j); }
                else if (kind == 3) { PHASE_PTRS const AttnCtx Cbp{H, nullptr, nullptr, nullptr, relb + (size_t)l * NH * NREL, OB, nullptr, nullptr, nullptr};
                                      const int bh = j & 15; attn_item<1>(lds, Cbp, bh >> 2, 15 - (j >> 4), bh & 3); }
                else { PHASE_PTRS const AttnCtx Cbs{H, c_bk + (size_t)l * NB_S * BAND * DB, c_bv + (size_t)l * NB_S * BAND * DB, nullptr, relb + (size_t)l * NH * NREL, OB, nullptr, nullptr, nullptr};
                       attn_item<2>(lds, Cbs, j >> 2, j & 3, 0); }
            }
        }
        SEAM(pb + 1);
        if (IN(pb + 2)) {
            { PHASE_PTRS
              const LruCtx CL{H, st_conv + (size_t)l * NB_S * 3 * DA, st_lru + (size_t)l * NB_S * DA, w_conv + (size_t)l * 4 * DA, b_conv + (size_t)l * DA, WgT + (size_t)l * 2 * 8 * HD * HD,
                              b_ra + (size_t)l * DA, b_rx + (size_t)l * DA, lam + (size_t)l * DA, gmix + (size_t)l * DM, SA, SH, Y, out, l, NB_LRU, PF_LRU, LRU_STREAM ? nullptr : OB, LRU_STREAM ? nullptr : OC, (float*)(ws + WS_AA), (bf16_t*)(ws + WS_UU)};
              if constexpr (LRU_STREAM) { for (int chunk = blockIdx.x; chunk < 256; chunk += G) lru_pass2_stream(lds, CL, chunk); }
              else { for (int chunk = blockIdx.x; chunk < 256; chunk += G) lru_fin(lds, CL, chunk); } }
            { PHASE_PTRS
              int ln = lane; asm volatile("" : "+v"(ln));
              for (int row = (LRU_STREAM ? 0 : TP) + gw; row < TT; row += NGW) mixnorm_row(OA, OB, OC, PO, PM, PL, gmix + (size_t)l * DM, Y, false, row, ln); }
        }
        SEAM(pb + 2);
        for (int half = 0; half < 2; ++half) {
            if (IN(pb + 3 + 3 * half)) {
                PHASE_PTRS
                const int Kg = half ? DFF : DM;
                pg8::Gemm g{half ? HDN : Y, half ? WdnT + (size_t)l * DM * DFF : WoutT + (size_t)l * DM * DM, TT, DM, Kg}; pg8::StaticOrder S; const int rem2 = (G > 0) ? (576 % G) : 0; const bool fill2 = (half == 0) && (l == 0) && rem2 > 0;
                S.init(TT, DM, Kg, G, (int)blockIdx.x, !fill2);
                pg8::EpiResP<true> E{Z, nullptr, nullptr, half ? X1b : Xb};
                pg8::gemm_phase<pg8::EpiResP<true>, pg8::StaticOrder, true, true>(lds, g, S, E, (float*)(ws + WS_SK), ctl + CW_SPLITK + (2 * l + half) * 64 * 16);
                if (fill2 && (int)blockIdx.x >= rem2) {
                    VM_WAIT(); __syncthreads();
                    LAS float* scr = (LAS float*)(lds + wave * 16384);
                    const int nsw = (G - rem2) * NWAVES;
                    for (int q = ((int)blockIdx.x - rem2) * NWAVES + wave; q < N_MV2; q += nsw)
                        conv_item(q < CV2_AN ? CV2_A0 + q : CV2_B0 + (q - CV2_AN), w_in, w_out, w_up, w_dn, w_ra, w_rx, WinT, WoutT, WupT, WdnT, WgT, scr, lane);
                    VM_WAIT(); __syncthreads();
                }
            }
            SEAM(pb + 3 + 3 * half);
            if (IN(pb + 4 + 3 * half)) {
                PHASE_PTRS
                const bool nxt = half && (l + 1 < DEPTH), last = half && (l == DEPTH - 1);
                const float* gg = (half ? ln2g : ln1g) + (size_t)l * DM; const float* bb = (half ? ln2b : ln1b) + (size_t)l * DM;
                float* xf = last ? out + O_YP : nullptr; bf16_t* xbo = half ? (last ? nullptr : Xb) : X1b;
                int ln = lane; asm volatile("" : "+v"(ln));
                for (int row = gw; row < TT; row += 3 * NGW) { const int nv = (TT - row + NGW - 1) / NGW; int l2 = ln; asm volatile("" : "+v"(l2));
                    ln_rows<3>(Z, gg, bb, xf, xbo, nxt ? WF + (size_t)(l + 1) * 4 * DM : nullptr, nxt ? bfg + (l + 1) * NH : nullptr, out, l + 1, row, NGW, nv < 3 ? nv : 3, l2); }
            }
            SEAM(pb + 4 + 3 * half);
            if (half == 0) {
                if (IN(pb + 5)) {
                    PHASE_PTRS
                    pg8::Gemm g{X1b, WupT + (size_t)l * DFF * DM, TT, DFF, DM}; pg8::StaticOrder S; S.init(TT, DFF, DM, G, (int)blockIdx.x, false);
                    pg8::EpiUpP E{HDN};
                    pg8::gemm_phase<pg8::EpiUpP, pg8::StaticOrder, true, true>(lds, g, S, E);
                }
                SEAM(pb + 5);
            }
        }
    }
#undef IN
#undef SEAM
#undef PHASE_PTRS
#undef tid
#undef lane
#undef TIDF
}
extern "C" void kernel_launch(void* const* d_in, const int* in_sizes, int n_in, void* d_out, int out_size, void* d_ws, size_t ws_size, hipStream_t stream) {
    static int grid = 0;
    if (grid == 0) {
        if (n_in != 27 || (size_t)out_size != O_END || ws_size < WS_END) { fprintf(stderr, "kernel_launch: unexpected sizes n_in %d out %d ws %zu (need %zu)\n", n_in, out_size, ws_size, (size_t)WS_END); grid = -1; return; }
        int dev = 0, cus = 0, per_cu = 0;
        if (hipGetDevice(&dev) != hipSuccess || hipDeviceGetAttribute(&cus, hipDeviceAttributeMultiprocessorCount, dev) != hipSuccess) { grid = -1; return; }
        if (hipFuncSetAttribute((const void*)mk_fwd, hipFuncAttributeMaxDynamicSharedMemorySize, LDS_BYTES) != hipSuccess) { fprintf(stderr, "kernel_launch: hipFuncSetAttribute failed\n"); grid = -1; return; }
        if (hipOccupancyMaxActiveBlocksPerMultiprocessor(&per_cu, (const void*)mk_fwd, NTHREADS, LDS_BYTES) != hipSuccess || per_cu < 1) fprintf(stderr, "kernel_launch: occupancy query says %d\n", per_cu);
        (void)hipGetLastError();
        grid = cus;
    }
    if (grid < 0) return;
    (void)hipMemsetAsync((unsigned char*)d_ws + WS_CTL, 0, CTL_ZERO_BYTES, stream);
    Args a{};
    for (int i = 0; i < 27; ++i) a.in[i] = (const float*)d_in[i];
    a.out = (float*)d_out; a.ws = (unsigned char*)d_ws; a.ph_lo = 0; a.ph_hi = NPH; a.li = 0; a.flags = 0;
    hipLaunchKernelGGL(mk_fwd, dim3(grid), dim3(NTHREADS), LDS_BYTES, stream, a);
#ifdef PROBE_PHASE
    { Args p = a; p.ph_lo = PROBE_PHASE; p.ph_hi = PROBE_PHASE + 1; p.li = 1; p.flags = 2;
      for (int r = 0; r < PROBE_REPS; ++r) { p.flags = 2 + 4 * r + (PROBE_MASK << 8) + (PROBE_NB << 16) + (PROBE_SKIP << 24); hipLaunchKernelGGL(mk_fwd, dim3(grid), dim3(NTHREADS), LDS_BYTES, stream, p); } }
#endif
    const hipError_t le = hipPeekAtLastError();
    if (le != hipSuccess) fprintf(stderr, "kernel_launch: mk_fwd launch failed: %s\n", hipGetErrorName(le));
}
```
